# Optimizing an MI355X kernel written in HIP

```python
import jax, jax.numpy as jnp
from jax import lax
import numpy as np

D_MODEL = 1024
BATCH = 16
SEQ = 2048
DEPTH = 1

D_MIX = D_MODEL
HEAD_DIM = 64
RW_HEADS = 8
RW_WIDTH = RW_HEADS * HEAD_DIM
RW_LORA_W = 64
RW_LORA_A = 64
RW_LORA_G = 128
RW_GN_EPS = 64e-5
AT_WIDTH = D_MIX - RW_WIDTH
AT_HEADS = AT_WIDTH // HEAD_DIM
IDX_HEADS = 4
IDX_DIM = 64
IDX_TOPK_MAX = 256
QBLOCK = 128
ROPE_THETA = 10000.0
NORM_EPS = 1e-6
LN_EPS = 1e-6
N_EXPERTS = 256
TOP_K = 8
N_GROUPS = 8
TOPK_GROUPS = 4
EXPERT_DIM = 256
SHARED_DIM = 256
ROUTED_SCALE = 2.5
EXPERT_BLOCK = 64
RW_SIZES = [RW_WIDTH, RW_WIDTH, RW_WIDTH, RW_LORA_W, RW_LORA_A, RW_LORA_G]
AT_SIZES = [AT_WIDTH, AT_WIDTH, AT_WIDTH, IDX_HEADS * IDX_DIM, IDX_DIM, IDX_HEADS]
RW_COLS = sum(RW_SIZES)
AT_COLS = sum(AT_SIZES)
IN_COLS = RW_COLS + AT_COLS

kernel_name = "hybrid_rwkv7_dsa_moe_block"


def _split(x, sizes):
    offs = np.cumsum(sizes)[:-1].tolist()
    return jnp.split(x, offs, axis=-1)


def _rmsnorm(x, g, eps=NORM_EPS):
    xf = x.astype(jnp.float32)
    y = xf * lax.rsqrt(jnp.mean(xf * xf, axis=-1, keepdims=True) + eps)
    return (y * g.astype(jnp.float32)).astype(x.dtype)


def _layernorm(x, g, b, eps=LN_EPS):
    xf = x.astype(jnp.float32)
    mu = jnp.mean(xf, axis=-1, keepdims=True)
    xc = xf - mu
    y = xc * lax.rsqrt(jnp.mean(xc * xc, axis=-1, keepdims=True) + eps)
    return (y * g.astype(jnp.float32) + b.astype(jnp.float32)).astype(x.dtype)


def _rope(x, positions):
    d = x.shape[-1]
    inv = ROPE_THETA ** (-jnp.arange(0, d, 2, dtype=jnp.float32) / d)
    ang = positions.astype(jnp.float32)[..., None] * inv
    ang = ang.reshape(ang.shape[:2] + (1,) * (x.ndim - 3) + (d // 2,))
    cos, sin = jnp.cos(ang), jnp.sin(ang)
    x1 = x[..., : d // 2].astype(jnp.float32)
    x2 = x[..., d // 2:].astype(jnp.float32)
    return jnp.concatenate([x1 * cos - x2 * sin, x2 * cos + x1 * sin], axis=-1).astype(x.dtype)


def _swiglu(x, w1, w3, w2):
    return (jax.nn.silu(x @ w1) * (x @ w3)) @ w2


def _rwkv7_scan(r, decay, k, v, kk, a):
    B, S, H, N = r.shape

    def step(state, inp):
        r_t, w_t, k_t, v_t, kk_t, a_t = inp
        sa = jnp.einsum('bhvk,bhk->bhv', state, kk_t)
        state = (state * w_t[:, :, None, :]
                 - sa[..., None] * (kk_t * a_t)[:, :, None, :]
                 + v_t[..., None] * k_t[:, :, None, :])
        return state, jnp.einsum('bhvk,bhk->bhv', state, r_t)

    xs = tuple(jnp.moveaxis(t, 1, 0) for t in (r, decay, k, v, kk, a))
    s0 = jnp.zeros((B, H, N, N), jnp.float32)
    _, ys = lax.scan(step, s0, xs)
    return jnp.moveaxis(ys, 0, 1)


def _rwkv7_mixer(p, mu, w0, w2, a0, a2, g2, k_k, k_a, r_k, ln_w, ln_b):
    B, S, _ = p.shape
    p_prev = jnp.pad(p, ((0, 0), (1, 0), (0, 0)))[:, :S]
    p = p + (p_prev - p) * mu
    r, k, v, wl, al, gl = _split(p, RW_SIZES)
    w = -jax.nn.softplus(-(w0 + jnp.tanh(wl) @ w2)) - 0.5
    decay = jnp.exp(-jnp.exp(w.astype(jnp.float32)))
    a = jax.nn.sigmoid(a0 + al @ a2)
    g = jax.nn.sigmoid(gl) @ g2

    def heads(t):
        return t.reshape(B, S, RW_HEADS, HEAD_DIM).astype(jnp.float32)

    r, k, v, a, decay = heads(r), heads(k), heads(v), heads(a), heads(decay)
    kk = k * k_k.reshape(RW_HEADS, HEAD_DIM).astype(jnp.float32)
    kk = kk / jnp.maximum(jnp.sqrt(jnp.sum(kk * kk, axis=-1, keepdims=True)), 1e-12)
    k = k * (1.0 + (a - 1.0) * k_a.reshape(RW_HEADS, HEAD_DIM).astype(jnp.float32))
    y = _rwkv7_scan(r, decay, k, v, kk, a)
    mu_y = jnp.mean(y, axis=-1, keepdims=True)
    yc = y - mu_y
    y = yc * lax.rsqrt(jnp.mean(yc * yc, axis=-1, keepdims=True) + RW_GN_EPS)
    y = y * ln_w.reshape(RW_HEADS, HEAD_DIM).astype(jnp.float32) + ln_b.reshape(RW_HEADS, HEAD_DIM).astype(jnp.float32)
    y = y + jnp.sum(r * k * r_k.astype(jnp.float32), axis=-1, keepdims=True) * v
    return (y.reshape(B, S, RW_WIDTH) * g.astype(jnp.float32)).astype(p.dtype)


def _gather_rows(t, idx):
    return jax.vmap(lambda tb, ib: tb[ib])(t, idx)


def _dsa_mixer(p, positions, q_norm_g, k_norm_g, idx_ln_w, idx_ln_b, out_g):
    B, S, _ = p.shape
    q, k, v, qi, ki, wi = _split(p, AT_SIZES)
    q = _rope(_rmsnorm(q.reshape(B, S, AT_HEADS, HEAD_DIM), q_norm_g), positions)
    k = _rope(_rmsnorm(k.reshape(B, S, AT_HEADS, HEAD_DIM), k_norm_g), positions)
    qi = _rope(qi.reshape(B, S, IDX_HEADS, IDX_DIM), positions)
    ki = _rope(_layernorm(ki, idx_ln_w, idx_ln_b), positions)
    wi = wi * (IDX_HEADS ** -0.5 * IDX_DIM ** -0.5)
    kf = k.reshape(B, S, AT_WIDTH)
    vf = v.reshape(B, S, AT_WIDTH)
    topk = min(IDX_TOPK_MAX, S // 4)
    key_pos = jnp.arange(S, dtype=jnp.int32)
    scale = HEAD_DIM ** -0.5

    def block(t0):
        qb = lax.dynamic_slice_in_dim(q, t0, QBLOCK, axis=1)
        qib = lax.dynamic_slice_in_dim(qi, t0, QBLOCK, axis=1)
        wib = lax.dynamic_slice_in_dim(wi, t0, QBLOCK, axis=1)
        qpos = t0 + jnp.arange(QBLOCK, dtype=jnp.int32)
        logits = jnp.einsum('bqhd,bsd->bqhs', qib, ki)
        score = jnp.einsum('bqh,bqhs->bqs', wib, jax.nn.relu(logits)).astype(jnp.float32)
        causal = key_pos[None, :] <= qpos[:, None]
        score = jnp.where(causal[None], score, -jnp.inf)
        _, sel = lax.top_k(score, topk)
        valid = sel <= qpos[None, :, None]
        ks = _gather_rows(kf, sel).reshape(B, QBLOCK, topk, AT_HEADS, HEAD_DIM)
        vs = _gather_rows(vf, sel).reshape(B, QBLOCK, topk, AT_HEADS, HEAD_DIM)
        s = jnp.einsum('bqhd,bqkhd->bqhk', qb, ks).astype(jnp.float32) * scale
        s = jnp.where(valid[:, :, None, :], s, -jnp.inf)
        pr = jax.nn.softmax(s, axis=-1)
        return jnp.einsum('bqhk,bqkhd->bqhd', pr.astype(vs.dtype), vs)

    starts = jnp.arange(S // QBLOCK, dtype=jnp.int32) * QBLOCK
    o = lax.map(block, starts)
    o = jnp.moveaxis(o, 0, 1).reshape(B, S, AT_HEADS, HEAD_DIM)
    o = _rmsnorm(o, out_g)
    return o.reshape(B, S, AT_WIDTH)


def _moe(h, router_w, router_bias, w1, w3, w2, sw1, sw3, sw2):
    T, D = h.shape
    scores = jax.nn.sigmoid(h.astype(jnp.float32) @ router_w.astype(jnp.float32))
    biased = scores + router_bias.astype(jnp.float32)
    per_group = N_EXPERTS // N_GROUPS
    grp_score = lax.top_k(biased.reshape(T, N_GROUPS, per_group), 2)[0].sum(-1)
    _, top_g = lax.top_k(grp_score, TOPK_GROUPS)
    gmask = jnp.zeros((T, N_GROUPS), bool).at[jnp.arange(T)[:, None], top_g].set(True)
    masked = jnp.where(jnp.repeat(gmask, per_group, axis=1), biased, -jnp.inf)
    _, eidx = lax.top_k(masked, TOP_K)
    gw = jnp.take_along_axis(scores, eidx, axis=1)
    gw = gw / jnp.sum(gw, axis=-1, keepdims=True) * ROUTED_SCALE

    A = T * TOP_K
    flat_e = eidx.reshape(A)
    order = jnp.argsort(flat_e)
    e_sorted = flat_e[order]
    counts = jnp.bincount(flat_e, length=N_EXPERTS)
    padded = (counts + EXPERT_BLOCK - 1) // EXPERT_BLOCK * EXPERT_BLOCK
    start = jnp.cumsum(counts) - counts
    pend = jnp.cumsum(padded)
    pstart = pend - padded
    dest = pstart[e_sorted] + jnp.arange(A, dtype=jnp.int32) - start[e_sorted]
    n_blocks = -(-(A + N_EXPERTS * (EXPERT_BLOCK - 1)) // EXPERT_BLOCK)
    P = n_blocks * EXPERT_BLOCK
    slot_tok = jnp.full((P,), T, jnp.int32).at[dest].set((order // TOP_K).astype(jnp.int32))
    slot_w = jnp.zeros((P,), jnp.float32).at[dest].set(gw.reshape(A)[order])
    block_e = jnp.searchsorted(pend, jnp.arange(n_blocks, dtype=jnp.int32) * EXPERT_BLOCK, side='right')
    block_e = jnp.minimum(block_e, N_EXPERTS - 1)
    h_pad = jnp.concatenate([h, jnp.zeros((1, D), h.dtype)], axis=0)

    def expert_block(args):
        tok, e = args
        return _swiglu(h_pad[tok], w1[e], w3[e], w2[e]).astype(jnp.float32)

    out = lax.map(expert_block, (slot_tok.reshape(n_blocks, EXPERT_BLOCK), block_e))
    routed = jnp.zeros((T + 1, D), jnp.float32).at[slot_tok].add(out.reshape(P, D) * slot_w[:, None])[:T]
    shared = _swiglu(h, sw1, sw3, sw2).astype(jnp.float32)
    return (routed + shared).astype(h.dtype)


def setup_inputs(seed: int = 0) -> dict:
    key = jax.random.key(seed)
    ks = iter(jax.random.split(key, 48))
    f32 = jnp.float32
    L = DEPTH

    def nrm(shape, scale):
        return jax.random.normal(next(ks), shape, f32) * scale

    x = nrm((BATCH, SEQ, D_MODEL), 1.0)
    c = nrm((BATCH, D_MODEL), 1.0)
    offset = jax.random.randint(next(ks), (BATCH, 1), 0, 4096, jnp.int32)
    positions = offset + jnp.arange(SEQ, dtype=jnp.int32)[None, :]
    return {
        "x": x,
        "c": c,
        "positions": positions,
        "w_ada": nrm((L, D_MODEL, 6 * D_MODEL), 0.5 * D_MODEL ** -0.5),
        "b_ada": nrm((L, 6 * D_MODEL), 0.02),
        "norm1_g": 1.0 + nrm((L, D_MODEL), 0.02),
        "norm2_g": 1.0 + nrm((L, D_MODEL), 0.02),
        "w_in": nrm((L, D_MODEL, IN_COLS), D_MODEL ** -0.5),
        "rw_mu": jax.random.uniform(next(ks), (L, RW_COLS), f32, 0.1, 0.9),
        "rw_w0": jax.random.uniform(next(ks), (L, RW_WIDTH), f32, -6.0, 0.0),
        "rw_w2": nrm((L, RW_LORA_W, RW_WIDTH), RW_LORA_W ** -0.5),
        "rw_a0": nrm((L, RW_WIDTH), 0.5),
        "rw_a2": nrm((L, RW_LORA_A, RW_WIDTH), RW_LORA_A ** -0.5),
        "rw_g2": nrm((L, RW_LORA_G, RW_WIDTH), RW_LORA_G ** -0.5),
        "rw_k_k": 0.85 + nrm((L, RW_WIDTH), 0.05),
        "rw_k_a": 1.0 + nrm((L, RW_WIDTH), 0.05),
        "rw_r_k": nrm((L, RW_HEADS, HEAD_DIM), 0.1),
        "rw_ln_w": 1.0 + nrm((L, RW_WIDTH), 0.02),
        "rw_ln_b": nrm((L, RW_WIDTH), 0.02),
        "q_norm_g": 1.0 + nrm((L, HEAD_DIM), 0.02),
        "k_norm_g": 1.0 + nrm((L, HEAD_DIM), 0.02),
        "idx_ln_w": 1.0 + nrm((L, IDX_DIM), 0.02),
        "idx_ln_b": nrm((L, IDX_DIM), 0.02),
        "at_out_g": 1.0 + nrm((L, AT_HEADS, HEAD_DIM), 0.02),
        "w_out": nrm((L, D_MIX, D_MODEL), D_MIX ** -0.5),
        "router_w": nrm((L, D_MODEL, N_EXPERTS), D_MODEL ** -0.5),
        "router_bias": nrm((L, N_EXPERTS), 0.01),
        "exp_w1": nrm((L, N_EXPERTS, D_MODEL, EXPERT_DIM), D_MODEL ** -0.5),
        "exp_w3": nrm((L, N_EXPERTS, D_MODEL, EXPERT_DIM), D_MODEL ** -0.5),
        "exp_w2": nrm((L, N_EXPERTS, EXPERT_DIM, D_MODEL), EXPERT_DIM ** -0.5),
        "shared_w1": nrm((L, D_MODEL, SHARED_DIM), D_MODEL ** -0.5),
        "shared_w3": nrm((L, D_MODEL, SHARED_DIM), D_MODEL ** -0.5),
        "shared_w2": nrm((L, SHARED_DIM, D_MODEL), SHARED_DIM ** -0.5),
    }


def reference(x, c, positions, w_ada, b_ada, norm1_g, norm2_g, w_in, rw_mu, rw_w0, rw_w2,
              rw_a0, rw_a2, rw_g2, rw_k_k, rw_k_a, rw_r_k, rw_ln_w, rw_ln_b, q_norm_g,
              k_norm_g, idx_ln_w, idx_ln_b, at_out_g, w_out, router_w, router_bias,
              exp_w1, exp_w3, exp_w2, shared_w1, shared_w3, shared_w2):
    B, S, D = x.shape
    c_act = jax.nn.silu(c)
    for l in range(DEPTH):
        mod = c_act @ w_ada[l] + b_ada[l]
        shift1, scale1, gate1, shift2, scale2, gate2 = [m[:, None, :] for m in jnp.split(mod, 6, axis=-1)]

        h = _rmsnorm(x, norm1_g[l]) * (1.0 + scale1) + shift1
        p = h @ w_in[l]
        p_rw, p_at = p[..., :RW_COLS], p[..., RW_COLS:]
        y_rw = _rwkv7_mixer(p_rw, rw_mu[l], rw_w0[l], rw_w2[l], rw_a0[l], rw_a2[l], rw_g2[l],
                            rw_k_k[l], rw_k_a[l], rw_r_k[l], rw_ln_w[l], rw_ln_b[l])
        y_at = _dsa_mixer(p_at, positions, q_norm_g[l], k_norm_g[l], idx_ln_w[l], idx_ln_b[l], at_out_g[l])
        mix = jnp.concatenate([y_rw.astype(x.dtype), y_at.astype(x.dtype)], axis=-1) @ w_out[l]
        x = x + gate1 * mix

        h2 = _rmsnorm(x, norm2_g[l]) * (1.0 + scale2) + shift2
        y = _moe(h2.reshape(B * S, D), router_w[l], router_bias[l], exp_w1[l], exp_w3[l], exp_w2[l],
                 shared_w1[l], shared_w3[l], shared_w2[l]).reshape(B, S, D)
        x = x + gate2 * y
    return x
```

```cpp
#include <hip/hip_runtime.h>
#include <cstdio>
#include <cstdint>

#ifndef MK_PER_PHASE
#define MK_PER_PHASE 0
#endif

#define LAS __attribute__((address_space(3)))
#define GAS __attribute__((address_space(1)))
typedef unsigned short bf16;
typedef short bf16x8 __attribute__((ext_vector_type(8)));
typedef float f32x4 __attribute__((ext_vector_type(4)));
typedef float f32x16 __attribute__((ext_vector_type(16)));
typedef unsigned u32x4 __attribute__((ext_vector_type(4)));
typedef unsigned u32x2 __attribute__((ext_vector_type(2)));

constexpr int BATCH = 16, SEQ = 2048, DM = 1024, T = BATCH * SEQ;
constexpr int NP = 3840;
constexpr int IN_COLS = 3652;
constexpr int C_RWR = 0, C_RWK = 512, C_RWV = 1024, C_WL = 1536;
constexpr int C_Q = 1792, C_K = 2304, C_V = 2816, C_QI = 3328, C_KI = 3584, C_WI = 3648;
constexpr int NEXP = 256, ECAP = 32768;

constexpr size_t MiB = 1u << 20;
constexpr size_t WS_CTL = 0, CTL_BYTES = 32768;
constexpr size_t WS_MOD = 1 * MiB;
constexpr size_t WS_WINT = 2 * MiB;
constexpr size_t WS_WOUTT = 10 * MiB;
constexpr size_t WS_WLT = 12 * MiB;
constexpr size_t WS_WRT = 13 * MiB;
constexpr size_t WS_W2T = 16 * MiB;
constexpr size_t WS_W13T = 145 * MiB;
constexpr size_t WS_H = 404 * MiB;
constexpr size_t WS_P = 468 * MiB;
constexpr size_t WS_XR = 708 * MiB, WS_XK = 740 * MiB, WS_XV = 772 * MiB, WS_KKN = 804 * MiB;
constexpr size_t WS_LORA = 836 * MiB;
constexpr size_t WS_EE = 852 * MiB, WS_BV = 884 * MiB, WS_GG = 916 * MiB, WS_VF = 948 * MiB, WS_KF = 980 * MiB, WS_KIF = 1012 * MiB;
constexpr size_t WS_LOGIT = 468 * MiB;
constexpr size_t WS_TOKL = 500 * MiB;
constexpr size_t WS_Y = 145 * MiB;
constexpr size_t WS_ACT = 724 * MiB;
constexpr size_t WS_SEL = 870 * MiB;
constexpr size_t WS_GW = 872 * MiB;
constexpr size_t WS_X1B = 560 * MiB;
constexpr size_t WS_HG = 874 * MiB;
constexpr size_t WS_END = 1024 * MiB;
constexpr int CW_QUEUE = 64, CW_CNT = 1024  , CW_BAR = 4096;

constexpr int RING_BYTES = 153600;
constexpr int MISC_OFF = RING_BYTES;
constexpr int TAB_OFF = RING_BYTES + 256;
constexpr int MASK_OFF = 131072;
constexpr int LDS_BYTES = RING_BYTES + 8192;

__device__ __forceinline__ float bf2f(unsigned h) { return __uint_as_float(h << 16); }
typedef __bf16 bf16v2 __attribute__((ext_vector_type(2)));
typedef float f32x2 __attribute__((ext_vector_type(2)));
__device__ __forceinline__ unsigned pk2(float lo, float hi) { const f32x2 v = {lo, hi}; return __builtin_bit_cast(unsigned, __builtin_convertvector(v, bf16v2)); }
__device__ __forceinline__ unsigned f2bf(float f) { return pk2(f, 0.f) & 0xffffu; }
__device__ __forceinline__ float lo16(unsigned w) { return __uint_as_float(w << 16); }
__device__ __forceinline__ float hi16(unsigned w) { return __uint_as_float(w & 0xffff0000u); }
__device__ __forceinline__ float sigmoidf_(float x) { return 1.0f / (1.0f + __expf(-x)); }

namespace pg8 {
constexpr int BM = 256, BK = 64, HALF = 128, HTB = HALF * BK * 2, STAGE_BYTES = 8 * HTB, NXCD = 8, WGM = 8;
__host__ __device__ __forceinline__ int lds_byte(int r, int c) { const int st = (r >> 4) * 2 + (c >> 5), rr = r & 15, cc = c & 31, ob = rr * 64 + cc * 2; return st * 1024 + (ob ^ (((ob >> 9) & 1) << 5)); }
__host__ __device__ __forceinline__ void stage_rc(int b, int& R, int& C) { const int st = b / 1024, sb = b % 1024, swz = sb ^ (((sb >> 9) & 1) << 5); R = (st >> 1) * 16 + swz / 64; C = (st & 1) * 32 + (swz % 64) / 2; }
__host__ __device__ __forceinline__ int perm32(int rho) { const int n = rho >> 4, i = rho & 15; return 8 * (i >> 2) + 4 * n + (i & 3); }

struct Unit { int arow, brow, orow, ocol, nvalid, aux; };
struct Gemm { const bf16* A; const bf16* Bt; int K; };

struct StaticOrder {
    int nM, nN, nwg, G, c;
    __device__ void init(int M, int N, int G_, int c_) { nM = M / BM; nN = N / BM; nwg = nM * nN; G = G_; c = c_; }
    __device__ bool next(int i, Unit& u) const {
        const long L = (long)i * G + c; if (L >= nwg) return false;
        int wgid = (int)L; { const int q = nwg / NXCD, r = nwg % NXCD, xcd = wgid % NXCD, off = wgid / NXCD; wgid = (xcd < r ? xcd * (q + 1) : r * (q + 1) + (xcd - r) * q) + off; }
        const int nig = WGM * nN, gid = wgid / nig, fm = gid * WGM, gsz = (nM - fm) < WGM ? (nM - fm) : WGM;
        const int pm = fm + ((wgid % nig) % gsz), pn = (wgid % nig) / gsz;
        u.arow = pm * BM; u.brow = pn * BM; u.orow = pm * BM; u.ocol = pn * BM; u.nvalid = BM; u.aux = 0; return true;
    }
};
struct OneUnit { Unit u; __device__ bool next(int i, Unit& o) const { if (i != 0) return false; o = u; return true; } };
struct NoGather { static constexpr bool GATHER = false; __device__ __forceinline__ unsigned rowoff(int, int) const { return 0u; } };

template <class Epi, class Sched, bool ALIGN_EPI, bool SP2, class AMap>
__device__ __forceinline__ void gemm_phase(LAS unsigned char* lds, const Gemm g, const Sched& S, const Epi& E, const AMap& amap) {
    constexpr bool GATHER = AMap::GATHER;
    const int tid = threadIdx.x, wid = __builtin_amdgcn_readfirstlane(tid >> 6), lane = tid & 63, wr = wid >> 2, wc = wid & 3, fr = lane & 15, fq = lane >> 4;
    const int K = g.K, nt = K / BK;
    unsigned voffA[2], voffB[2], voffG[2][2];
    int RA[2], CA[2];
#pragma unroll
    for (int i = 0; i < 2; ++i) { int R, C; stage_rc(tid * 16 + i * 8192, R, C); const int Rb = Epi::PERM ? ((R & ~31) + perm32(R & 31)) : R;
        voffA[i] = (unsigned)(R * K + C) * 2u; voffB[i] = (unsigned)(Rb * K + C) * 2u; RA[i] = R; CA[i] = C; voffG[0][i] = 0u; voffG[1][i] = 0u; }
    unsigned voffGn[2][2] = {{0u, 0u}, {0u, 0u}};
    if constexpr (GATHER) {
#pragma unroll
        for (int h = 0; h < 2; ++h)
#pragma unroll
            for (int i = 0; i < 2; ++i) voffG[h][i] = amap.rowoff(0, h * HALF + RA[i]) + (unsigned)CA[i] * 2u;
    }
    const size_t kstep = (size_t)(BK * 2);
    const size_t hstep = (size_t)HALF * K * 2;
    const size_t rowb = (size_t)K * 2;
    const unsigned ldsw = (unsigned)wid * 1024u;
    const int aoff = lds_byte(wr * 64 + fr, fq * 8), boff = lds_byte(wc * 32 + fr, fq * 8);
#define PG8_SA(b, h) (((b) * 2 + (h)) * HTB)
#define PG8_SB(b, h) ((4 + (b) * 2 + (h)) * HTB)
#define PG8_STAGE(bufoff, gbase, voff) do { _Pragma("unroll") for (int _i = 0; _i < 2; ++_i) \
        __builtin_amdgcn_global_load_lds((const unsigned*)((const char*)(gbase) + (voff)[_i]), (LAS unsigned*)(lds + (bufoff) + ldsw + _i * 8192), 16, 0, 0); } while (0)
#define PG8_STAGEA(bufoff, gbase, h) do { if constexpr (GATHER) { PG8_STAGE(bufoff, gbase, voffG[h]); } else { PG8_STAGE(bufoff, (gbase) + (h) * hstep, voffA); } } while (0)
#define PG8_STAGEAN(bufoff, gbase, h) do { if constexpr (GATHER) { PG8_STAGE(bufoff, gbase, vsel[h]); } else { PG8_STAGE(bufoff, (gbase) + (h) * hstep, voffA); } } while (0)
#define PG8_LDA(dst, b, h) do { _Pragma("unroll") for (int m = 0; m < 4; ++m) _Pragma("unroll") for (int k = 0; k < 2; ++k) dst[m][k] = *(const LAS bf16x8*)(lds + PG8_SA(b, h) + aoff + m * 2048 + k * 1024); } while (0)
#define PG8_LDB(dst, b, h) do { _Pragma("unroll") for (int n = 0; n < 2; ++n) _Pragma("unroll") for (int k = 0; k < 2; ++k) dst[n][k] = *(const LAS bf16x8*)(lds + PG8_SB(b, h) + boff + n * 2048 + k * 1024); } while (0)
#define PG8_MMA(ai, bj, At, Bt) do { __builtin_amdgcn_s_setprio(1); _Pragma("unroll") for (int m = 0; m < 4; ++m) _Pragma("unroll") for (int n = 0; n < 2; ++n) _Pragma("unroll") for (int k = 0; k < 2; ++k) \
        acc[ai][bj][m][n] = __builtin_amdgcn_mfma_f32_16x16x32_bf16(Bt[n][k], At[m][k], acc[ai][bj][m][n], 0, 0, 0); __builtin_amdgcn_s_setprio(0); } while (0)
#define PG8_WAIT_V(n) asm volatile("s_waitcnt vmcnt(" #n ")" ::: "memory")
#define PG8_WAIT_L(n) asm volatile("s_waitcnt lgkmcnt(" #n ")" ::: "memory")
#define PG8_BAR __builtin_amdgcn_s_barrier()
#define PG8_SCHED __builtin_amdgcn_sched_barrier(0)
    Unit cur, nxt; int ui = 0;
    if (!S.next(0, cur)) return;
    f32x4 acc[2][2][4][2];
#pragma unroll
    for (int a = 0; a < 2; ++a)
#pragma unroll
        for (int b = 0; b < 2; ++b)
#pragma unroll
            for (int m = 0; m < 4; ++m)
#pragma unroll
                for (int n = 0; n < 2; ++n) acc[a][b][m][n] = (f32x4){0.f, 0.f, 0.f, 0.f};
    bf16x8 At[4][2], B0[2][2], B1[2][2];
    const char* cA = (const char*)g.A + (GATHER ? (size_t)0 : (size_t)cur.arow * rowb); const char* cB = (const char*)g.Bt + (size_t)cur.brow * rowb;
    if constexpr (SP2) {
        PG8_STAGE(PG8_SB(0, 0), cB, voffB); PG8_STAGE(PG8_SB(0, 1), cB + hstep, voffB); PG8_STAGEA(PG8_SA(0, 0), cA, 0); PG8_STAGEA(PG8_SA(0, 1), cA, 1);
        if (wr == 1) PG8_BAR;
        PG8_WAIT_V(2); PG8_BAR;
        PG8_STAGE(PG8_SB(1, 0), cB + kstep, voffB); PG8_STAGEA(PG8_SA(1, 0), cA + kstep, 0); PG8_STAGE(PG8_SB(1, 1), cB + hstep + kstep, voffB);
        PG8_WAIT_V(6); PG8_BAR;
    } else {
        PG8_STAGE(PG8_SB(0, 0), cB, voffB); PG8_STAGEA(PG8_SA(0, 0), cA, 0); PG8_STAGE(PG8_SB(0, 1), cB + hstep, voffB); PG8_STAGEA(PG8_SA(0, 1), cA, 1);
        if (wr == 1) PG8_BAR;
        PG8_WAIT_V(4); PG8_BAR;
        PG8_STAGE(PG8_SB(1, 0), cB + kstep, voffB); PG8_STAGEA(PG8_SA(1, 0), cA + kstep, 0); PG8_STAGE(PG8_SB(1, 1), cB + hstep + kstep, voffB);
        PG8_WAIT_V(6); PG8_BAR;
    }
    for (;;) {
        const bool has_next = S.next(ui + 1, nxt);
        if constexpr (GATHER) { if (has_next) {
#pragma unroll
            for (int h = 0; h < 2; ++h)
#pragma unroll
                for (int i = 0; i < 2; ++i) voffGn[h][i] = amap.rowoff(ui + 1, h * HALF + RA[i]) + (unsigned)CA[i] * 2u; } else {
#pragma unroll
            for (int h = 0; h < 2; ++h)
#pragma unroll
                for (int i = 0; i < 2; ++i) voffGn[h][i] = voffG[h][i]; } }
        const char* nA = has_next ? (const char*)g.A + (GATHER ? (size_t)0 : (size_t)nxt.arow * rowb) : cA; const char* nB = has_next ? (const char*)g.Bt + (size_t)nxt.brow * rowb : cB;
#pragma unroll 1
        for (int t = 0; t < nt; t += 2) {
            const bool last = (t == nt - 2);
            const char* a1 = cA + (size_t)(t + 1) * kstep;
            const char* a2 = last ? nA : cA + (size_t)(t + 2) * kstep; const char* b2 = last ? nB : cB + (size_t)(t + 2) * kstep;
            const char* a3 = a2 + kstep; const char* b3 = b2 + kstep;
            unsigned vsel[2][2];
#pragma unroll
            for (int h = 0; h < 2; ++h)
#pragma unroll
                for (int i = 0; i < 2; ++i) vsel[h][i] = last ? voffGn[h][i] : voffG[h][i];
            if constexpr (SP2) {
            PG8_LDB(B0, 0, 0); PG8_LDB(B1, 0, 1); PG8_SCHED; PG8_LDA(At, 0, 0); PG8_STAGEA(PG8_SA(1, 1), a1, 1);
            PG8_WAIT_V(8); PG8_WAIT_L(0); PG8_BAR; PG8_MMA(0, 0, At, B0); PG8_MMA(0, 1, At, B1); PG8_BAR; PG8_SCHED;
            PG8_LDA(At, 0, 1); PG8_STAGE(PG8_SB(0, 0), b2, voffB); PG8_STAGE(PG8_SB(0, 1), b2 + hstep, voffB); PG8_STAGEAN(PG8_SA(0, 0), a2, 0);
            PG8_WAIT_V(8); PG8_WAIT_L(0); PG8_BAR; if (cur.nvalid > HALF) { PG8_MMA(1, 0, At, B0); PG8_MMA(1, 1, At, B1); } PG8_BAR; PG8_SCHED;
            PG8_LDB(B0, 1, 0); PG8_LDB(B1, 1, 1); PG8_SCHED; PG8_LDA(At, 1, 0); PG8_STAGEAN(PG8_SA(0, 1), a2, 1);
            PG8_WAIT_V(8); PG8_WAIT_L(0); PG8_BAR; PG8_MMA(0, 0, At, B0); PG8_MMA(0, 1, At, B1); PG8_BAR; PG8_SCHED;
            PG8_LDA(At, 1, 1); PG8_STAGE(PG8_SB(1, 0), b3, voffB); PG8_STAGE(PG8_SB(1, 1), b3 + hstep, voffB); PG8_STAGEAN(PG8_SA(1, 0), a3, 0);
            PG8_WAIT_V(8); PG8_WAIT_L(0); PG8_BAR; if (cur.nvalid > HALF) { PG8_MMA(1, 0, At, B0); PG8_MMA(1, 1, At, B1); } PG8_BAR; PG8_SCHED;
            } else {
            PG8_LDB(B0, 0, 0); PG8_SCHED; PG8_LDA(At, 0, 0); PG8_STAGEA(PG8_SA(1, 1), a1, 1);
            PG8_WAIT_L(8); PG8_BAR; PG8_WAIT_L(0); PG8_MMA(0, 0, At, B0); PG8_BAR; PG8_SCHED;
            PG8_LDB(B1, 0, 1); PG8_STAGE(PG8_SB(0, 0), b2, voffB);
            PG8_BAR; PG8_WAIT_L(0); PG8_MMA(0, 1, At, B1); PG8_BAR;
            PG8_LDA(At, 0, 1); PG8_STAGEAN(PG8_SA(0, 0), a2, 0);
            PG8_BAR; PG8_WAIT_L(0); PG8_MMA(1, 0, At, B0); PG8_BAR; PG8_SCHED;
            PG8_STAGE(PG8_SB(0, 1), b2 + hstep, voffB);
            PG8_WAIT_V(6); PG8_BAR; PG8_MMA(1, 1, At, B1); PG8_BAR;
            PG8_LDB(B0, 1, 0); PG8_SCHED; PG8_LDA(At, 1, 0); PG8_STAGEAN(PG8_SA(0, 1), a2, 1);
            PG8_WAIT_L(8); PG8_BAR; PG8_WAIT_L(0); PG8_MMA(0, 0, At, B0); PG8_BAR; PG8_SCHED;
            PG8_LDB(B1, 1, 1); PG8_STAGE(PG8_SB(1, 0), b3, voffB);
            PG8_BAR; PG8_WAIT_L(0); PG8_MMA(0, 1, At, B1); PG8_BAR;
            PG8_LDA(At, 1, 1); PG8_STAGEAN(PG8_SA(1, 0), a3, 0);
            PG8_BAR; PG8_WAIT_L(0); PG8_MMA(1, 0, At, B0); PG8_BAR; PG8_SCHED;
            PG8_STAGE(PG8_SB(1, 1), b3 + hstep, voffB);
            PG8_WAIT_V(6); PG8_BAR; PG8_MMA(1, 1, At, B1); PG8_BAR;
            }
        }
        if constexpr (ALIGN_EPI) { if (wr == 0) PG8_BAR; }
        E(acc, cur, wr, wc, fr, fq);
        if (!has_next) break;
#pragma unroll
        for (int a = 0; a < 2; ++a)
#pragma unroll
            for (int b = 0; b < 2; ++b)
#pragma unroll
                for (int m = 0; m < 4; ++m)
#pragma unroll
                    for (int n = 0; n < 2; ++n) acc[a][b][m][n] = (f32x4){0.f, 0.f, 0.f, 0.f};
        cur = nxt; cA = nA; cB = nB; ++ui;
        if constexpr (GATHER) {
#pragma unroll
            for (int h = 0; h < 2; ++h)
#pragma unroll
                for (int i = 0; i < 2; ++i) voffG[h][i] = voffGn[h][i]; }
        if constexpr (ALIGN_EPI) { if (wr == 1) PG8_BAR; }
    }
    PG8_WAIT_V(0);
    if constexpr (!ALIGN_EPI) { if (wr == 0) PG8_BAR; }
    PG8_BAR;
#undef PG8_SA
#undef PG8_SB
#undef PG8_STAGE
#undef PG8_STAGEA
#undef PG8_STAGEAN
#undef PG8_LDA
#undef PG8_LDB
#undef PG8_MMA
#undef PG8_WAIT_V
#undef PG8_WAIT_L
#undef PG8_BAR
#undef PG8_SCHED
}

struct EpiBf16 {
    static constexpr bool PERM = true;
    bf16* O; int ldc; int skip;
    __device__ __forceinline__ void operator()(const f32x4 (&acc)[2][2][4][2], const Unit& u, int wr, int wc, int fr, int fq) const {
#pragma unroll
        for (int ai = 0; ai < 2; ++ai)
#pragma unroll
            for (int m = 0; m < 4; ++m) { const int lr = ai * HALF + wr * 64 + m * 16 + fr; if (lr < u.nvalid - skip) { bf16* rowp = O + (size_t)(u.orow + lr) * ldc + u.ocol + wc * 32 + 8 * fq;
#pragma unroll
                for (int bj = 0; bj < 2; ++bj) { const f32x4 v0 = acc[ai][bj][m][0], v1 = acc[ai][bj][m][1]; u32x4 w; w.x = pk2(v0[0], v0[1]); w.y = pk2(v0[2], v0[3]); w.z = pk2(v1[0], v1[1]); w.w = pk2(v1[2], v1[3]);
                    *(u32x4*)(rowp + bj * HALF) = w; } } }
    }
};
struct EpiFp8 {
    static constexpr bool PERM = true;
    unsigned char* O; int ldc; int skip;
    __device__ __forceinline__ void operator()(const f32x4 (&acc)[2][2][4][2], const Unit& u, int wr, int wc, int fr, int fq) const {
#pragma unroll
        for (int ai = 0; ai < 2; ++ai)
#pragma unroll
            for (int m = 0; m < 4; ++m) { const int lr = ai * HALF + wr * 64 + m * 16 + fr; if (lr < u.nvalid - skip) { unsigned char* rowp = O + (size_t)(u.orow + lr) * ldc + u.ocol + wc * 32 + 8 * fq;
#pragma unroll
                for (int bj = 0; bj < 2; ++bj) { const f32x4 v0 = acc[ai][bj][m][0], v1 = acc[ai][bj][m][1]; int w0 = 0, w1 = 0;
                    w0 = __builtin_amdgcn_cvt_pk_fp8_f32(v0[0], v0[1], w0, false); w0 = __builtin_amdgcn_cvt_pk_fp8_f32(v0[2], v0[3], w0, true);
                    w1 = __builtin_amdgcn_cvt_pk_fp8_f32(v1[0], v1[1], w1, false); w1 = __builtin_amdgcn_cvt_pk_fp8_f32(v1[2], v1[3], w1, true);
                    *(u32x2*)(rowp + bj * HALF) = (u32x2){(unsigned)w0, (unsigned)w1}; } } }
    }
};
struct EpiF32 {
    static constexpr bool PERM = false;
    float* C; int ldc;
    __device__ __forceinline__ void operator()(const f32x4 (&acc)[2][2][4][2], const Unit& u, int wr, int wc, int fr, int fq) const {
#pragma unroll
        for (int ai = 0; ai < 2; ++ai)
#pragma unroll
            for (int m = 0; m < 4; ++m) { float* rowp = C + (size_t)(u.orow + ai * HALF + wr * 64 + m * 16 + fr) * ldc + u.ocol + wc * 32 + 4 * fq;
#pragma unroll
                for (int bj = 0; bj < 2; ++bj)
#pragma unroll
                    for (int n = 0; n < 2; ++n) *(f32x4*)(rowp + bj * HALF + n * 16) = acc[ai][bj][m][n]; }
    }
};
struct EpiResid {
    static constexpr bool PERM = true;
    const float* x; bf16* out; const float* mod; int goff;
    __device__ __forceinline__ void operator()(const f32x4 (&acc)[2][2][4][2], const Unit& u, int wr, int wc, int fr, int fq) const {
        const int b = u.orow / SEQ; const float* gp = mod + (size_t)b * 6144 + goff + u.ocol + wc * 32 + 8 * fq;
        f32x4 gv[2][2];
#pragma unroll
        for (int bj = 0; bj < 2; ++bj)
#pragma unroll
            for (int n = 0; n < 2; ++n) gv[bj][n] = *(const f32x4*)(gp + bj * HALF + 4 * n);
#pragma unroll
        for (int ai = 0; ai < 2; ++ai)
#pragma unroll
            for (int mp = 0; mp < 4; mp += 2) {
                f32x4 xv[2][2][2];
#pragma unroll
                for (int mm = 0; mm < 2; ++mm) { const size_t off = (size_t)(u.orow + ai * HALF + wr * 64 + (mp + mm) * 16 + fr) * DM + u.ocol + wc * 32 + 8 * fq;
#pragma unroll
                    for (int bj = 0; bj < 2; ++bj)
#pragma unroll
                        for (int n = 0; n < 2; ++n) xv[mm][bj][n] = *(const f32x4*)(x + off + bj * HALF + 4 * n); }
#pragma unroll
                for (int mm = 0; mm < 2; ++mm) { const size_t off = (size_t)(u.orow + ai * HALF + wr * 64 + (mp + mm) * 16 + fr) * DM + u.ocol + wc * 32 + 8 * fq;
#pragma unroll
                    for (int bj = 0; bj < 2; ++bj) { const f32x4 o0 = xv[mm][bj][0] + gv[bj][0] * acc[ai][bj][mp + mm][0], o1 = xv[mm][bj][1] + gv[bj][1] * acc[ai][bj][mp + mm][1];
                        *(u32x4*)(out + off + bj * HALF) = (u32x4){pk2(o0[0], o0[1]), pk2(o0[2], o0[3]), pk2(o1[0], o1[1]), pk2(o1[2], o1[3])}; } }
            }
    }
};
struct EpiSwiglu {
    static constexpr bool PERM = true;
    bf16* act;
    __device__ __forceinline__ void operator()(const f32x4 (&acc)[2][2][4][2], const Unit& u, int wr, int wc, int fr, int fq) const {
#pragma unroll
        for (int ai = 0; ai < 2; ++ai)
#pragma unroll
            for (int m = 0; m < 4; ++m) { const int lr = ai * HALF + wr * 64 + m * 16 + fr; if (lr < u.nvalid) {
                float o[8];
#pragma unroll
                for (int n = 0; n < 2; ++n)
#pragma unroll
                    for (int i = 0; i < 4; ++i) { const float a = acc[ai][0][m][n][i], c = acc[ai][1][m][n][i]; o[4 * n + i] = a * sigmoidf_(a) * c; }
                u32x4 w; w.x = pk2(o[0], o[1]); w.y = pk2(o[2], o[3]); w.z = pk2(o[4], o[5]); w.w = pk2(o[6], o[7]);
                *(u32x4*)(act + (size_t)(u.orow + lr) * 256 + u.ocol + wc * 32 + 8 * fq) = w; } }
    }
};
struct EpiLora {
    static constexpr bool PERM = true;
    const float* w0; const float* a0; const float* k_a; bf16* EE; bf16* XK; const bf16* KKN; bf16* BV; bf16* GG;
    __device__ __forceinline__ void operator()(const f32x4 (&acc)[2][2][4][2], const Unit& u, int wr, int wc, int fr, int fq) const {
        const int br = u.ocol >> 9;
        const int cbase = (u.ocol & 511) + wc * 32 + 8 * fq;
        const size_t rbase = (size_t)(u.orow + wr * 64 + fr) * 512 + cbase;
        if (br == 0) {
#pragma unroll
            for (int bj = 0; bj < 2; ++bj) {
                const f32x4 pa = *(const f32x4*)(w0 + cbase + bj * HALF), pb = *(const f32x4*)(w0 + cbase + bj * HALF + 4);
#pragma unroll
                for (int ai = 0; ai < 2; ++ai)
#pragma unroll
                    for (int m = 0; m < 4; ++m) {
                        float e[8];
#pragma unroll
                        for (int i = 0; i < 4; ++i) {
                            { const float z = -(pa[i] + acc[ai][bj][m][0][i]); const float sp = fmaxf(z, 0.f) + __logf(1.0f + __expf(-fabsf(z))); e[i] = __expf(-sp - 0.5f); }
                            { const float z = -(pb[i] + acc[ai][bj][m][1][i]); const float sp = fmaxf(z, 0.f) + __logf(1.0f + __expf(-fabsf(z))); e[4 + i] = __expf(-sp - 0.5f); }
                        }
                        u32x4 w; w.x = pk2(e[0], e[1]); w.y = pk2(e[2], e[3]); w.z = pk2(e[4], e[5]); w.w = pk2(e[6], e[7]);
                        *(u32x4*)(EE + rbase + (size_t)(ai * HALF + m * 16) * 512 + bj * HALF) = w;
                    }
            }
        } else if (br == 1) {
#pragma unroll
            for (int bj = 0; bj < 2; ++bj) {
                const f32x4 pa = *(const f32x4*)(a0 + cbase + bj * HALF), pb = *(const f32x4*)(a0 + cbase + bj * HALF + 4);
#pragma unroll
                for (int ai = 0; ai < 2; ++ai)
#pragma unroll
                    for (int m = 0; m < 4; ++m) {
                        float av[8];
#pragma unroll
                        for (int i = 0; i < 4; ++i) { av[i] = sigmoidf_(pa[i] + acc[ai][bj][m][0][i]); av[4 + i] = sigmoidf_(pb[i] + acc[ai][bj][m][1][i]); }
                        u32x4 w; w.x = pk2(av[0], av[1]); w.y = pk2(av[2], av[3]); w.z = pk2(av[4], av[5]); w.w = pk2(av[6], av[7]);
                        *(u32x4*)(BV + rbase + (size_t)(ai * HALF + m * 16) * 512 + bj * HALF) = w;
                    }
            }
        } else {
#pragma unroll
            for (int bj = 0; bj < 2; ++bj)
#pragma unroll
                for (int ai = 0; ai < 2; ++ai)
#pragma unroll
                    for (int m = 0; m < 4; ++m) {
                        const f32x4 v0 = acc[ai][bj][m][0], v1 = acc[ai][bj][m][1];
                        u32x4 w; w.x = pk2(v0[0], v0[1]); w.y = pk2(v0[2], v0[3]); w.z = pk2(v1[0], v1[1]); w.w = pk2(v1[2], v1[3]);
                        *(u32x4*)(GG + rbase + (size_t)(ai * HALF + m * 16) * 512 + bj * HALF) = w;
                    }
        }
    }
};
}

#define XB_TMO      128
#define XB_XCNT(j)  (256  + 64 * (j))
#define XB_XSUB(j)  (1280 + 64 * (j))
#define XB_XGEN(j)  (2304 + 64 * (j))
#define XB_TOP      3328
#define XB_TOPGEN   3392
#define XCD_BAR_WORDS 3456
#define XB_SPIN_CAP (1u << 22)
__device__ __forceinline__ unsigned xb_ld(unsigned* p)              { return __hip_atomic_load(p, __ATOMIC_RELAXED, __HIP_MEMORY_SCOPE_AGENT); }
__device__ __forceinline__ unsigned xb_add(unsigned* p, unsigned v) { return __hip_atomic_fetch_add(p, v, __ATOMIC_RELAXED, __HIP_MEMORY_SCOPE_AGENT); }
__device__ __forceinline__ unsigned xb_xcc_id() { return (unsigned)__builtin_amdgcn_s_getreg((3 << 11) | 20) & 0xFu; }
#define XB_SPIN(cond, bar) do { unsigned _sp = 0; while (cond) { __builtin_amdgcn_s_sleep(1); \
    if ((++_sp & 255u) == 0u) { if (xb_ld(&(bar)[XB_TMO])) break; if (_sp > XB_SPIN_CAP) { atomicAdd(&(bar)[XB_TMO], 1u); break; } } } } while (0)
struct XcdBarrier { unsigned* bar; unsigned x; volatile LAS unsigned* st; };
__device__ __forceinline__ XcdBarrier xcd_barrier_post(unsigned* bar, volatile LAS unsigned* st) {
    XcdBarrier b; b.bar = bar; b.x = xb_xcc_id(); b.st = st;
    if (threadIdx.x == 0) (void)xb_add(&bar[XB_XCNT(b.x)], 1u);
    return b;
}
__device__ __forceinline__ void xcd_barrier_complete(unsigned* bar, unsigned x, unsigned& nloc, unsigned& nx) {
    const unsigned G = gridDim.x * gridDim.y * gridDim.z;
    unsigned sum, cnt, mine, sp = 0u;
    for (;;) {
        sum = 0u; cnt = 0u; mine = 0u;
#pragma unroll
        for (unsigned j = 0; j < 16; ++j) { const unsigned c = xb_ld(&bar[XB_XCNT(j)]); sum += c; cnt += (c > 0u) ? 1u : 0u; mine = (j == x) ? c : mine; }
        if (sum == G) break;
        __builtin_amdgcn_s_sleep(1);
        if ((++sp & 255u) == 0u) { if (xb_ld(&bar[XB_TMO])) break; if (sp > XB_SPIN_CAP) { atomicAdd(&bar[XB_TMO], 1u); break; } }
    }
    nloc = mine > 0u ? mine : 1u; nx = cnt > 0u ? cnt : 1u;
}
__device__ __forceinline__ void xcd_barrier(const XcdBarrier& b) {
    asm volatile("s_waitcnt vmcnt(0)" ::: "memory");
    __syncthreads();
    if (threadIdx.x == 0) {
        unsigned* bar = b.bar;
        __builtin_amdgcn_s_waitcnt(0);
        unsigned nloc = b.st[0], nx = b.st[1];
        if (nloc == 0u) { xcd_barrier_complete(bar, b.x, nloc, nx); b.st[0] = nloc; b.st[1] = nx; }
        const unsigned old = xb_add(&bar[XB_XSUB(b.x)], 1u);
        const unsigned gen = old / nloc;
        if (old + 1u == (gen + 1u) * nloc) {
            __builtin_amdgcn_fence(__ATOMIC_RELEASE, "agent");
            asm volatile("s_waitcnt vmcnt(0)" ::: "memory");
            const unsigned og = xb_add(&bar[XB_TOP], 1u);
            const unsigned tg = og / nx;
            if (og + 1u == (tg + 1u) * nx) xb_add(&bar[XB_TOPGEN], 1u);
            else XB_SPIN(xb_ld(&bar[XB_TOPGEN]) == tg, bar);
            __builtin_amdgcn_fence(__ATOMIC_ACQUIRE, "agent");
            xb_add(&bar[XB_XGEN(b.x)], 1u);
            asm volatile("s_waitcnt vmcnt(0)" ::: "memory");
        } else {
            XB_SPIN(xb_ld(&bar[XB_XGEN(b.x)]) == gen, bar);
            __builtin_amdgcn_fence(__ATOMIC_ACQUIRE, "agent");
            asm volatile("s_waitcnt vmcnt(0)" ::: "memory");
        }
    }
    __syncthreads();
}

struct Args { const float* in[33]; float* out; unsigned char* ws; int ph_lo, ph_hi, probe, pad; };

#define LDS_WAIT() asm volatile("s_waitcnt lgkmcnt(0)" ::: "memory")

__device__ __forceinline__ void p0_transpose_item(const float* W, int K, int Nsrc, bf16* WT, int dest_row0, int k0, int n0, LAS float* scr, int lane) {
    const int c4 = 4 * (lane & 15), kr = lane >> 4; const bool ok = (n0 + c4) < Nsrc;
    f32x4 tv[16];
#pragma unroll
    for (int i = 0; i < 16; ++i) { const int kk = 4 * i + kr; tv[i] = ok ? __builtin_nontemporal_load((const f32x4*)(W + (size_t)(k0 + kk) * Nsrc + n0 + c4)) : (f32x4){0.f, 0.f, 0.f, 0.f}; }
#pragma unroll
    for (int i = 0; i < 16; ++i) { const int kk = 4 * i + kr; LAS float* d = scr + kk * 65 + c4; d[0] = tv[i].x; d[1] = tv[i].y; d[2] = tv[i].z; d[3] = tv[i].w; }
    LDS_WAIT(); asm volatile("" ::: "memory");
    const int c = lane & 7;
#pragma unroll
    for (int j = 0; j < 8; ++j) { const int n = (lane >> 3) + 8 * j; const LAS float* sp = scr + (8 * c) * 65 + n;
        u32x4 o; o.x = pk2(sp[0 * 65], sp[1 * 65]); o.y = pk2(sp[2 * 65], sp[3 * 65]); o.z = pk2(sp[4 * 65], sp[5 * 65]); o.w = pk2(sp[6 * 65], sp[7 * 65]);
        *(u32x4*)(WT + (size_t)(dest_row0 + n) * K + k0 + 8 * c) = o; }
    LDS_WAIT(); asm volatile("" ::: "memory");
}
struct P0Item { const float* src; bf16* dst; int K, Nsrc, dest_row0, k0, n0; };
__device__ __forceinline__ P0Item p0_expert_desc(const Args& args, unsigned char* ws, int e, int q) {
    P0Item it;
    if (q < 128) {
        const int which = q >> 6, qq = q & 63, kb = qq / 4, nb = qq % 4, n0 = 64 * nb;
        it.src = (e < 256) ? args.in[which ? 28 : 27] + (size_t)e * 1024 * 256 : args.in[which ? 31 : 30];
        it.dst = (bf16*)(ws + WS_W13T) + (size_t)e * 512 * 1024; it.K = 1024; it.Nsrc = 256; it.dest_row0 = (n0 >> 7) * 256 + (n0 & 127) + which * 128; it.k0 = 64 * kb; it.n0 = n0;
    } else {
        const int qq = q - 128, kb = qq / 16, nb = qq % 16;
        it.src = (e < 256) ? args.in[29] + (size_t)e * 256 * 1024 : args.in[32];
        it.dst = (bf16*)(ws + WS_W2T) + (size_t)e * 1024 * 256; it.K = 256; it.Nsrc = 1024; it.dest_row0 = 64 * nb; it.k0 = 64 * kb; it.n0 = 64 * nb;
    }
    return it;
}
__device__ __forceinline__ void p0_expert_item(const Args& args, unsigned char* ws, int e, int q, LAS float* scr, int lane) {
    const P0Item it = p0_expert_desc(args, ws, e, q);
    p0_transpose_item(it.src, it.K, it.Nsrc, it.dst, it.dest_row0, it.k0, it.n0, scr, lane);
}
__device__ __forceinline__ void p0_expert_wave(const Args& args, unsigned char* ws, int e, int qbeg, int qend, int wave, LAS float* scr, int lane) {
    const int c4 = 4 * (lane & 15), kr = lane >> 4, c = lane & 7;
    LAS unsigned* S = (LAS unsigned*)scr;
    f32x4 tv[16];
    P0Item cur = p0_expert_desc(args, ws, e, qbeg + wave);
#pragma unroll
    for (int i = 0; i < 16; ++i) tv[i] = __builtin_nontemporal_load((const f32x4*)(cur.src + (size_t)(cur.k0 + 8 * (i >> 1) + 2 * kr + (i & 1)) * cur.Nsrc + cur.n0 + c4));
    auto step = [&](int q) {
#pragma unroll
        for (int i = 0; i < 8; ++i) { LAS unsigned* d = S + c4 * 33 + 4 * i + kr;
            d[0] = pk2(tv[2 * i].x, tv[2 * i + 1].x); d[33] = pk2(tv[2 * i].y, tv[2 * i + 1].y); d[66] = pk2(tv[2 * i].z, tv[2 * i + 1].z); d[99] = pk2(tv[2 * i].w, tv[2 * i + 1].w); }
        const P0Item nxt = p0_expert_desc(args, ws, e, (q + 8 < qend) ? q + 8 : q);
#pragma unroll
        for (int i = 0; i < 16; ++i) tv[i] = __builtin_nontemporal_load((const f32x4*)(nxt.src + (size_t)(nxt.k0 + 8 * (i >> 1) + 2 * kr + (i & 1)) * nxt.Nsrc + nxt.n0 + c4));
        LDS_WAIT(); asm volatile("" ::: "memory");
#pragma unroll
        for (int j = 0; j < 8; ++j) { const int n = (lane >> 3) + 8 * j; const LAS unsigned* sp = S + n * 33 + 4 * c;
            u32x4 o; o.x = sp[0]; o.y = sp[1]; o.z = sp[2]; o.w = sp[3];
            __builtin_nontemporal_store(o, (u32x4*)(cur.dst + (size_t)(cur.dest_row0 + n) * cur.K + cur.k0 + 8 * c)); }
        LDS_WAIT(); asm volatile("" ::: "memory");
        cur = nxt;
    };
    step(qbeg + wave);
#pragma unroll 1
    for (int q = qbeg + wave + 8; q < qend; q += 8) step(q);
}
__device__ __forceinline__ float wave_sum(float v) {
#pragma unroll
    for (int o = 1; o < 64; o <<= 1) v += __shfl_xor(v, o);
    return v;
}
__device__ __forceinline__ void norm_mod_rows16(const float* xbase, const float* g, const float* shift, const float* scale, bf16* obase, int lane) {
    f32x4 gs[4], sh[4];
#pragma unroll
    for (int j = 0; j < 4; ++j) { gs[j] = ((const f32x4*)g)[lane + 64 * j] * (((const f32x4*)scale)[lane + 64 * j] + 1.0f); sh[j] = ((const f32x4*)shift)[lane + 64 * j]; }
    f32x4 v0[4], v1[4];
    { const f32x4* x0 = (const f32x4*)xbase + lane; const f32x4* x1 = x0 + DM / 4;
#pragma unroll
      for (int j = 0; j < 4; ++j) { v0[j] = x0[64 * j]; v1[j] = x1[64 * j]; } }
#pragma unroll 1
    for (int r = 0; r < 16; r += 2) {
        const int rn = (r + 2 < 16) ? r + 2 : r;
        const f32x4* x0 = (const f32x4*)(xbase + (size_t)rn * DM) + lane; const f32x4* x1 = x0 + DM / 4;
        f32x4 n0[4], n1[4]; float s0 = 0.f, s1 = 0.f;
#pragma unroll
        for (int j = 0; j < 4; ++j) { n0[j] = x0[64 * j]; n1[j] = x1[64 * j]; }
        __builtin_amdgcn_sched_barrier(0);
#pragma unroll
        for (int j = 0; j < 4; ++j) { s0 += (v0[j].x * v0[j].x + v0[j].y * v0[j].y) + (v0[j].z * v0[j].z + v0[j].w * v0[j].w); s1 += (v1[j].x * v1[j].x + v1[j].y * v1[j].y) + (v1[j].z * v1[j].z + v1[j].w * v1[j].w); }
        const float r0 = 1.0f / sqrtf(wave_sum(s0) * (1.f / DM) + 1e-6f), r1 = 1.0f / sqrtf(wave_sum(s1) * (1.f / DM) + 1e-6f);
        unsigned long long* o0 = (unsigned long long*)(obase + (size_t)r * DM) + lane; unsigned long long* o1 = o0 + DM / 4;
#pragma unroll
        for (int j = 0; j < 4; ++j) {
            const f32x4 y0 = v0[j] * r0 * gs[j] + sh[j], y1 = v1[j] * r1 * gs[j] + sh[j];
            o0[64 * j] = (unsigned long long)pk2(y0.x, y0.y) | ((unsigned long long)pk2(y0.z, y0.w) << 32);
            o1[64 * j] = (unsigned long long)pk2(y1.x, y1.y) | ((unsigned long long)pk2(y1.z, y1.w) << 32);
        }
#pragma unroll
        for (int j = 0; j < 4; ++j) { v0[j] = n0[j]; v1[j] = n1[j]; }
    }
}

__device__ __forceinline__ void norm_mod_rows16_bf(const bf16* xbase, const float* g, const float* shift, const float* scale, bf16* obase, int lane) {
    f32x4 gs[4], sh[4];
#pragma unroll
    for (int j = 0; j < 4; ++j) { gs[j] = ((const f32x4*)g)[lane + 64 * j] * (((const f32x4*)scale)[lane + 64 * j] + 1.0f); sh[j] = ((const f32x4*)shift)[lane + 64 * j]; }
    u32x2 w0[4], w1[4];
    { const u32x2* x0 = (const u32x2*)xbase + lane; const u32x2* x1 = x0 + DM / 4;
#pragma unroll
      for (int j = 0; j < 4; ++j) { w0[j] = x0[64 * j]; w1[j] = x1[64 * j]; } }
#pragma unroll 1
    for (int r = 0; r < 16; r += 2) {
        const int rn = (r + 2 < 16) ? r + 2 : r;
        const u32x2* x0 = (const u32x2*)(xbase + (size_t)rn * DM) + lane; const u32x2* x1 = x0 + DM / 4;
        u32x2 m0[4], m1[4]; f32x4 v0[4], v1[4]; float s0 = 0.f, s1 = 0.f;
#pragma unroll
        for (int j = 0; j < 4; ++j) { m0[j] = x0[64 * j]; m1[j] = x1[64 * j]; }
        __builtin_amdgcn_sched_barrier(0);
#pragma unroll
        for (int j = 0; j < 4; ++j) { v0[j] = (f32x4){lo16(w0[j].x), hi16(w0[j].x), lo16(w0[j].y), hi16(w0[j].y)}; v1[j] = (f32x4){lo16(w1[j].x), hi16(w1[j].x), lo16(w1[j].y), hi16(w1[j].y)};
            s0 += (v0[j].x * v0[j].x + v0[j].y * v0[j].y) + (v0[j].z * v0[j].z + v0[j].w * v0[j].w); s1 += (v1[j].x * v1[j].x + v1[j].y * v1[j].y) + (v1[j].z * v1[j].z + v1[j].w * v1[j].w); }
        const float r0 = 1.0f / sqrtf(wave_sum(s0) * (1.f / DM) + 1e-6f), r1 = 1.0f / sqrtf(wave_sum(s1) * (1.f / DM) + 1e-6f);
        unsigned long long* o0 = (unsigned long long*)(obase + (size_t)r * DM) + lane; unsigned long long* o1 = o0 + DM / 4;
#pragma unroll
        for (int j = 0; j < 4; ++j) {
            const f32x4 y0 = v0[j] * r0 * gs[j] + sh[j], y1 = v1[j] * r1 * gs[j] + sh[j];
            o0[64 * j] = (unsigned long long)pk2(y0.x, y0.y) | ((unsigned long long)pk2(y0.z, y0.w) << 32);
            o1[64 * j] = (unsigned long long)pk2(y1.x, y1.y) | ((unsigned long long)pk2(y1.z, y1.w) << 32);
        }
#pragma unroll
        for (int j = 0; j < 4; ++j) { w0[j] = m0[j]; w1[j] = m1[j]; }
    }
}

__device__ __forceinline__ float quad_sum(float x) {
    x += __builtin_bit_cast(float, __builtin_amdgcn_update_dpp(0, __builtin_bit_cast(int, x), 0xB1, 0xF, 0xF, true));
    x += __builtin_bit_cast(float, __builtin_amdgcn_update_dpp(0, __builtin_bit_cast(int, x), 0x4E, 0xF, 0xF, true));
    return x;
}
__device__ __forceinline__ float red16(float x) { x += __shfl_xor(x, 1); x += __shfl_xor(x, 2); x += __shfl_xor(x, 4); x += __shfl_xor(x, 8); return x; }
__device__ __forceinline__ float red8(float x) { x += __shfl_xor(x, 1); x += __shfl_xor(x, 2); x += __shfl_xor(x, 4); return x; }

constexpr int CP = 80;
constexpr int MB = 64 * CP * 2;
#define CMAT(i) ((LAS bf16*)(lds + (i) * MB))
__device__ __forceinline__ f32x4 mm_tile(const LAS bf16* A, const LAS bf16* Bt, int m0, int n0, int fr, int fq, f32x4 acc) {
#pragma unroll
    for (int ks = 0; ks < 2; ++ks) {
        const bf16x8 a = *(const LAS bf16x8*)(A + (m0 + fr) * CP + 32 * ks + 8 * fq), b = *(const LAS bf16x8*)(Bt + (n0 + fr) * CP + 32 * ks + 8 * fq);
        acc = __builtin_amdgcn_mfma_f32_16x16x32_bf16(a, b, acc, 0, 0, 0);
    }
    return acc;
}
__device__ __forceinline__ void tstore(LAS bf16* dst, int m0, int n0, int fr, int fq, f32x4 v) {
    u32x2 w; w.x = pk2(v[0], v[1]); w.y = pk2(v[2], v[3]);
    *(LAS u32x2*)(dst + (n0 + fr) * CP + m0 + 4 * fq) = w;
}
__device__ __forceinline__ void nstore(LAS bf16* dst, int m0, int n0, int fr, int fq, f32x4 v) {
#pragma unroll
    for (int r = 0; r < 4; ++r) dst[(m0 + 4 * fq + r) * CP + n0 + fr] = (bf16)f2bf(v[r]);
}
__device__ __forceinline__ void scan_job(LAS unsigned char* lds, int job, const unsigned char* ws, const float* r_k, const float* ln_w, const float* ln_b, const float* k_k, const float* k_a, int tid, int lane, int wave, int pmode) {
#define REPS(k) for (int _rp = 0; _rp < ((pmode == 10 + (k)) ? 5 : 1); ++_rp)
    const bf16* XR = (const bf16*)(ws + WS_XR); const bf16* EE = (const bf16*)(ws + WS_EE); const bf16* XK = (const bf16*)(ws + WS_XK);
    const bf16* XV = (const bf16*)(ws + WS_XV); const bf16* KKN = (const bf16*)(ws + WS_KKN); const bf16* BV = (const bf16*)(ws + WS_BV);
    const bf16* GG = (const bf16*)(ws + WS_GG); bf16* YC = (bf16*)(ws + WS_H);
    asm volatile("" : "+v"(tid), "+v"(lane));
    const int b = job >> 3, h = job & 7;
    const int fr = lane & 15, fq = lane >> 4;
    const int tm0 = 16 * (wave >> 1), tn0 = 32 * (wave & 1);
    const int et = tid >> 3, ej = 8 * (tid & 7);
    LAS bf16* Kt = CMAT(0); LAS bf16* Rt = CMAT(1); LAS bf16* Kh = CMAT(2); LAS bf16* Bh = CMAT(3); LAS bf16* KgT = CMAT(4); LAS bf16* BgT = CMAT(5); LAS bf16* VT = CMAT(6);
    LAS bf16* Akk = CMAT(7); LAS bf16* Lm = CMAT(8); LAS bf16* LT = CMAT(9); LAS bf16* Ark = CMAT(10); LAS bf16* Arb = CMAT(11);
    LAS float* Ebuf = (LAS float*)(lds + 7 * MB);
    LAS float* Ybuf = (LAS float*)(lds + 2 * MB);
    LAS float* gCv = (LAS float*)(lds + TAB_OFF);
    LAS float* bonv = gCv + 64;
    LAS float* Wtot = gCv + 128;
    const size_t mbase = (size_t)b * SEQ;
    f32x4 Sreg[2]; Sreg[0] = (f32x4){0.f, 0.f, 0.f, 0.f}; Sreg[1] = Sreg[0];
    for (int i = tid; i < MB / 4; i += 512) ((LAS unsigned*)(lds + 14 * MB))[i] = 0u;
    u32x4 ld[6];
    auto issue = [&](int c) {
        const size_t off = (mbase + 64 * c + et) * 512 + h * 64 + ej;
        ld[0] = *(const u32x4*)(XR + off); ld[1] = *(const u32x4*)(EE + off); ld[2] = *(const u32x4*)(XK + off);
        ld[3] = *(const u32x4*)(XV + off); ld[4] = *(const u32x4*)(BV + off); ld[5] = *(const u32x4*)(GG + off);
    };
    LAS float* rkl = gCv + 640; LAS float* lwl = gCv + 704; LAS float* lbl = gCv + 768;
    LAS float* kkl = gCv + 832; LAS float* kal = gCv + 896;
    if (tid < 64) { rkl[tid] = r_k[h * 64 + tid]; lwl[tid] = ln_w[h * 64 + tid]; lbl[tid] = ln_b[h * 64 + tid]; kkl[tid] = k_k[h * 64 + tid]; kal[tid] = k_a[h * 64 + tid]; }
    issue(0);
    __syncthreads();
#pragma unroll 1
    for (int c = 0; c < SEQ / 64; ++c) {
        LAS bf16* S0c = CMAT(14);
        float rr[8], ee[8], kk2[8], vv[8], kn[8], bb[8];
        {
            float n2 = 0.f;
#pragma unroll
            for (int i = 0; i < 4; ++i) { const unsigned w0 = ld[0][i], w1 = ld[1][i], w2 = ld[2][i], w3 = ld[3][i], w4 = ld[4][i];
                rr[2 * i] = lo16(w0); rr[2 * i + 1] = hi16(w0); ee[2 * i] = lo16(w1); ee[2 * i + 1] = hi16(w1); kk2[2 * i] = lo16(w2); kk2[2 * i + 1] = hi16(w2);
                vv[2 * i] = lo16(w3); vv[2 * i + 1] = hi16(w3); bb[2 * i] = lo16(w4); bb[2 * i + 1] = hi16(w4); }
#pragma unroll
            for (int i = 0; i < 8; ++i) { kn[i] = kk2[i] * kkl[ej + i]; n2 += kn[i] * kn[i]; }
            const float inv = 1.0f / fmaxf(sqrtf(red8(n2)), 1e-12f);
#pragma unroll
            for (int i = 0; i < 8; ++i) { kn[i] *= inv; kk2[i] *= 1.0f + (bb[i] - 1.0f) * kal[ej + i]; bb[i] *= kn[i]; }
        }
        const u32x4 gw = ld[5];
        REPS(0) {
        float cum[8];
#pragma unroll
        for (int i = 0; i < 8; ++i) cum[i] = ee[i];
#pragma unroll
        for (int o = 8; o < 64; o <<= 1) {
#pragma unroll
            for (int i = 0; i < 8; ++i) { const float y = __shfl_up(cum[i], o); if (lane >= o) cum[i] += y; } }
        if (lane >= 56) { *(LAS f32x4*)(Wtot + wave * 64 + ej) = (f32x4){cum[0], cum[1], cum[2], cum[3]}; *(LAS f32x4*)(Wtot + wave * 64 + ej + 4) = (f32x4){cum[4], cum[5], cum[6], cum[7]}; }
        __syncthreads();
        {
            float off[8], cumC[8];
#pragma unroll
            for (int i = 0; i < 8; ++i) { off[i] = 0.f; cumC[i] = 0.f; }
#pragma unroll
            for (int w = 0; w < 8; ++w) { const f32x4 a = *(const LAS f32x4*)(Wtot + w * 64 + ej), bq = *(const LAS f32x4*)(Wtot + w * 64 + ej + 4);
                const float tv[8] = {a.x, a.y, a.z, a.w, bq.x, bq.y, bq.z, bq.w};
#pragma unroll
                for (int i = 0; i < 8; ++i) { cumC[i] += tv[i]; off[i] += (w < wave) ? tv[i] : 0.f; } }
            float bsum = 0.f;
            unsigned pkt[4], prt[4], pkh[4], pbh[4], pkg[4], pbg[4], pvn[4]; float okt[8], ort[8], okh[8], obh[8], okg[8], obg[8];
#pragma unroll
            for (int i = 0; i < 8; ++i) {
                const float cm = cum[i] + off[i], cc = cumC[i];
                const float g = __expf(-cm), gp = __expf(ee[i] - cm), gi = __expf(cm), gc = __expf(cm - cc);
                okt[i] = kn[i] * gp; ort[i] = rr[i] * g; okh[i] = kk2[i] * gi; obh[i] = bb[i] * gi; okg[i] = kk2[i] * gc; obg[i] = bb[i] * gc;
                if (et == 63) gCv[ej + i] = __expf(-cc);
                bsum += rr[i] * kk2[i] * rkl[ej + i];
            }
#pragma unroll
            for (int i = 0; i < 4; ++i) { pkt[i] = pk2(okt[2 * i], okt[2 * i + 1]); prt[i] = pk2(ort[2 * i], ort[2 * i + 1]); pkh[i] = pk2(okh[2 * i], okh[2 * i + 1]); pbh[i] = pk2(obh[2 * i], obh[2 * i + 1]);
                pkg[i] = pk2(okg[2 * i], okg[2 * i + 1]); pbg[i] = pk2(obg[2 * i], obg[2 * i + 1]); pvn[i] = pk2(vv[2 * i], vv[2 * i + 1]); }
            *(LAS u32x4*)(Kt + et * CP + ej) = (u32x4){pkt[0], pkt[1], pkt[2], pkt[3]}; *(LAS u32x4*)(Rt + et * CP + ej) = (u32x4){prt[0], prt[1], prt[2], prt[3]};
            *(LAS u32x4*)(Kh + et * CP + ej) = (u32x4){pkh[0], pkh[1], pkh[2], pkh[3]}; *(LAS u32x4*)(Bh + et * CP + ej) = (u32x4){pbh[0], pbh[1], pbh[2], pbh[3]};
            *(LAS u32x4*)(CMAT(9) + et * CP + ej) = (u32x4){pkg[0], pkg[1], pkg[2], pkg[3]}; *(LAS u32x4*)(CMAT(10) + et * CP + ej) = (u32x4){pbg[0], pbg[1], pbg[2], pbg[3]};
            *(LAS u32x4*)(CMAT(11) + et * CP + ej) = (u32x4){pvn[0], pvn[1], pvn[2], pvn[3]};
            bsum = red8(bsum);
            if ((tid & 7) == 0) bonv[et] = bsum;
        }
        __syncthreads();
        {
            const int tj = tid & 63, tb = 8 * (tid >> 6);
#pragma unroll
            for (int mtx = 0; mtx < 3; ++mtx) {
                const LAS bf16* src = CMAT(9 + mtx); LAS bf16* dst = CMAT(4 + mtx); unsigned e[8];
#pragma unroll
                for (int i = 0; i < 8; ++i) e[i] = src[(tb + i) * CP + tj];
                *(LAS u32x4*)(dst + tj * CP + tb) = (u32x4){e[0] | (e[1] << 16), e[2] | (e[3] << 16), e[4] | (e[5] << 16), e[6] | (e[7] << 16)};
            }
        }
        __syncthreads();
        }
        if (c + 1 < SEQ / 64) issue(c + 1);
        const f32x4 z4 = (f32x4){0.f, 0.f, 0.f, 0.f};
        REPS(1) {
#pragma unroll
        for (int tt = 0; tt < 2; ++tt) {
            const int m0 = tm0, n0 = tn0 + 16 * tt;
            f32x4 a1 = z4, a2 = z4, a3 = z4, a4 = z4, a5 = z4;
            if (m0 <= n0) { a1 = mm_tile(Kh, Kt, m0, n0, fr, fq, z4); a2 = mm_tile(Bh, Kt, m0, n0, fr, fq, z4); a4 = mm_tile(Kh, Rt, m0, n0, fr, fq, z4); a5 = mm_tile(Bh, Rt, m0, n0, fr, fq, z4); }
            if (m0 >= n0) a3 = mm_tile(Kt, Bh, m0, n0, fr, fq, z4);
#pragma unroll
            for (int r = 0; r < 4; ++r) { const int mi = m0 + 4 * fq + r, ni = n0 + fr;
                if (!(mi < ni)) { a1[r] = 0.f; a2[r] = 0.f; } if (!(mi <= ni)) { a4[r] = 0.f; a5[r] = 0.f; } if (!(ni < mi)) a3[r] = 0.f; }
            tstore(Akk, m0, n0, fr, fq, a1); tstore(Lm, m0, n0, fr, fq, a2); tstore(LT, m0, n0, fr, fq, a3); tstore(Ark, m0, n0, fr, fq, a4); tstore(Arb, m0, n0, fr, fq, a5);
        }
        __syncthreads();
        }
        REPS(2) {
            LAS bf16* Pw = CMAT(2); LAS bf16* PwT = CMAT(3); LAS bf16* Tm = CMAT(12);
#pragma unroll
            for (int tt = 0; tt < 2; ++tt) { const int m0 = tm0, n0 = tn0 + 16 * tt;
                const f32x4 p2 = mm_tile(Lm, LT, m0, n0, fr, fq, z4); tstore(PwT, m0, n0, fr, fq, p2); nstore(Pw, m0, n0, fr, fq, p2); }
            const u32x4 lw = *(const LAS u32x4*)(Lm + et * CP + ej); const unsigned lwa[4] = {lw.x, lw.y, lw.z, lw.w}; unsigned o[4];
#pragma unroll
            for (int i = 0; i < 4; ++i) { const float x0 = ((ej + 2 * i) == et ? 1.f : 0.f) - lo16(lwa[i]), x1 = ((ej + 2 * i + 1) == et ? 1.f : 0.f) - hi16(lwa[i]); o[i] = pk2(x0, x1); }
            *(LAS u32x4*)(Tm + et * CP + ej) = (u32x4){o[0], o[1], o[2], o[3]};
        __syncthreads();
        }
        REPS(3)
#pragma unroll 1
        for (int sidx = 0; sidx < 5; ++sidx) {
            LAS bf16* Pw = CMAT((sidx & 1) ? 8 : 2); LAS bf16* PwT = CMAT((sidx & 1) ? 9 : 3); LAS bf16* PwN = CMAT((sidx & 1) ? 2 : 8); LAS bf16* PwNT = CMAT((sidx & 1) ? 3 : 9);
            LAS bf16* Tm = CMAT(12 + (sidx & 1)); LAS bf16* TmN = CMAT(13 - (sidx & 1));
            const LAS bf16* fa = PwT + (tm0 + fr) * CP + 8 * fq; const LAS bf16* fb = Pw + (tm0 + fr) * CP + 8 * fq;
            const bf16x8 aT0 = *(const LAS bf16x8*)fa, aT1 = *(const LAS bf16x8*)(fa + 32), aP0 = *(const LAS bf16x8*)fb, aP1 = *(const LAS bf16x8*)(fb + 32);
            bf16x8 bT[2][2], bP[2][2]; u32x2 tw[2];
#pragma unroll
            for (int tt = 0; tt < 2; ++tt) { const int n0 = tn0 + 16 * tt;
                const LAS bf16* ft = Tm + (n0 + fr) * CP + 8 * fq; const LAS bf16* fp = PwT + (n0 + fr) * CP + 8 * fq;
                bT[tt][0] = *(const LAS bf16x8*)ft; bT[tt][1] = *(const LAS bf16x8*)(ft + 32); bP[tt][0] = *(const LAS bf16x8*)fp; bP[tt][1] = *(const LAS bf16x8*)(fp + 32);
                tw[tt] = *(const LAS u32x2*)(Tm + (n0 + fr) * CP + tm0 + 4 * fq); }
            f32x4 at[2], pt[2];
#pragma unroll
            for (int tt = 0; tt < 2; ++tt) {
                at[tt] = __builtin_amdgcn_mfma_f32_16x16x32_bf16(aT0, bT[tt][0], z4, 0, 0, 0); pt[tt] = __builtin_amdgcn_mfma_f32_16x16x32_bf16(aP0, bP[tt][0], z4, 0, 0, 0); }
#pragma unroll
            for (int tt = 0; tt < 2; ++tt) {
                at[tt] = __builtin_amdgcn_mfma_f32_16x16x32_bf16(aT1, bT[tt][1], at[tt], 0, 0, 0); pt[tt] = __builtin_amdgcn_mfma_f32_16x16x32_bf16(aP1, bP[tt][1], pt[tt], 0, 0, 0); }
#pragma unroll
            for (int tt = 0; tt < 2; ++tt) { const int m0 = tm0, n0 = tn0 + 16 * tt;
                at[tt][0] += lo16(tw[tt].x); at[tt][1] += hi16(tw[tt].x); at[tt][2] += lo16(tw[tt].y); at[tt][3] += hi16(tw[tt].y);
                tstore(TmN, m0, n0, fr, fq, at[tt]); tstore(PwNT, m0, n0, fr, fq, pt[tt]); nstore(PwN, m0, n0, fr, fq, pt[tt]);
            }
            __syncthreads();
        }
        LAS bf16* TmF = CMAT(13);
        LAS bf16* UT = CMAT(8); LAS bf16* SAT = CMAT(9);
        REPS(4) {
#pragma unroll
        for (int tt = 0; tt < 2; ++tt) { const int m0 = tm0, n0 = tn0 + 16 * tt;
            f32x4 a = mm_tile(Kt, S0c, m0, n0, fr, fq, z4); a = mm_tile(Akk, VT, m0, n0, fr, fq, a); tstore(UT, m0, n0, fr, fq, a); }
        __syncthreads();
        }
        REPS(5) {
#pragma unroll
        for (int tt = 0; tt < 2; ++tt) { const int m0 = tm0, n0 = tn0 + 16 * tt; tstore(SAT, m0, n0, fr, fq, mm_tile(TmF, UT, m0, n0, fr, fq, z4)); }
        __syncthreads();
        }
        REPS(6) {
#pragma unroll
        for (int tt = 0; tt < 2; ++tt) { const int m0 = tm0, n0 = tn0 + 16 * tt;
            f32x4 y = mm_tile(Rt, S0c, m0, n0, fr, fq, z4); y = mm_tile(Ark, VT, m0, n0, fr, fq, y); const f32x4 y2 = mm_tile(Arb, SAT, m0, n0, fr, fq, z4);
#pragma unroll
            for (int r = 0; r < 4; ++r) Ybuf[(m0 + 4 * fq + r) * 64 + n0 + fr] = y[r] - y2[r];
            f32x4 sn = mm_tile(KgT, VT, m0, n0, fr, fq, z4); const f32x4 s2 = mm_tile(BgT, SAT, m0, n0, fr, fq, z4);
            const f32x4 gc4 = *(const LAS f32x4*)(gCv + m0 + 4 * fq);
            sn = gc4 * Sreg[tt] + sn - s2; Sreg[tt] = sn;
        }
        __syncthreads();
#pragma unroll
        for (int tt = 0; tt < 2; ++tt) tstore(S0c, tm0, tn0 + 16 * tt, fr, fq, Sreg[tt]);
        }
        REPS(7) {
            const f32x4 ya = *(const LAS f32x4*)(Ybuf + et * 64 + ej), yb = *(const LAS f32x4*)(Ybuf + et * 64 + ej + 4);
            float y[8] = {ya.x, ya.y, ya.z, ya.w, yb.x, yb.y, yb.z, yb.w};
            float sm = 0.f;
#pragma unroll
            for (int i = 0; i < 8; ++i) sm += y[i];
            const float mean = red8(sm) * (1.f / 64.f); float sq = 0.f;
#pragma unroll
            for (int i = 0; i < 8; ++i) { y[i] -= mean; sq += y[i] * y[i]; }
            const float rs = 1.0f / sqrtf(red8(sq) * (1.f / 64.f) + 64e-5f);
            const float bon = bonv[et];
            const size_t mrow = mbase + 64 * c + et;
            const unsigned gwa[4] = {gw.x, gw.y, gw.z, gw.w};
            unsigned o[4];
#pragma unroll
            for (int i = 0; i < 4; ++i) {
                const float o0 = ((y[2 * i] * rs) * lwl[ej + 2 * i] + lbl[ej + 2 * i] + vv[2 * i] * bon) * lo16(gwa[i]), o1 = ((y[2 * i + 1] * rs) * lwl[ej + 2 * i + 1] + lbl[ej + 2 * i + 1] + vv[2 * i + 1] * bon) * hi16(gwa[i]);
                o[i] = pk2(o0, o1); }
            *(u32x4*)(YC + mrow * 1024 + h * 64 + ej) = (u32x4){o[0], o[1], o[2], o[3]};
        }
    }
    __syncthreads();
}

__device__ __forceinline__ unsigned sortable(float f) { const unsigned u = __float_as_uint(f); return (u & 0x80000000u) ? ~u : (u | 0x80000000u); }
#define MFMA32(a, b, c) __builtin_amdgcn_mfma_f32_32x32x16_bf16((a), (b), (c), 0, 0, 0)
__device__ __forceinline__ int wave_sum_i(int v) {
    v += __builtin_amdgcn_update_dpp(0, v, 0xB1, 0xF, 0xF, true);
    v += __builtin_amdgcn_update_dpp(0, v, 0x4E, 0xF, 0xF, true);
    v += __builtin_amdgcn_update_dpp(0, v, 0x141, 0xF, 0xF, true);
    v += __builtin_amdgcn_update_dpp(0, v, 0x140, 0xF, 0xF, true);
    v += __builtin_amdgcn_update_dpp(0, v, 0x142, 0xA, 0xF, true);
    v += __builtin_amdgcn_update_dpp(0, v, 0x143, 0xC, 0xF, true);
    return __builtin_amdgcn_readlane(v, 63);
}
__device__ __forceinline__ int wave_prefix_i(int v) {
    v += __builtin_amdgcn_update_dpp(0, v, 0x111, 0xF, 0xF, false);
    v += __builtin_amdgcn_update_dpp(0, v, 0x112, 0xF, 0xF, false);
    v += __builtin_amdgcn_update_dpp(0, v, 0x114, 0xF, 0xF, false);
    v += __builtin_amdgcn_update_dpp(0, v, 0x118, 0xF, 0xF, false);
    v += __builtin_amdgcn_update_dpp(0, v, 0x142, 0xA, 0xF, false);
    v += __builtin_amdgcn_update_dpp(0, v, 0x143, 0xC, 0xF, false);
    return v;
}
constexpr int HWORDS = 2368;
template <int NR>
__device__ __forceinline__ void radix_pass(const unsigned (&k)[NR], LAS unsigned* H, int lane, int shift, unsigned binmask, bool pred, int pshift, unsigned pval, int need, int& Bout, int& above_out, int& inbin_out) {
    const u32x4 z = (u32x4){0u, 0u, 0u, 0u};
#pragma unroll
    for (int q = 0; q < 9; ++q) ((LAS u32x4*)H)[lane + 64 * q] = z;
    asm volatile("" ::: "memory");
#pragma unroll
    for (int i = 0; i < NR; ++i) {
        const unsigned bin = (k[i] >> shift) & binmask; unsigned a = bin + 4u * (bin >> 5);
        if (pred) a = ((k[i] >> pshift) == pval) ? a : (2304u + (unsigned)lane);
        __hip_atomic_fetch_add(H + a, 1u, __ATOMIC_RELAXED, __HIP_MEMORY_SCOPE_WORKGROUP);
    }
    asm volatile("s_waitcnt lgkmcnt(0)" ::: "memory");
    const int blk = 63 - lane;
    int tot = 0;
#pragma unroll
    for (int q = 0; q < 8; ++q) { const u32x4 v = ((const LAS u32x4*)(H + 36 * blk))[q]; tot += (int)(v.x + v.y + v.z + v.w); }
    const int inc = wave_prefix_i(tot);
    const int A = inc - tot;
    const unsigned long long cross = __ballot(A < need && inc >= need);
    const int Ll = __builtin_ctzll(cross);
    const int Aab = __builtin_amdgcn_readlane(A, Ll);
    const int Bblk = 63 - Ll;
    const int h = (lane < 32) ? (int)H[36 * Bblk + 31 - lane] : 0;
    const int inc2 = wave_prefix_i(h);
    const int a2 = inc2 - h;
    const unsigned long long cross2 = __ballot(lane < 32 && (Aab + a2 < need) && (Aab + inc2 >= need));
    const int js = __builtin_ctzll(cross2);
    Bout = 32 * Bblk + 31 - js; above_out = Aab + __builtin_amdgcn_readlane(a2, js); inbin_out = __builtin_amdgcn_readlane(h, js);
}
template <int NR>
__device__ __forceinline__ void radix_pass1(const unsigned (&k)[NR], LAS unsigned* H, int lane, int need, int& Bout, int& above_out, int& inbin_out) {
    const u32x4 z = (u32x4){0u, 0u, 0u, 0u};
#pragma unroll
    for (int q = 0; q < 9; ++q) ((LAS u32x4*)H)[lane + 64 * q] = z;
    asm volatile("" ::: "memory");
#pragma unroll
    for (int i = 0; i < NR; ++i) { const unsigned vb = ((k[i] >> 24) << 3) | (unsigned)(lane & 7); __hip_atomic_fetch_add(H + vb + 4u * (vb >> 5), 1u, __ATOMIC_RELAXED, __HIP_MEMORY_SCOPE_WORKGROUP); }
    asm volatile("s_waitcnt lgkmcnt(0)" ::: "memory");
    const int blk = 63 - lane;
    int tot = 0;
#pragma unroll
    for (int q = 0; q < 8; ++q) { const u32x4 v = ((const LAS u32x4*)(H + 36 * blk))[q]; tot += (int)(v.x + v.y + v.z + v.w); }
    const int inc = wave_prefix_i(tot);
    const int A = inc - tot;
    const unsigned long long cross = __ballot(A < need && inc >= need);
    const int Ll = __builtin_ctzll(cross);
    const int Aab = __builtin_amdgcn_readlane(A, Ll);
    const int Bblk = 63 - Ll;
    int h = 0;
    if (lane < 4) { const LAS u32x4* hp = (const LAS u32x4*)(H + 36 * Bblk + 8 * (3 - lane)); const u32x4 v0 = hp[0], v1 = hp[1]; h = (int)(v0.x + v0.y + v0.z + v0.w + v1.x + v1.y + v1.z + v1.w); }
    const int inc2 = wave_prefix_i(h);
    const int a2 = inc2 - h;
    const unsigned long long cross2 = __ballot(lane < 4 && (Aab + a2 < need) && (Aab + inc2 >= need));
    const int js = __builtin_ctzll(cross2);
    Bout = 4 * Bblk + 3 - js; above_out = Aab + __builtin_amdgcn_readlane(a2, js); inbin_out = __builtin_amdgcn_readlane(h, js);
}
template <int NR>
__device__ __forceinline__ void dsa_select2(const LAS unsigned* SC, LAS unsigned* MK, LAS unsigned* HB, int sub, int wave, int lane, int nk, int pmode) {
    unsigned ka[NR], kb[NR];
    const int qa = 2 * wave, qb2 = 2 * wave + 1;
#pragma unroll
    for (int i = 0; i < NR; ++i) { const int idx = 64 * i + lane; const bool ok = idx < nk; ka[i] = ok ? SC[qa * 2048 + idx] : 0u; kb[i] = ok ? SC[qb2 * 2048 + idx] : 0u; }
    __syncthreads();
    LAS unsigned* H = HB + wave * HWORDS;
#pragma unroll
    for (int which = 0; which < 2; ++which) {
        const unsigned (&k)[NR] = which ? kb : ka;
        unsigned Tt = 0x80000000u; int need = 1;
        if (pmode != 23) {
            int B, ab, cb; unsigned prefix; bool fin = false;
            radix_pass1<NR>(k, H, lane, 256, B, ab, cb);
            need = 256 - ab; prefix = (unsigned)B;
            if (need == cb && prefix != 0u) { Tt = (prefix << 24) - 1u; need = 0; fin = true; }
            if (!fin) { radix_pass<NR>(k, H, lane, 13, 2047u, true, 24, prefix, need, B, ab, cb);
                need -= ab; prefix = (prefix << 11) | (unsigned)B;
                if (need == cb) { Tt = (prefix << 13) - 1u; need = 0; fin = true; } }
            if (!fin) { radix_pass<NR>(k, H, lane, 2, 2047u, true, 13, prefix, need, B, ab, cb);
                need -= ab; prefix = (prefix << 11) | (unsigned)B;
                if (need == cb) { Tt = (prefix << 2) - 1u; need = 0; fin = true; } }
            if (!fin) { radix_pass<NR>(k, H, lane, 0, 3u, true, 2, prefix, need, B, ab, cb);
                need -= ab; Tt = (prefix << 2) | (unsigned)B; }
        }
        if (pmode != 22) {
        LAS unsigned long long* mrow = (LAS unsigned long long*)(MK + (16 * sub + 2 * wave + which) * 64);
#pragma unroll
        for (int i = 0; i < NR; ++i) {
            const unsigned kvv = k[i];
            const unsigned long long gt = __ballot(kvv > Tt), eq = __ballot(kvv == Tt);
            const int ne = __builtin_popcountll(eq);
            unsigned long long take;
            if (ne <= need) { take = eq; need -= ne; }
            else { take = 0ull; unsigned long long e2 = eq; for (int z = 0; z < need; ++z) { const unsigned long long lb = e2 & (~e2 + 1ull); take |= lb; e2 ^= lb; } need = 0; }
            if (lane == 0) mrow[i] = gt | take;
        }
        if (lane >= NR && lane < 32) mrow[lane] = 0ull;
        }
    }
}
__device__ __forceinline__ void dsa_unit(LAS unsigned char* lds, int b, int qb, const unsigned char* ws, const float* at_out_g, int tid, int lane, int wave, int pmode) {
    const bf16* P = (const bf16*)(ws + WS_P); const bf16* VF = (const bf16*)(ws + WS_VF); const bf16* KF = (const bf16*)(ws + WS_KF); const bf16* KIF = (const bf16*)(ws + WS_KIF); bf16* YC = (bf16*)(ws + WS_H);
    asm volatile("" : "+v"(tid), "+v"(lane));
    const int t0 = qb * 32, nk = t0 + 32, nkt = nk >> 5;
    LAS unsigned* SC = (LAS unsigned*)lds;
    LAS unsigned* MK = (LAS unsigned*)(lds + MASK_OFF);
    const size_t rowbase = (size_t)b * SEQ;
    const int l32 = lane & 31, hi = lane >> 5;
    f32x16 zero16;
#pragma unroll
    for (int i = 0; i < 16; ++i) zero16[i] = 0.f;
    if (qb >= 8 && pmode != 4) {
        for (int sub = 0; sub < 2; ++sub) {
            if (pmode != 6) {
            bf16x8 aq[2][4]; float wq[2][4][4];
#pragma unroll
            for (int mt = 0; mt < 2; ++mt) {
#pragma unroll
                for (int s = 0; s < 4; ++s) aq[mt][s] = *(const bf16x8*)(P + (rowbase + t0 + 16 * sub + 8 * mt + (l32 & 7)) * NP + C_QI + (l32 >> 3) * 64 + 16 * s + 8 * hi);
#pragma unroll
                for (int j = 0; j < 4; ++j) { const u32x2 w = *(const u32x2*)(P + (rowbase + t0 + 16 * sub + 8 * mt + 4 * hi + j) * NP + C_WI);
                    wq[mt][j][0] = lo16(w.x) * 0.0625f; wq[mt][j][1] = hi16(w.x) * 0.0625f; wq[mt][j][2] = lo16(w.y) * 0.0625f; wq[mt][j][3] = hi16(w.y) * 0.0625f; }
            }
            bf16x8 bkA[4], bkB[4];
#define SC_LOAD(BK_, kt_) do { const int _kt = (kt_) < nkt ? (kt_) : nkt - 1; \
                _Pragma("unroll") for (int s = 0; s < 4; ++s) BK_[s] = *(const bf16x8*)(KIF + ((((size_t)b * 64 + _kt) * 4 + s) * 64 + lane) * 8); } while (0)
#define SC_STEP(BK_, kt_) do { const bool _ok = (kt_) < nkt; { \
                _Pragma("unroll") for (int mt = 0; mt < 2; ++mt) { \
                    f32x16 acc = zero16; \
                    _Pragma("unroll") for (int s = 0; s < 4; ++s) acc = MFMA32(aq[mt][s], BK_[s], acc); \
                    _Pragma("unroll") for (int j = 0; j < 4; ++j) { \
                        float sc = 0.f; \
                        _Pragma("unroll") for (int g = 0; g < 4; ++g) sc += wq[mt][j][g] * fmaxf(acc[4 * g + j], 0.f); \
                        const int ql = 8 * mt + 4 * hi + j, tq = t0 + 16 * sub + ql, key = 32 * (kt_) + l32; \
                        unsigned u = sortable(sc); if (key > tq) u = 0u; \
                        if (_ok) SC[ql * 2048 + key] = u; } } } } while (0)
            for (int _rp = 0; _rp < (pmode == 20 ? 5 : 1); ++_rp) {
            SC_LOAD(bkA, wave);
            for (int kt = wave; kt < nkt; kt += 16) {
                SC_LOAD(bkB, kt + 8); __builtin_amdgcn_sched_barrier(0); SC_STEP(bkA, kt);
                SC_LOAD(bkA, kt + 16); __builtin_amdgcn_sched_barrier(0); SC_STEP(bkB, kt + 8);
            }
            }
#undef SC_LOAD
#undef SC_STEP
            }
            __syncthreads();
            if (pmode != 5) { const int nr8 = (nk + 511) >> 9;
              if (nr8 == 1) dsa_select2<8>(SC, MK, SC, sub, wave, lane, nk, pmode); else if (nr8 == 2) dsa_select2<16>(SC, MK, SC, sub, wave, lane, nk, pmode);
              else if (nr8 == 3) dsa_select2<24>(SC, MK, SC, sub, wave, lane, nk, pmode); else dsa_select2<32>(SC, MK, SC, sub, wave, lane, nk, pmode); }
            __syncthreads();
        }
    } else {
        for (int idx = tid; idx < 32 * 64; idx += 512) { const int qq = idx >> 6, w = idx & 63, tq = t0 + qq, lo = 32 * w;
            const unsigned m = (lo + 31 <= tq) ? 0xffffffffu : (lo > tq ? 0u : ((1u << (tq - lo + 1)) - 1u)); MK[idx] = m; }
        __syncthreads();
    }
    if (pmode != 3 && pmode != 5 && pmode != 6 && pmode < 20) {
        const int hd = wave;
        bf16x8 qf[4];
#pragma unroll
        for (int s = 0; s < 4; ++s) qf[s] = *(const bf16x8*)(P + (rowbase + t0 + l32) * NP + C_Q + 64 * hd + 16 * s + 8 * hi);
        f32x16 o0 = zero16, o1 = zero16; float lrun = 0.f;
        const bf16* Kb = KF + ((size_t)(b * 8 + hd) * 64) * 4 * 64 * 8 + (size_t)lane * 8;
        const bf16* Vb = VF + ((size_t)(b * 8 + hd) * 64) * 4 * 64 * 8 + (size_t)lane * 8;
        bf16x8 kf0[4], kf1[4], vf0[2][2], vf1[2][2];
#define ATT_LOAD(KF_, VF_, kt_) do { const int _kt = (kt_) < nkt ? (kt_) : nkt - 1; \
            _Pragma("unroll") for (int s = 0; s < 4; ++s) KF_[s] = *(const bf16x8*)(Kb + ((size_t)_kt * 4 + s) * 512); \
            _Pragma("unroll") for (int dt = 0; dt < 2; ++dt) _Pragma("unroll") for (int s2 = 0; s2 < 2; ++s2) VF_[dt][s2] = *(const bf16x8*)(Vb + (((size_t)_kt * 2 + dt) * 2 + s2) * 512); } while (0)
#define ATT_STEP(KF_, VF_, kt_) do { \
            f32x16 sacc = zero16; \
            _Pragma("unroll") for (int s = 0; s < 4; ++s) sacc = MFMA32(KF_[s], qf[s], sacc); \
            const int _kc = (kt_) < nkt ? (kt_) : nkt - 1; \
            unsigned mw = MK[l32 * 64 + _kc] >> (4 * hi); mw = ((kt_) < nkt) ? mw : 0u;     \
            float pv[16]; \
            _Pragma("unroll") for (int r = 0; r < 16; ++r) { const int sb = ((int)(mw << (31 - (8 * (r >> 2) + (r & 3))))) >> 31; \
                pv[r] = __int_as_float(__float_as_int(__builtin_amdgcn_exp2f(sacc[r])) & sb); lrun += pv[r]; } \
            bf16x8 pf[2]; \
            _Pragma("unroll") for (int s2 = 0; s2 < 2; ++s2) { u32x4 t; t.x = pk2(pv[8 * s2], pv[8 * s2 + 1]); t.y = pk2(pv[8 * s2 + 2], pv[8 * s2 + 3]); t.z = pk2(pv[8 * s2 + 4], pv[8 * s2 + 5]); t.w = pk2(pv[8 * s2 + 6], pv[8 * s2 + 7]); pf[s2] = __builtin_bit_cast(bf16x8, t); } \
            _Pragma("unroll") for (int s2 = 0; s2 < 2; ++s2) { o0 = MFMA32(VF_[0][s2], pf[s2], o0); o1 = MFMA32(VF_[1][s2], pf[s2], o1); } } while (0)
        ATT_LOAD(kf0, vf0, 0);
        for (int kt = 0; kt < nkt; kt += 2) {
            ATT_LOAD(kf1, vf1, kt + 1); __builtin_amdgcn_sched_barrier(0); ATT_STEP(kf0, vf0, kt);
            ATT_LOAD(kf0, vf0, kt + 2); __builtin_amdgcn_sched_barrier(0); ATT_STEP(kf1, vf1, kt + 1);
        }
#undef ATT_LOAD
#undef ATT_STEP
        lrun += __shfl_xor(lrun, 32);
        const float inv = 1.0f / lrun;
        float ss = 0.f;
#pragma unroll
        for (int r = 0; r < 16; ++r) { o0[r] *= inv; o1[r] *= inv; ss += o0[r] * o0[r] + o1[r] * o1[r]; }
        ss += __shfl_xor(ss, 32);
        const float rs = 1.0f / sqrtf(ss * (1.f / 64.f) + 1e-6f);
        bf16* orow = YC + (rowbase + t0 + l32) * 1024 + 512 + 64 * hd;
        f32x4 ogv[2][4];
#pragma unroll
        for (int dt = 0; dt < 2; ++dt)
#pragma unroll
            for (int g = 0; g < 4; ++g) ogv[dt][g] = *(const f32x4*)(at_out_g + hd * 64 + 32 * dt + 8 * g + 4 * hi);
#pragma unroll
        for (int dt = 0; dt < 2; ++dt)
#pragma unroll
            for (int g = 0; g < 4; ++g) { const int d = 32 * dt + 8 * g + 4 * hi; const f32x4 og = ogv[dt][g];
                float v0, v1, v2, v3;
                if (dt == 0) { v0 = o0[4 * g]; v1 = o0[4 * g + 1]; v2 = o0[4 * g + 2]; v3 = o0[4 * g + 3]; } else { v0 = o1[4 * g]; v1 = o1[4 * g + 1]; v2 = o1[4 * g + 2]; v3 = o1[4 * g + 3]; }
                u32x2 w; w.x = pk2(v0 * rs * og.x, v1 * rs * og.y); w.y = pk2(v2 * rs * og.z, v3 * rs * og.w);
                *(u32x2*)(orow + d) = w; }
    }
    __syncthreads();
}

__device__ __forceinline__ void moe_tables(LAS int* tab, const unsigned* ctl, int tid) {
    LAS int* cnt = tab; LAS int* cum = tab + 260; LAS int* tcum = tab + 520;
    if (tid < 64) {
        int c[4], tl[4]; int sc = 0, stl = 0;
#pragma unroll
        for (int i = 0; i < 4; ++i) { c[i] = (int)__hip_atomic_load(ctl + CW_CNT + 4 * tid + i, __ATOMIC_RELAXED, __HIP_MEMORY_SCOPE_AGENT); tl[i] = (c[i] + 255) >> 8; sc += c[i]; stl += tl[i]; }
        int ic = sc, it = stl;
#pragma unroll
        for (int o = 1; o < 64; o <<= 1) { const int a = __shfl_up(ic, o), bq = __shfl_up(it, o); if (tid >= o) { ic += a; it += bq; } }
        int ec = ic - sc, et = it - stl;
#pragma unroll
        for (int i = 0; i < 4; ++i) { cnt[4 * tid + i] = c[i]; cum[4 * tid + i] = ec; tcum[4 * tid + i] = et; ec += c[i]; et += tl[i]; }
        if (tid == 63) { cnt[256] = T; cum[256] = T * 8; tcum[256] = et; tcum[257] = et + T / 256; cum[257] = T * 8 + T; }
    }
    __syncthreads();
    LAS unsigned short* t2e = (LAS unsigned short*)(tab + 800);
    if (tid <= 256) { const int t0 = tcum[tid], t1 = tcum[tid + 1]; for (int j = t0; j < t1; ++j) t2e[j] = (unsigned short)tid; }
    __syncthreads();
}
__device__ __forceinline__ int find_expert(const LAS int* tcum, int tile) {
    return (int)((const LAS unsigned short*)(tcum - 520 + 800))[tile];
}
struct LdsGather {
    static constexpr bool GATHER = true;
    const LAS unsigned* tabl;
    __device__ __forceinline__ unsigned rowoff(int ui, int r) const { return tabl[ui * 256 + r]; }
};
struct Fc1Order {
    const LAS int* tab; int total, G, c;
    __device__ bool next(int i, pg8::Unit& u) const {
        const long L = (long)i * G + c; if (L >= total) return false;
        const int tile = (int)(L >> 1), pn = (int)(L & 1);
        const LAS int* cnt = tab; const LAS int* cum = tab + 260; const LAS int* tcum = tab + 520;
        const int e = __builtin_amdgcn_readfirstlane(find_expert(tcum, tile)), j = tile - __builtin_amdgcn_readfirstlane(tcum[e]);
        u.arow = 0; u.brow = e * 512 + 256 * pn; u.orow = __builtin_amdgcn_readfirstlane(cum[e]) + 256 * j; u.ocol = 128 * pn; const int rem = __builtin_amdgcn_readfirstlane(cnt[e]) - 256 * j; u.nvalid = rem < 256 ? rem : 256; u.aux = 0; return true;
    }
};
struct Fc2Order {
    const LAS int* tab; int total, G, c;
    __device__ bool next(int i, pg8::Unit& u) const {
        const long L = (long)i * G + c; if (L >= total) return false;
        const int tile = (int)(L >> 2), pn = (int)(L & 3);
        const LAS int* cnt = tab; const LAS int* cum = tab + 260; const LAS int* tcum = tab + 520;
        const int e = __builtin_amdgcn_readfirstlane(find_expert(tcum, tile)), j = tile - __builtin_amdgcn_readfirstlane(tcum[e]);
        u.arow = __builtin_amdgcn_readfirstlane(cum[e]) + 256 * j; u.brow = e * 1024 + 256 * pn; u.orow = u.arow; u.ocol = 256 * pn; const int rem = __builtin_amdgcn_readfirstlane(cnt[e]) - 256 * j; u.nvalid = rem < 256 ? rem : 256; u.aux = 0; return true;
    }
};

constexpr int NPHASE = 14;
__global__ void __launch_bounds__(512, 2) fwd_kernel(Args args) {
    extern __shared__ __attribute__((aligned(16))) unsigned char lds_raw[];
    LAS unsigned char* lds = (LAS unsigned char*)lds_raw;
    volatile LAS unsigned* MISC = (volatile LAS unsigned*)(lds + MISC_OFF);
    const int tid = threadIdx.x, lane = tid & 63, wave = __builtin_amdgcn_readfirstlane(tid >> 6);
    const int G = gridDim.x; const int bx = blockIdx.x; const int vcu = (G % 8 == 0) ? (bx % 8) * (G / 8) + bx / 8 : bx;
    unsigned char* ws = args.ws;
    unsigned* ctl = (unsigned*)(ws + WS_CTL);
    if (tid < 64) MISC[tid] = 0u;
    __syncthreads();
    XcdBarrier bar; bar.bar = ctl + CW_BAR; bar.x = 0; bar.st = nullptr;
    if (!MK_PER_PHASE) bar = xcd_barrier_post(ctl + CW_BAR, MISC + 8);
    const int lo = args.ph_lo, hi = args.ph_hi;
#ifdef PROBE_SUB
#define PMODE (args.probe ? PROBE_SUB : 0)
#else
#define PMODE 0
#endif
#ifndef PHASE_MASK
#define PHASE_MASK 0xffffffffu
#endif
#define IN(k) (((PHASE_MASK >> (k)) & 1u) && lo <= (k) && (k) < hi)
#ifndef REPEAT_MASK
#define REPEAT_MASK 0u
#endif
#define NREP(k) (1 + (int)((REPEAT_MASK >> (k)) & 1u))
#define SEAM(k) do { if (IN(k) && IN((k) + 1)) xcd_barrier(bar); } while (0)
    const float* x = args.in[0];
    float* mod = (float*)(ws + WS_MOD);
    const int gw = vcu * 8 + wave, NGW = G * 8;
    const bool conv_split = (G == 256); const int conv_base = conv_split ? 64 : 0;

    if (IN(0)) for (int rep = 0; rep < NREP(0); ++rep) {
        __syncthreads();
        if (vcu < 192) {
            LAS float* cact = (LAS float*)lds;
            const float* c = args.in[1];
            { float cv[32];
#pragma unroll
              for (int j = 0; j < 32; ++j) cv[j] = c[tid + 512 * j];
              __builtin_amdgcn_sched_barrier(0);
#pragma unroll
              for (int j = 0; j < 32; ++j) { const int i = tid + 512 * j, b = i >> 10, k = i & 1023; cact[k * 16 + b] = cv[j] / (1.0f + __expf(-cv[j])); } }
            __syncthreads();
            const float* w_ada = args.in[3]; const float* b_ada = args.in[4];
            const int j0 = vcu * 32, col = lane & 31, kh = lane >> 5;
            float acc[16];
#pragma unroll
            for (int b = 0; b < 16; ++b) acc[b] = 0.f;
#pragma unroll 8
            for (int kk = 0; kk < 64; ++kk) { const int k = 128 * wave + 2 * kk + kh; const float wv = w_ada[(size_t)k * 6144 + j0 + col];
                const LAS f32x4* cp = (const LAS f32x4*)(cact + k * 16);
#pragma unroll
                for (int q4 = 0; q4 < 4; ++q4) { const f32x4 cv = cp[q4]; acc[4 * q4] += cv.x * wv; acc[4 * q4 + 1] += cv.y * wv; acc[4 * q4 + 2] += cv.z * wv; acc[4 * q4 + 3] += cv.w * wv; } }
            LAS float* part = (LAS float*)(lds + 65536);
#pragma unroll
            for (int b = 0; b < 16; ++b) { const float v = acc[b] + __shfl_xor(acc[b], 32); if (lane < 32) part[(wave * 16 + b) * 32 + col] = v; }
            __syncthreads();
            { const int b = tid >> 5, cc = tid & 31; float s = b_ada[j0 + cc];
#pragma unroll
              for (int w = 0; w < 8; ++w) s += part[(w * 16 + b) * 32 + cc];
              mod[(size_t)b * 6144 + j0 + cc] = s; }
            __syncthreads();
        }
        {
            bf16* WLT = (bf16*)(ws + WS_WLT); const float* w2 = args.in[10]; const float* a2 = args.in[12]; const float* g2 = args.in[13];
            for (int idx = vcu * 512 + tid; idx < 1536 * 256; idx += G * 512) { const int n = idx >> 8, k = idx & 255, br = n >> 9, c = n & 511; float v = 0.f;
                if (br == 0) { if (k < 64) v = w2[k * 512 + c]; } else if (br == 1) { if (k >= 64 && k < 128) v = a2[(k - 64) * 512 + c]; } else { if (k >= 128) v = g2[(k - 128) * 512 + c]; }
                WLT[idx] = (bf16)f2bf(v); }
        }
        LAS float* scr = (LAS float*)(lds + wave * 16640);
        constexpr int I_IN = 16 * 60, I_OUT = 16 * 16, I_R = 16 * 4, I_SMALL = I_IN + I_OUT + I_R, I_E = 192, NITEMS = I_SMALL + 257 * I_E;
#ifndef CONV_IN_P5
#define CONV_IN_P5 1
#endif
        const bool p0_split = CONV_IN_P5 && G == 256;
        for (int it = p0_split ? ((vcu >= 192) ? (vcu - 192) * 8 + wave : NITEMS) : gw; it < (CONV_IN_P5 ? I_SMALL : NITEMS); it += p0_split ? 512 : NGW) {
            int r = it;
            if (r < I_IN) { const int kb = r / 60, nb = r % 60; p0_transpose_item(args.in[7], 1024, IN_COLS, (bf16*)(ws + WS_WINT), 64 * nb, 64 * kb, 64 * nb, scr, lane); continue; } r -= I_IN;
            if (r < I_OUT) { const int kb = r / 16, nb = r % 16; p0_transpose_item(args.in[24], 1024, 1024, (bf16*)(ws + WS_WOUTT), 64 * nb, 64 * kb, 64 * nb, scr, lane); continue; } r -= I_OUT;
            if (r < I_R) { const int kb = r / 4, nb = r % 4; p0_transpose_item(args.in[25], 1024, 256, (bf16*)(ws + WS_WRT), 64 * nb, 64 * kb, 64 * nb, scr, lane); continue; } r -= I_R;
            p0_expert_item(args, ws, r / I_E, r % I_E, scr, lane);
        }
    }
    SEAM(0);
    if (IN(1)) for (int rep = 0; rep < NREP(1); ++rep) {
        bf16* H = (bf16*)(ws + WS_H);
        for (int m = gw * 16; m < T; m += NGW * 16) { const int b = m / SEQ; const float* mb = mod + (size_t)b * 6144; norm_mod_rows16(x + (size_t)m * DM, args.in[5], mb, mb + 1024, H + (size_t)m * DM, lane); }
    }
    SEAM(1);
    if (IN(2)) for (int rep = 0; rep < NREP(2); ++rep) {
        pg8::Gemm g{(const bf16*)(ws + WS_H), (const bf16*)(ws + WS_WINT), 1024}; pg8::StaticOrder S; S.init(T, NP, G, bx);
        pg8::EpiBf16 E{(bf16*)(ws + WS_P), NP, 0};
        pg8::gemm_phase<pg8::EpiBf16, pg8::StaticOrder, true, true, pg8::NoGather>(lds, g, S, E, pg8::NoGather{});
        if (conv_split && bx >= 128) {
            __syncthreads();
            const int un = bx - 128; int ln = lane; asm volatile("" : "+v"(ln));
            p0_expert_wave(args, ws, un / 6, 32 * (un % 6), 32 * (un % 6) + 32, wave, (LAS float*)(lds + wave * 16640), ln);
        }
    }
    SEAM(2);
    if (IN(3)) for (int rep = 0; rep < NREP(3); ++rep) {
        bf16* P = (bf16*)(ws + WS_P);
        bf16* XR = (bf16*)(ws + WS_XR); bf16* XK = (bf16*)(ws + WS_XK); bf16* XV = (bf16*)(ws + WS_XV); bf16* KKN = (bf16*)(ws + WS_KKN); bf16* LORA = (bf16*)(ws + WS_LORA); bf16* VF = (bf16*)(ws + WS_VF); bf16* KF = (bf16*)(ws + WS_KF); bf16* KIF = (bf16*)(ws + WS_KIF);
        const float* mu = args.in[8]; const float* k_k = args.in[14]; const int* positions = (const int*)args.in[2];
        const float* qg = args.in[19]; const float* kg = args.in[20]; const float* ilw = args.in[21]; const float* ilb = args.in[22];
        LAS bf16* vbuf = (LAS bf16*)lds;
        float mu0[8], mu1[8], mu2[8], mu3[8], kkc[8], g1[8], g2[8], frq[8];
        const int ri = lane & 3;
#pragma unroll
        for (int i = 0; i < 8; ++i) { mu0[i] = mu[8 * lane + i]; mu1[i] = mu[512 + 8 * lane + i]; mu2[i] = mu[1024 + 8 * lane + i]; mu3[i] = (lane < 32) ? mu[1536 + 8 * lane + i] : 0.f;
            kkc[i] = k_k[8 * lane + i]; const float* gsrc = (lane < 32) ? qg : kg; g1[i] = gsrc[8 * ri + i]; g2[i] = gsrc[32 + 8 * ri + i];
            frq[i] = exp2f(-(float)(8 * ri + i) * (13.287712379549449f / 32.0f)) * 0.15915494309189535f; }
        struct Tok { u32x4 c0, c1, c2, c3, p0, p1, p2, p3, qa, qb, va, ia, ib; float pos; };
        auto load_tok = [&](size_t m, Tok& t) {
            const bf16* prow = P + m * NP; const bool has_prev = (m % SEQ) != 0; const bf16* pp = has_prev ? prow - NP : prow;
            t.c0 = *(const u32x4*)(prow + 8 * lane); t.c1 = *(const u32x4*)(prow + 512 + 8 * lane); t.c2 = *(const u32x4*)(prow + 1024 + 8 * lane);
            t.p0 = *(const u32x4*)(pp + 8 * lane); t.p1 = *(const u32x4*)(pp + 512 + 8 * lane); t.p2 = *(const u32x4*)(pp + 1024 + 8 * lane);
            if (lane < 32) { t.c3 = *(const u32x4*)(prow + 1536 + 8 * lane); t.p3 = *(const u32x4*)(pp + 1536 + 8 * lane); } else { t.c3 = (u32x4){0u, 0u, 0u, 0u}; t.p3 = t.c3; }
            if (!has_prev) { const u32x4 z = (u32x4){0u, 0u, 0u, 0u}; t.p0 = z; t.p1 = z; t.p2 = z; t.p3 = z; }
            const int qkb = ((lane < 32) ? C_Q : C_K) + 64 * ((lane & 31) >> 2) + 8 * ri;
            t.qa = *(const u32x4*)(prow + qkb); t.qb = *(const u32x4*)(prow + qkb + 32);
            t.va = *(const u32x4*)(prow + C_V + 8 * lane);
            const int ib0 = (lane < 16) ? (C_QI + 64 * (lane >> 2) + 8 * ri) : (C_KI + 8 * ri);
            if (lane < 20) { t.ia = *(const u32x4*)(prow + ib0); t.ib = *(const u32x4*)(prow + ib0 + 32); } else { t.ia = (u32x4){0u, 0u, 0u, 0u}; t.ib = t.ia; }
            t.pos = (float)positions[m];
        };
        auto unpack8 = [&](const u32x4& w, float (&o)[8]) { o[0] = lo16(w.x); o[1] = hi16(w.x); o[2] = lo16(w.y); o[3] = hi16(w.y); o[4] = lo16(w.z); o[5] = hi16(w.z); o[6] = lo16(w.w); o[7] = hi16(w.w); };
        auto pack8 = [&](const float (&o)[8]) { return (u32x4){pk2(o[0], o[1]), pk2(o[2], o[3]), pk2(o[4], o[5]), pk2(o[6], o[7])}; };
        auto proc_tok = [&](size_t m, int tl, const Tok& t) {
            bf16* prow = P + m * NP; const int sq = (int)(m % SEQ), bb = (int)(m / SEQ);
            float c[8], p[8], x[8];
            unpack8(t.c0, c); unpack8(t.p0, p);
#pragma unroll
            for (int i = 0; i < 8; ++i) x[i] = c[i] + (p[i] - c[i]) * mu0[i];
            *(u32x4*)(XR + m * 512 + 8 * lane) = pack8(x);
            unpack8(t.c1, c); unpack8(t.p1, p);
#pragma unroll
            for (int i = 0; i < 8; ++i) x[i] = c[i] + (p[i] - c[i]) * mu1[i];
            *(u32x4*)(XK + m * 512 + 8 * lane) = pack8(x);
            unpack8(t.c2, c); unpack8(t.p2, p);
#pragma unroll
            for (int i = 0; i < 8; ++i) x[i] = c[i] + (p[i] - c[i]) * mu2[i];
            *(u32x4*)(XV + m * 512 + 8 * lane) = pack8(x);
            if (lane < 32) {
                unpack8(t.c3, c); unpack8(t.p3, p);
#pragma unroll
                for (int i = 0; i < 8; ++i) { const float ps = c[i] + (p[i] - c[i]) * mu3[i]; x[i] = (lane < 8) ? tanhf(ps) : ((lane < 16) ? ps : sigmoidf_(ps)); }
                *(u32x4*)(LORA + m * 256 + 8 * lane) = pack8(x);
            }
            float cs[8], sn[8];
#pragma unroll
            for (int i = 0; i < 8; ++i) { float rev = t.pos * frq[i]; rev -= rintf(rev); sn[i] = __builtin_amdgcn_sinf(rev); cs[i] = __builtin_amdgcn_cosf(rev); }
            {
                float x1[8], x2[8]; unpack8(t.qa, x1); unpack8(t.qb, x2);
                float ssq = 0.f;
#pragma unroll
                for (int i = 0; i < 8; ++i) ssq += x1[i] * x1[i] + x2[i] * x2[i];
                ssq += __shfl_xor(ssq, 1); ssq += __shfl_xor(ssq, 2);
                float rstd = 1.0f / sqrtf(ssq * (1.f / 64.f) + 1e-6f); if (lane < 32) rstd *= 0.125f * 1.4426950408889634f;
                float y1[8], y2[8];
#pragma unroll
                for (int i = 0; i < 8; ++i) { const float a = x1[i] * rstd * g1[i], bq = x2[i] * rstd * g2[i]; y1[i] = a * cs[i] - bq * sn[i]; y2[i] = bq * cs[i] + a * sn[i]; }
                const u32x4 o1 = pack8(y1), o2 = pack8(y2);
                if (lane < 32) { const int qkb = C_Q + 64 * (lane >> 2) + 8 * ri; *(u32x4*)(prow + qkb) = o1; *(u32x4*)(prow + qkb + 32) = o2; }
                else {
                    bf16* kfb = KF + (((size_t)(bb * 8 + ((lane - 32) >> 2)) * 64 + (sq >> 5)) * 4) * 512 + (sq & 31) * 8;
                    *(u32x4*)(kfb + ((ri >> 1) * 64 + (ri & 1) * 32) * 8) = o1;
                    *(u32x4*)(kfb + ((2 + (ri >> 1)) * 64 + (ri & 1) * 32) * 8) = o2;
                }
            }
            *(LAS u32x4*)(vbuf + tl * 512 + 8 * lane) = t.va;
            if (lane < 20) {
                float x1[8], x2[8]; unpack8(t.ia, x1); unpack8(t.ib, x2);
                float sm = 0.f;
#pragma unroll
                for (int i = 0; i < 8; ++i) sm += x1[i] + x2[i];
                sm += __shfl_xor(sm, 1); sm += __shfl_xor(sm, 2);
                const bool iski = lane >= 16;
                const float mean = iski ? sm * (1.f / 64.f) : 0.f; float vq = 0.f;
#pragma unroll
                for (int i = 0; i < 8; ++i) { x1[i] -= mean; x2[i] -= mean; vq += x1[i] * x1[i] + x2[i] * x2[i]; }
                vq += __shfl_xor(vq, 1); vq += __shfl_xor(vq, 2);
                const float rstd = iski ? 1.0f / sqrtf(vq * (1.f / 64.f) + 1e-6f) : 1.0f;
                float y1[8], y2[8];
#pragma unroll
                for (int i = 0; i < 8; ++i) { float a = x1[i] * rstd, bq = x2[i] * rstd;
                    if (iski) { a = a * ilw[8 * ri + i] + ilb[8 * ri + i]; bq = bq * ilw[32 + 8 * ri + i] + ilb[32 + 8 * ri + i]; }
                    y1[i] = a * cs[i] - bq * sn[i]; y2[i] = bq * cs[i] + a * sn[i]; }
                const u32x4 o1 = pack8(y1), o2 = pack8(y2);
                if (!iski) { const int ib0 = C_QI + 64 * (lane >> 2) + 8 * ri; *(u32x4*)(prow + ib0) = o1; *(u32x4*)(prow + ib0 + 32) = o2; }
                else {
                    bf16* kfb = KIF + (((size_t)bb * 64 + (sq >> 5)) * 4) * 512 + (sq & 31) * 8;
                    *(u32x4*)(kfb + ((ri >> 1) * 64 + (ri & 1) * 32) * 8) = o1;
                    *(u32x4*)(kfb + ((2 + (ri >> 1)) * 64 + (ri & 1) * 32) * 8) = o2;
                }
            }
        };
        for (int tile = vcu; tile < T / 64; tile += G) {
#pragma unroll 1
            for (int i = 0; i < 8; i += 2) {
                const int tl = wave * 8 + i; const size_t m = (size_t)tile * 64 + tl;
                Tok ta, tb; load_tok(m, ta); load_tok(m + 1, tb);
                proc_tok(m, tl, ta); proc_tok(m + 1, tl + 1, tb);
            }
            __syncthreads();
            {
                const size_t m0 = (size_t)tile * 64; const int b = (int)(m0 / SEQ), s0 = (int)(m0 % SEQ);
                const int h = tid >> 6, d = tid & 63, dt = d >> 5, dl = d & 31;
#pragma unroll
                for (int ktl = 0; ktl < 2; ++ktl)
#pragma unroll
                    for (int s2 = 0; s2 < 2; ++s2)
#pragma unroll
                        for (int hh = 0; hh < 2; ++hh) {
                            const int tb = 32 * ktl + 16 * s2 + 4 * hh; unsigned e[8];
#pragma unroll
                            for (int i = 0; i < 4; ++i) { e[i] = vbuf[(tb + i) * 512 + tid]; e[4 + i] = vbuf[(tb + 8 + i) * 512 + tid]; }
                            u32x4 w; w.x = e[0] | (e[1] << 16); w.y = e[2] | (e[3] << 16); w.z = e[4] | (e[5] << 16); w.w = e[6] | (e[7] << 16);
                            *(u32x4*)(VF + ((((((size_t)(b * 8 + h) * 64 + (s0 >> 5) + ktl) * 2 + dt) * 2 + s2) * 64) + hh * 32 + dl) * 8) = w;
                        }
            }
            __syncthreads();
        }
    }
    SEAM(3);
    if (IN(4)) for (int rep = 0; rep < NREP(4); ++rep) {
        pg8::Gemm g{(const bf16*)(ws + WS_LORA), (const bf16*)(ws + WS_WLT), 256}; pg8::StaticOrder S; S.init(T, 1536, G, bx);
        pg8::EpiLora E{args.in[9], args.in[11], args.in[15], (bf16*)(ws + WS_EE), (bf16*)(ws + WS_XK), (const bf16*)(ws + WS_KKN), (bf16*)(ws + WS_BV), (bf16*)(ws + WS_GG)};
        pg8::gemm_phase<pg8::EpiLora, pg8::StaticOrder, true, true, pg8::NoGather>(lds, g, S, E, pg8::NoGather{});
    }
    SEAM(4);
    if (IN(5)) for (int rep = 0; rep < NREP(5); ++rep) {
        const int myx = (int)(xb_xcc_id() & 7u);
        for (int d = 0; d < 8; ++d) {
            const int qx = (myx + d) & 7;
            for (;;) {
                if (tid == 0) MISC[0] = atomicAdd(ctl + CW_QUEUE + 256 * (rep + 2 * args.probe) + 16 * qx, 1u);
                __syncthreads();
                int item = (int)MISC[0];
                __syncthreads();
#ifdef PROBE_SUB
                if (args.probe) { if (PROBE_SUB == 1 || (PROBE_SUB >= 10 && PROBE_SUB < 20)) { if (item >= 16) break; } else item += 16; }
#endif
#if CONV_IN_P5
                if (item >= 16 + 165) break;
                if (item >= 16) {
                    const int sl = item - 16, c5 = sl / 5;
                    if (sl - 5 * c5 == 4) {
                        const int e = conv_base + qx + 8 * c5;
                        if (e < 257) { int ln = lane; asm volatile("" : "+v"(ln)); p0_expert_wave(args, ws, e, 0, 192, wave, (LAS float*)(lds + wave * 16640), ln); }
                        continue;
                    }
                    item = 16 + sl - c5;
                    if (item >= 16 + 128) continue;
                }
#else
                if (item >= 16 + 128) break;
#endif
#ifndef NO_SCAN
                if (item < 16) scan_job(lds, 16 * qx + item, ws, args.in[16], args.in[17], args.in[18], args.in[14], args.in[15], tid, lane, wave, PMODE);
#endif
#ifndef NO_DSA
                if (item >= 16) { const int u = item - 16; dsa_unit(lds, 2 * qx + (u >> 6), 63 - (u & 63), ws, args.in[23], tid, lane, wave, PMODE); }
#endif
            }
        }
    }
    SEAM(5);
    if (IN(6)) for (int rep = 0; rep < NREP(6); ++rep) {
        pg8::Gemm g{(const bf16*)(ws + WS_H), (const bf16*)(ws + WS_WOUTT), 1024}; pg8::StaticOrder S; S.init(T, 1024, G, bx);
        pg8::EpiResid E{x, (bf16*)(ws + WS_X1B), mod, 2048};
        pg8::gemm_phase<pg8::EpiResid, pg8::StaticOrder, true, true, pg8::NoGather>(lds, g, S, E, pg8::NoGather{});
    }
    SEAM(6);
    if (IN(7)) for (int rep = 0; rep < NREP(7); ++rep) {
        bf16* H = (bf16*)(ws + WS_H);
        for (int m = gw * 16; m < T; m += NGW * 16) { const int b = m / SEQ; const float* mb = mod + (size_t)b * 6144; norm_mod_rows16_bf((const bf16*)(ws + WS_X1B) + (size_t)m * DM, args.in[6], mb + 3072, mb + 4096, H + (size_t)m * DM, lane); }
    }
    SEAM(7);
    if (IN(8)) for (int rep = 0; rep < NREP(8); ++rep) {
        pg8::Gemm g{(const bf16*)(ws + WS_H), (const bf16*)(ws + WS_WRT), 1024}; pg8::StaticOrder S; S.init(T, 256, G, bx);
        pg8::EpiF32 E{(float*)(ws + WS_LOGIT), 256};
        pg8::gemm_phase<pg8::EpiF32, pg8::StaticOrder, true, true, pg8::NoGather>(lds, g, S, E, pg8::NoGather{});
        if (conv_split && bx >= 128) {
            __syncthreads();
            int ln = lane; asm volatile("" : "+v"(ln));
#pragma unroll 1
            for (int j = 0; j < 2; ++j) { const int un = 128 + 2 * (bx - 128) + j; p0_expert_wave(args, ws, un / 6, 32 * (un % 6), 32 * (un % 6) + 32, wave, (LAS float*)(lds + wave * 16640), ln); }
        }
    }
    SEAM(8);
    if (IN(9)) for (int rep = 0; rep < NREP(9); ++rep) {
        const float* LG = (const float*)(ws + WS_LOGIT); const float* rbias = args.in[26];
        unsigned* SEL = (unsigned*)(ws + WS_SEL); float* GWt = (float*)(ws + WS_GW); int* HG = (int*)(ws + WS_HG);
        LAS int* hist = (LAS int*)lds;
        if (tid < 256) hist[tid] = 0;
        __syncthreads();
        const f32x4 bv = *(const f32x4*)(rbias + 4 * lane);
        for (int i16 = 0; i16 < 16; ++i16) {
            const int m = vcu * 128 + wave * 16 + i16;
            const f32x4 lg = *(const f32x4*)(LG + (size_t)m * 256 + 4 * lane);
            float sc[4], bs[4];
#pragma unroll
            for (int i = 0; i < 4; ++i) { sc[i] = sigmoidf_(lg[i]); bs[i] = sc[i] + bv[i]; }
            float a1 = fmaxf(bs[0], bs[1]), a2 = fminf(bs[0], bs[1]);
            { const float b1 = fmaxf(bs[2], bs[3]), b2 = fminf(bs[2], bs[3]); const float n1 = fmaxf(a1, b1), n2 = fmaxf(fminf(a1, b1), fmaxf(a2, b2)); a1 = n1; a2 = n2; }
#pragma unroll
            for (int o = 1; o < 8; o <<= 1) { const float b1 = __shfl_xor(a1, o), b2 = __shfl_xor(a2, o); const float n1 = fmaxf(a1, b1), n2 = fmaxf(fminf(a1, b1), fmaxf(a2, b2)); a1 = n1; a2 = n2; }
            const float gs = a1 + a2; const int mygrp = lane >> 3;
            int rank = 0;
#pragma unroll
            for (int g = 0; g < 8; ++g) { const float og = __shfl(gs, 8 * g); rank += (og > gs || (og == gs && g < mygrp)) ? 1 : 0; }
            const bool gsel = rank < 4;
            unsigned long long key[4];
#pragma unroll
            for (int i = 0; i < 4; ++i) key[i] = gsel ? (((unsigned long long)sortable(bs[i]) << 32) | (unsigned)(255 - (4 * lane + i))) : 0ull;
            int my_e = 0; float my_s = 0.f; float ssum = 0.f;
#pragma unroll 1
            for (int r = 0; r < 8; ++r) {
                unsigned long long best = key[0] > key[1] ? key[0] : key[1]; const unsigned long long b2 = key[2] > key[3] ? key[2] : key[3]; best = best > b2 ? best : b2;
#pragma unroll
                for (int o = 1; o < 64; o <<= 1) { const unsigned long long ob = __shfl_xor(best, o); best = ob > best ? ob : best; }
                const int e = 255 - (int)(best & 0xffffffffull);
                const int ol = e >> 2, oi = e & 3;
                float sv = (oi == 0) ? sc[0] : (oi == 1) ? sc[1] : (oi == 2) ? sc[2] : sc[3];
                sv = __shfl(sv, ol);
                if (lane == ol) {
#pragma unroll
                    for (int i = 0; i < 4; ++i) if (i == oi) key[i] = 0ull;
                }
                ssum += sv;
                if (lane == r) { my_e = e; my_s = sv; }
            }
            if (lane < 8) {
                const int lpos = __hip_atomic_fetch_add(hist + my_e, 1, __ATOMIC_RELAXED, __HIP_MEMORY_SCOPE_WORKGROUP);
                SEL[(size_t)m * 8 + lane] = (unsigned)my_e | ((unsigned)lpos << 8);
                GWt[(size_t)m * 8 + lane] = my_s / ssum * 2.5f;
            }
        }
        __syncthreads();
        if (tid < 256) HG[vcu * 256 + tid] = hist[tid];
        __syncthreads();
    }
    SEAM(9);
    if (IN(10)) for (int rep = 0; rep < NREP(10); ++rep) {
        unsigned* SEL = (unsigned*)(ws + WS_SEL); const int* HG = (const int*)(ws + WS_HG); int* TOKL = (int*)(ws + WS_TOKL);
        LAS int* basel = (LAS int*)lds;
        {
            const int e = tid & 255, half = tid >> 8; int bsum = 0, tsum = 0;
#pragma unroll 16
            for (int w = 0; w < 128; ++w) { const int wg = half * 128 + w; const int v = HG[wg * 256 + e]; tsum += v; bsum += (wg < vcu) ? v : 0; }
            basel[half * 256 + e] = bsum; basel[512 + half * 256 + e] = tsum;
        }
        __syncthreads();
        if (tid < 256) { const int bsum = basel[tid] + basel[256 + tid], tsum = basel[512 + tid] + basel[768 + tid]; basel[1024 + tid] = bsum; if (vcu == 0) ctl[CW_CNT + tid] = (unsigned)tsum; }
        __syncthreads();
#pragma unroll
        for (int k2 = 0; k2 < 2; ++k2) { const int idx = tid + 512 * k2; const int m = vcu * 128 + (idx >> 3);
            const unsigned se = SEL[(size_t)m * 8 + (idx & 7)]; const int e = (int)(se & 255u), pos = basel[1024 + e] + (int)(se >> 8);
            SEL[(size_t)m * 8 + (idx & 7)] = (unsigned)e | ((unsigned)pos << 8); TOKL[(size_t)e * ECAP + pos] = m; }
        __syncthreads();
    }
    SEAM(10);
    if (IN(11)) for (int rep = 0; rep < NREP(11); ++rep) {
        LAS int* tab = (LAS int*)(lds + TAB_OFF);
        moe_tables(tab, ctl, tid);
        const LAS int* cnt = tab; const LAS int* cum = tab + 260; const LAS int* tcum = tab + 520;
        const int total = 2 * __builtin_amdgcn_readfirstlane(tcum[257]);
        LAS unsigned* gtab = (LAS unsigned*)(lds + 131072);
        {
            const int* TOKL = (const int*)(ws + WS_TOKL);
            for (int i = tid >> 8; ; i += 2) { const int uix = vcu + i * G; if (uix >= total || i >= 22) break;
                const int tile = uix >> 1, e = find_expert(tcum, tile), j = tile - tcum[e], r = tid & 255, rem = cnt[e] - 256 * j;
                int tok; if (e < 256) tok = TOKL[(size_t)e * ECAP + 256 * j + (r < rem ? r : 0)]; else tok = 256 * j + r;
                gtab[i * 256 + r] = (unsigned)tok * 2048u; }
        }
        __syncthreads();
        Fc1Order S; S.tab = tab; S.total = total; S.G = G; S.c = vcu;
        LdsGather am; am.tabl = gtab;
        pg8::Gemm g{(const bf16*)(ws + WS_H), (const bf16*)(ws + WS_W13T), 1024};
        pg8::EpiSwiglu E{(bf16*)(ws + WS_ACT)};
        pg8::gemm_phase<pg8::EpiSwiglu, Fc1Order, true, true, LdsGather>(lds, g, S, E, am);
        (void)cum;
    }
    SEAM(11);
    if (IN(12)) for (int rep = 0; rep < NREP(12); ++rep) {
        LAS int* tab = (LAS int*)(lds + TAB_OFF);
        moe_tables(tab, ctl, tid);
        Fc2Order S; S.tab = tab; S.total = 4 * __builtin_amdgcn_readfirstlane(tab[520 + 257]); S.G = G; S.c = vcu;
        pg8::Gemm g{(const bf16*)(ws + WS_ACT), (const bf16*)(ws + WS_W2T), 256};
        pg8::EpiFp8 E{(unsigned char*)(ws + WS_Y), 1024, (PMODE == 7) ? 100000 : 0};
        pg8::gemm_phase<pg8::EpiFp8, Fc2Order, true, true, pg8::NoGather>(lds, g, S, E, pg8::NoGather{});
    }
    SEAM(12);
    if (IN(13)) for (int rep = 0; rep < NREP(13); ++rep) {
        LAS int* tab = (LAS int*)(lds + TAB_OFF);
        moe_tables(tab, ctl, tid);
        const LAS int* cum = tab + 260;
        const unsigned char* Y = (const unsigned char*)(ws + WS_Y); const unsigned* SEL = (const unsigned*)(ws + WS_SEL); const float* GWt = (const float*)(ws + WS_GW);
        for (int m = gw; m < T; m += NGW) {
            const int b = m / SEQ; const float* g2 = mod + (size_t)b * 6144 + 5120;
            float acc[16];
            u32x4 yv[9]; float wv[9];
            yv[0] = __builtin_nontemporal_load((const u32x4*)(Y + ((size_t)T * 8 + m) * 1024 + 16 * lane)); wv[0] = 1.0f;
#pragma unroll
            for (int j = 0; j < 8; ++j) {
                const unsigned se = SEL[(size_t)m * 8 + j]; wv[1 + j] = GWt[(size_t)m * 8 + j];
                const int e = (int)(se & 255u), pos = (int)(se >> 8);
                yv[1 + j] = __builtin_nontemporal_load((const u32x4*)(Y + ((size_t)cum[e] + pos) * 1024 + 16 * lane));
            }
#pragma unroll
            for (int i = 0; i < 16; ++i) acc[i] = 0.f;
#pragma unroll
            for (int j = 0; j < 9; ++j) {
                const float w = wv[j]; const unsigned dw[4] = {yv[j].x, yv[j].y, yv[j].z, yv[j].w};
#pragma unroll
                for (int q4 = 0; q4 < 4; ++q4) { const f32x2 lo = __builtin_amdgcn_cvt_pk_f32_fp8((int)dw[q4], false), hi2 = __builtin_amdgcn_cvt_pk_f32_fp8((int)dw[q4], true);
                    acc[4 * q4] += w * lo.x; acc[4 * q4 + 1] += w * lo.y; acc[4 * q4 + 2] += w * hi2.x; acc[4 * q4 + 3] += w * hi2.y; }
            }
            float* orow = args.out + (size_t)m * DM + 16 * lane;
            const u32x4* xr1 = (const u32x4*)((const bf16*)(ws + WS_X1B) + (size_t)m * DM + 16 * lane); const u32x4 xa = xr1[0], xb = xr1[1];
            const unsigned xw[8] = {xa.x, xa.y, xa.z, xa.w, xb.x, xb.y, xb.z, xb.w};
#pragma unroll
            for (int q4 = 0; q4 < 4; ++q4) { const f32x4 gv = *(const f32x4*)(g2 + 16 * lane + 4 * q4);
                f32x4 o; o.x = lo16(xw[2 * q4]) + gv.x * acc[4 * q4]; o.y = hi16(xw[2 * q4]) + gv.y * acc[4 * q4 + 1]; o.z = lo16(xw[2 * q4 + 1]) + gv.z * acc[4 * q4 + 2]; o.w = hi16(xw[2 * q4 + 1]) + gv.w * acc[4 * q4 + 3];
                *(f32x4*)(orow + 4 * q4) = o; }
        }
    }
#undef IN
#undef SEAM
}

extern "C" void kernel_launch(void* const* d_in, const int* in_sizes, int n_in, void* d_out, int out_size, void* d_ws, size_t ws_size, hipStream_t stream) {
    static int grid = 0;
    if (grid == 0) {
        if (n_in != 33 || out_size != T * DM || ws_size < WS_END) { fprintf(stderr, "kernel_launch: unexpected shapes (n_in %d out %d ws %zu)\n", n_in, out_size, ws_size); grid = -1; return; }
        int dev = 0, cus = 0, per_cu = 0;
        hipGetDevice(&dev); hipDeviceGetAttribute(&cus, hipDeviceAttributeMultiprocessorCount, dev);
        hipFuncSetAttribute((const void*)fwd_kernel, hipFuncAttributeMaxDynamicSharedMemorySize, LDS_BYTES);
        hipOccupancyMaxActiveBlocksPerMultiprocessor(&per_cu, (const void*)fwd_kernel, 512, LDS_BYTES);
        (void)hipGetLastError();
        if (per_cu < 1) fprintf(stderr, "kernel_launch: occupancy query says %d\n", per_cu);
        grid = cus;
    }
    if (grid < 0) return;
    hipMemsetAsync((char*)d_ws + WS_CTL, 0, CTL_BYTES, stream);
    Args a{};
    for (int i = 0; i < 33; ++i) a.in[i] = (const float*)d_in[i];
    a.out = (float*)d_out; a.ws = (unsigned char*)d_ws;
#if MK_PER_PHASE
    for (int p = 0; p < NPHASE; ++p) { a.ph_lo = p; a.ph_hi = p + 1; hipLaunchKernelGGL(fwd_kernel, dim3(grid), dim3(512), LDS_BYTES, stream, a); }
#else
    a.ph_lo = 0; a.ph_hi = NPHASE;
    void* kargs[] = {&a};
    hipError_t e = hipLaunchCooperativeKernel((const void*)fwd_kernel, dim3(grid), dim3(512), kargs, LDS_BYTES, stream);
    if (e != hipSuccess) fprintf(stderr, "cooperative launch failed: %s (grid %d)\n", hipGetErrorString(e), grid);
#ifdef PROBE_PHASE
    a.ph_lo = PROBE_PHASE; a.ph_hi = PROBE_PHASE + 1; a.probe = 1; hipLaunchKernelGGL(fwd_kernel, dim3(grid), dim3(512), LDS_BYTES, stream, a);
#endif
#endif
}
```

```cpp
#include <hip/hip_runtime.h>
#include <cstdio>
#include <cstdint>

#ifndef MK_PER_PHASE
#define MK_PER_PHASE 0
#endif

#define LAS __attribute__((address_space(3)))
#define GAS __attribute__((address_space(1)))
typedef unsigned short bf16;
typedef short bf16x8 __attribute__((ext_vector_type(8)));
typedef float f32x4 __attribute__((ext_vector_type(4)));
typedef float f32x16 __attribute__((ext_vector_type(16)));
typedef unsigned u32x4 __attribute__((ext_vector_type(4)));
typedef unsigned u32x2 __attribute__((ext_vector_type(2)));

constexpr int BATCH = 16, SEQ = 2048, DM = 1024, T = BATCH * SEQ;
constexpr int NP = 3840;
constexpr int IN_COLS = 3652;
constexpr int C_RWR = 0, C_RWK = 512, C_RWV = 1024, C_WL = 1536;
constexpr int C_Q = 1792, C_K = 2304, C_V = 2816, C_QI = 3328, C_KI = 3584, C_WI = 3648;
constexpr int NEXP = 256, ECAP = 32768;

constexpr size_t MiB = 1u << 20;
constexpr size_t WS_CTL = 0, CTL_BYTES = 32768;
constexpr size_t WS_MOD = 1 * MiB;
constexpr size_t WS_WINT = 2 * MiB;
constexpr size_t WS_WOUTT = 10 * MiB;
constexpr size_t WS_WLT = 12 * MiB;
constexpr size_t WS_WRT = 13 * MiB;
constexpr size_t WS_W2T = 16 * MiB;
constexpr size_t WS_W13T = 145 * MiB;
constexpr size_t WS_H = 404 * MiB;
constexpr size_t WS_P = 468 * MiB;
constexpr size_t WS_XR = 708 * MiB, WS_XK = 740 * MiB, WS_XV = 772 * MiB, WS_KKN = 804 * MiB;
constexpr size_t WS_LORA = 836 * MiB;
constexpr size_t WS_EE = 852 * MiB, WS_BV = 884 * MiB, WS_GG = 916 * MiB, WS_VF = 948 * MiB, WS_KF = 980 * MiB, WS_KIF = 1012 * MiB;
constexpr size_t WS_LOGIT = 468 * MiB;
constexpr size_t WS_TOKL = 500 * MiB;
constexpr size_t WS_Y = 145 * MiB;
constexpr size_t WS_ACT = 724 * MiB;
constexpr size_t WS_SEL = 870 * MiB;
constexpr size_t WS_GW = 872 * MiB;
constexpr size_t WS_X1B = 560 * MiB;
constexpr size_t WS_HG = 874 * MiB;
constexpr size_t WS_END = 1024 * MiB;
constexpr int CW_QUEUE = 64, CW_CNT = 1024  , CW_BAR = 4096;

constexpr int RING_BYTES = 153600;
constexpr int MISC_OFF = RING_BYTES;
constexpr int TAB_OFF = RING_BYTES + 256;
constexpr int MASK_OFF = 131072;
constexpr int LDS_BYTES = RING_BYTES + 8192;

__device__ __forceinline__ float bf2f(unsigned h) { return __uint_as_float(h << 16); }
typedef __bf16 bf16v2 __attribute__((ext_vector_type(2)));
typedef float f32x2 __attribute__((ext_vector_type(2)));
__device__ __forceinline__ unsigned pk2(float lo, float hi) { const f32x2 v = {lo, hi}; return __builtin_bit_cast(unsigned, __builtin_convertvector(v, bf16v2)); }
__device__ __forceinline__ unsigned f2bf(float f) { return pk2(f, 0.f) & 0xffffu; }
__device__ __forceinline__ float lo16(unsigned w) { return __uint_as_float(w << 16); }
__device__ __forceinline__ float hi16(unsigned w) { return __uint_as_float(w & 0xffff0000u); }
__device__ __forceinline__ float sigmoidf_(float x) { return 1.0f / (1.0f + __expf(-x)); }

namespace pg8 {
constexpr int BM = 256, BK = 64, HALF = 128, HTB = HALF * BK * 2, STAGE_BYTES = 8 * HTB, NXCD = 8, WGM = 8;
__host__ __device__ __forceinline__ int lds_byte(int r, int c) { const int st = (r >> 4) * 2 + (c >> 5), rr = r & 15, cc = c & 31, ob = rr * 64 + cc * 2; return st * 1024 + (ob ^ (((ob >> 9) & 1) << 5)); }
__host__ __device__ __forceinline__ void stage_rc(int b, int& R, int& C) { const int st = b / 1024, sb = b % 1024, swz = sb ^ (((sb >> 9) & 1) << 5); R = (st >> 1) * 16 + swz / 64; C = (st & 1) * 32 + (swz % 64) / 2; }
__host__ __device__ __forceinline__ int perm32(int rho) { const int n = rho >> 4, i = rho & 15; return 8 * (i >> 2) + 4 * n + (i & 3); }

struct Unit { int arow, brow, orow, ocol, nvalid, aux; };
struct Gemm { const bf16* A; const bf16* Bt; int K; };

struct StaticOrder {
    int nM, nN, nwg, G, c;
    __device__ void init(int M, int N, int G_, int c_) { nM = M / BM; nN = N / BM; nwg = nM * nN; G = G_; c = c_; }
    __device__ bool next(int i, Unit& u) const {
        const long L = (long)i * G + c; if (L >= nwg) return false;
        int wgid = (int)L; { const int q = nwg / NXCD, r = nwg % NXCD, xcd = wgid % NXCD, off = wgid / NXCD; wgid = (xcd < r ? xcd * (q + 1) : r * (q + 1) + (xcd - r) * q) + off; }
        const int nig = WGM * nN, gid = wgid / nig, fm = gid * WGM, gsz = (nM - fm) < WGM ? (nM - fm) : WGM;
        const int pm = fm + ((wgid % nig) % gsz), pn = (wgid % nig) / gsz;
        u.arow = pm * BM; u.brow = pn * BM; u.orow = pm * BM; u.ocol = pn * BM; u.nvalid = BM; u.aux = 0; return true;
    }
};
struct OneUnit { Unit u; __device__ bool next(int i, Unit& o) const { if (i != 0) return false; o = u; return true; } };
struct NoGather { static constexpr bool GATHER = false; __device__ __forceinline__ unsigned rowoff(int, int) const { return 0u; } };

template <class Epi, class Sched, bool ALIGN_EPI, bool SP2, class AMap>
__device__ __forceinline__ void gemm_phase(LAS unsigned char* lds, const Gemm g, const Sched& S, const Epi& E, const AMap& amap) {
    constexpr bool GATHER = AMap::GATHER;
    const int tid = threadIdx.x, wid = __builtin_amdgcn_readfirstlane(tid >> 6), lane = tid & 63, wr = wid >> 2, wc = wid & 3, fr = lane & 15, fq = lane >> 4;
    const int K = g.K, nt = K / BK;
    unsigned voffA[2], voffB[2], voffG[2][2];
    int RA[2], CA[2];
#pragma unroll
    for (int i = 0; i < 2; ++i) { int R, C; stage_rc(tid * 16 + i * 8192, R, C); const int Rb = Epi::PERM ? ((R & ~31) + perm32(R & 31)) : R;
        voffA[i] = (unsigned)(R * K + C) * 2u; voffB[i] = (unsigned)(Rb * K + C) * 2u; RA[i] = R; CA[i] = C; voffG[0][i] = 0u; voffG[1][i] = 0u; }
    unsigned voffGn[2][2] = {{0u, 0u}, {0u, 0u}};
    if constexpr (GATHER) {
#pragma unroll
        for (int h = 0; h < 2; ++h)
#pragma unroll
            for (int i = 0; i < 2; ++i) voffG[h][i] = amap.rowoff(0, h * HALF + RA[i]) + (unsigned)CA[i] * 2u;
    }
    const size_t kstep = (size_t)(BK * 2);
    const size_t hstep = (size_t)HALF * K * 2;
    const size_t rowb = (size_t)K * 2;
    const unsigned ldsw = (unsigned)wid * 1024u;
    const int aoff = lds_byte(wr * 64 + fr, fq * 8), boff = lds_byte(wc * 32 + fr, fq * 8);
#define PG8_SA(b, h) (((b) * 2 + (h)) * HTB)
#define PG8_SB(b, h) ((4 + (b) * 2 + (h)) * HTB)
#define PG8_STAGE(bufoff, gbase, voff) do { _Pragma("unroll") for (int _i = 0; _i < 2; ++_i) \
        __builtin_amdgcn_global_load_lds((const unsigned*)((const char*)(gbase) + (voff)[_i]), (LAS unsigned*)(lds + (bufoff) + ldsw + _i * 8192), 16, 0, 0); } while (0)
#define PG8_STAGEA(bufoff, gbase, h) do { if constexpr (GATHER) { PG8_STAGE(bufoff, gbase, voffG[h]); } else { PG8_STAGE(bufoff, (gbase) + (h) * hstep, voffA); } } while (0)
#define PG8_STAGEAN(bufoff, gbase, h) do { if constexpr (GATHER) { PG8_STAGE(bufoff, gbase, vsel[h]); } else { PG8_STAGE(bufoff, (gbase) + (h) * hstep, voffA); } } while (0)
#define PG8_LDA(dst, b, h) do { _Pragma("unroll") for (int m = 0; m < 4; ++m) _Pragma("unroll") for (int k = 0; k < 2; ++k) dst[m][k] = *(const LAS bf16x8*)(lds + PG8_SA(b, h) + aoff + m * 2048 + k * 1024); } while (0)
#define PG8_LDB(dst, b, h) do { _Pragma("unroll") for (int n = 0; n < 2; ++n) _Pragma("unroll") for (int k = 0; k < 2; ++k) dst[n][k] = *(const LAS bf16x8*)(lds + PG8_SB(b, h) + boff + n * 2048 + k * 1024); } while (0)
#define PG8_MMA(ai, bj, At, Bt) do { __builtin_amdgcn_s_setprio(1); _Pragma("unroll") for (int m = 0; m < 4; ++m) _Pragma("unroll") for (int n = 0; n < 2; ++n) _Pragma("unroll") for (int k = 0; k < 2; ++k) \
        acc[ai][bj][m][n] = __builtin_amdgcn_mfma_f32_16x16x32_bf16(Bt[n][k], At[m][k], acc[ai][bj][m][n], 0, 0, 0); __builtin_amdgcn_s_setprio(0); } while (0)
#define PG8_WAIT_V(n) asm volatile("s_waitcnt vmcnt(" #n ")" ::: "memory")
#define PG8_WAIT_L(n) asm volatile("s_waitcnt lgkmcnt(" #n ")" ::: "memory")
#define PG8_BAR __builtin_amdgcn_s_barrier()
#define PG8_SCHED __builtin_amdgcn_sched_barrier(0)
    Unit cur, nxt; int ui = 0;
    if (!S.next(0, cur)) return;
    f32x4 acc[2][2][4][2];
#pragma unroll
    for (int a = 0; a < 2; ++a)
#pragma unroll
        for (int b = 0; b < 2; ++b)
#pragma unroll
            for (int m = 0; m < 4; ++m)
#pragma unroll
                for (int n = 0; n < 2; ++n) acc[a][b][m][n] = (f32x4){0.f, 0.f, 0.f, 0.f};
    bf16x8 At[4][2], B0[2][2], B1[2][2];
    const char* cA = (const char*)g.A + (GATHER ? (size_t)0 : (size_t)cur.arow * rowb); const char* cB = (const char*)g.Bt + (size_t)cur.brow * rowb;
    if constexpr (SP2) {
        PG8_STAGE(PG8_SB(0, 0), cB, voffB); PG8_STAGE(PG8_SB(0, 1), cB + hstep, voffB); PG8_STAGEA(PG8_SA(0, 0), cA, 0); PG8_STAGEA(PG8_SA(0, 1), cA, 1);
        if (wr == 1) PG8_BAR;
        PG8_WAIT_V(2); PG8_BAR;
        PG8_STAGE(PG8_SB(1, 0), cB + kstep, voffB); PG8_STAGEA(PG8_SA(1, 0), cA + kstep, 0); PG8_STAGE(PG8_SB(1, 1), cB + hstep + kstep, voffB);
        PG8_WAIT_V(6); PG8_BAR;
    } else {
        PG8_STAGE(PG8_SB(0, 0), cB, voffB); PG8_STAGEA(PG8_SA(0, 0), cA, 0); PG8_STAGE(PG8_SB(0, 1), cB + hstep, voffB); PG8_STAGEA(PG8_SA(0, 1), cA, 1);
        if (wr == 1) PG8_BAR;
        PG8_WAIT_V(4); PG8_BAR;
        PG8_STAGE(PG8_SB(1, 0), cB + kstep, voffB); PG8_STAGEA(PG8_SA(1, 0), cA + kstep, 0); PG8_STAGE(PG8_SB(1, 1), cB + hstep + kstep, voffB);
        PG8_WAIT_V(6); PG8_BAR;
    }
    for (;;) {
        const bool has_next = S.next(ui + 1, nxt);
        if constexpr (GATHER) { if (has_next) {
#pragma unroll
            for (int h = 0; h < 2; ++h)
#pragma unroll
                for (int i = 0; i < 2; ++i) voffGn[h][i] = amap.rowoff(ui + 1, h * HALF + RA[i]) + (unsigned)CA[i] * 2u; } else {
#pragma unroll
            for (int h = 0; h < 2; ++h)
#pragma unroll
                for (int i = 0; i < 2; ++i) voffGn[h][i] = voffG[h][i]; } }
        const char* nA = has_next ? (const char*)g.A + (GATHER ? (size_t)0 : (size_t)nxt.arow * rowb) : cA; const char* nB = has_next ? (const char*)g.Bt + (size_t)nxt.brow * rowb : cB;
#pragma unroll 1
        for (int t = 0; t < nt; t += 2) {
            const bool last = (t == nt - 2);
            const char* a1 = cA + (size_t)(t + 1) * kstep;
            const char* a2 = last ? nA : cA + (size_t)(t + 2) * kstep; const char* b2 = last ? nB : cB + (size_t)(t + 2) * kstep;
            const char* a3 = a2 + kstep; const char* b3 = b2 + kstep;
            unsigned vsel[2][2];
#pragma unroll
            for (int h = 0; h < 2; ++h)
#pragma unroll
                for (int i = 0; i < 2; ++i) vsel[h][i] = last ? voffGn[h][i] : voffG[h][i];
            if constexpr (SP2) {
            PG8_LDB(B0, 0, 0); PG8_LDB(B1, 0, 1); PG8_SCHED; PG8_LDA(At, 0, 0); PG8_STAGEA(PG8_SA(1, 1), a1, 1);
            PG8_WAIT_V(8); PG8_WAIT_L(0); PG8_BAR; PG8_MMA(0, 0, At, B0); PG8_MMA(0, 1, At, B1); PG8_BAR; PG8_SCHED;
            PG8_LDA(At, 0, 1); PG8_STAGE(PG8_SB(0, 0), b2, voffB); PG8_STAGE(PG8_SB(0, 1), b2 + hstep, voffB); PG8_STAGEAN(PG8_SA(0, 0), a2, 0);
            PG8_WAIT_V(8); PG8_WAIT_L(0); PG8_BAR; if (cur.nvalid > HALF) { PG8_MMA(1, 0, At, B0); PG8_MMA(1, 1, At, B1); } PG8_BAR; PG8_SCHED;
            PG8_LDB(B0, 1, 0); PG8_LDB(B1, 1, 1); PG8_SCHED; PG8_LDA(At, 1, 0); PG8_STAGEAN(PG8_SA(0, 1), a2, 1);
            PG8_WAIT_V(8); PG8_WAIT_L(0); PG8_BAR; PG8_MMA(0, 0, At, B0); PG8_MMA(0, 1, At, B1); PG8_BAR; PG8_SCHED;
            PG8_LDA(At, 1, 1); PG8_STAGE(PG8_SB(1, 0), b3, voffB); PG8_STAGE(PG8_SB(1, 1), b3 + hstep, voffB); PG8_STAGEAN(PG8_SA(1, 0), a3, 0);
            PG8_WAIT_V(8); PG8_WAIT_L(0); PG8_BAR; if (cur.nvalid > HALF) { PG8_MMA(1, 0, At, B0); PG8_MMA(1, 1, At, B1); } PG8_BAR; PG8_SCHED;
            } else {
            PG8_LDB(B0, 0, 0); PG8_SCHED; PG8_LDA(At, 0, 0); PG8_STAGEA(PG8_SA(1, 1), a1, 1);
            PG8_WAIT_L(8); PG8_BAR; PG8_WAIT_L(0); PG8_MMA(0, 0, At, B0); PG8_BAR; PG8_SCHED;
            PG8_LDB(B1, 0, 1); PG8_STAGE(PG8_SB(0, 0), b2, voffB);
            PG8_BAR; PG8_WAIT_L(0); PG8_MMA(0, 1, At, B1); PG8_BAR;
            PG8_LDA(At, 0, 1); PG8_STAGEAN(PG8_SA(0, 0), a2, 0);
            PG8_BAR; PG8_WAIT_L(0); PG8_MMA(1, 0, At, B0); PG8_BAR; PG8_SCHED;
            PG8_STAGE(PG8_SB(0, 1), b2 + hstep, voffB);
            PG8_WAIT_V(6); PG8_BAR; PG8_MMA(1, 1, At, B1); PG8_BAR;
            PG8_LDB(B0, 1, 0); PG8_SCHED; PG8_LDA(At, 1, 0); PG8_STAGEAN(PG8_SA(0, 1), a2, 1);
            PG8_WAIT_L(8); PG8_BAR; PG8_WAIT_L(0); PG8_MMA(0, 0, At, B0); PG8_BAR; PG8_SCHED;
            PG8_LDB(B1, 1, 1); PG8_STAGE(PG8_SB(1, 0), b3, voffB);
            PG8_BAR; PG8_WAIT_L(0); PG8_MMA(0, 1, At, B1); PG8_BAR;
            PG8_LDA(At, 1, 1); PG8_STAGEAN(PG8_SA(1, 0), a3, 0);
            PG8_BAR; PG8_WAIT_L(0); PG8_MMA(1, 0, At, B0); PG8_BAR; PG8_SCHED;
            PG8_STAGE(PG8_SB(1, 1), b3 + hstep, voffB);
            PG8_WAIT_V(6); PG8_BAR; PG8_MMA(1, 1, At, B1); PG8_BAR;
            }
        }
        if constexpr (ALIGN_EPI) { if (wr == 0) PG8_BAR; }
        E(acc, cur, wr, wc, fr, fq);
        if (!has_next) break;
#pragma unroll
        for (int a = 0; a < 2; ++a)
#pragma unroll
            for (int b = 0; b < 2; ++b)
#pragma unroll
                for (int m = 0; m < 4; ++m)
#pragma unroll
                    for (int n = 0; n < 2; ++n) acc[a][b][m][n] = (f32x4){0.f, 0.f, 0.f, 0.f};
        cur = nxt; cA = nA; cB = nB; ++ui;
        if constexpr (GATHER) {
#pragma unroll
            for (int h = 0; h < 2; ++h)
#pragma unroll
                for (int i = 0; i < 2; ++i) voffG[h][i] = voffGn[h][i]; }
        if constexpr (ALIGN_EPI) { if (wr == 1) PG8_BAR; }
    }
    PG8_WAIT_V(0);
    if constexpr (!ALIGN_EPI) { if (wr == 0) PG8_BAR; }
    PG8_BAR;
#undef PG8_SA
#undef PG8_SB
#undef PG8_STAGE
#undef PG8_STAGEA
#undef PG8_STAGEAN
#undef PG8_LDA
#undef PG8_LDB
#undef PG8_MMA
#undef PG8_WAIT_V
#undef PG8_WAIT_L
#undef PG8_BAR
#undef PG8_SCHED
}

struct EpiBf16 {
    static constexpr bool PERM = true;
    bf16* O; int ldc; int skip;
    __device__ __forceinline__ void operator()(const f32x4 (&acc)[2][2][4][2], const Unit& u, int wr, int wc, int fr, int fq) const {
#pragma unroll
        for (int ai = 0; ai < 2; ++ai)
#pragma unroll
            for (int m = 0; m < 4; ++m) { const int lr = ai * HALF + wr * 64 + m * 16 + fr; if (lr < u.nvalid - skip) { bf16* rowp = O + (size_t)(u.orow + lr) * ldc + u.ocol + wc * 32 + 8 * fq;
#pragma unroll
                for (int bj = 0; bj < 2; ++bj) { const f32x4 v0 = acc[ai][bj][m][0], v1 = acc[ai][bj][m][1]; u32x4 w; w.x = pk2(v0[0], v0[1]); w.y = pk2(v0[2], v0[3]); w.z = pk2(v1[0], v1[1]); w.w = pk2(v1[2], v1[3]);
                    *(u32x4*)(rowp + bj * HALF) = w; } } }
    }
};
struct EpiFp8 {
    static constexpr bool PERM = true;
    unsigned char* O; int ldc; int skip;
    __device__ __forceinline__ void operator()(const f32x4 (&acc)[2][2][4][2], const Unit& u, int wr, int wc, int fr, int fq) const {
#pragma unroll
        for (int ai = 0; ai < 2; ++ai)
#pragma unroll
            for (int m = 0; m < 4; ++m) { const int lr = ai * HALF + wr * 64 + m * 16 + fr; if (lr < u.nvalid - skip) { unsigned char* rowp = O + (size_t)(u.orow + lr) * ldc + u.ocol + wc * 32 + 8 * fq;
#pragma unroll
                for (int bj = 0; bj < 2; ++bj) { const f32x4 v0 = acc[ai][bj][m][0], v1 = acc[ai][bj][m][1]; int w0 = 0, w1 = 0;
                    w0 = __builtin_amdgcn_cvt_pk_fp8_f32(v0[0], v0[1], w0, false); w0 = __builtin_amdgcn_cvt_pk_fp8_f32(v0[2], v0[3], w0, true);
                    w1 = __builtin_amdgcn_cvt_pk_fp8_f32(v1[0], v1[1], w1, false); w1 = __builtin_amdgcn_cvt_pk_fp8_f32(v1[2], v1[3], w1, true);
                    *(u32x2*)(rowp + bj * HALF) = (u32x2){(unsigned)w0, (unsigned)w1}; } } }
    }
};
struct EpiF32 {
    static constexpr bool PERM = false;
    float* C; int ldc;
    __device__ __forceinline__ void operator()(const f32x4 (&acc)[2][2][4][2], const Unit& u, int wr, int wc, int fr, int fq) const {
#pragma unroll
        for (int ai = 0; ai < 2; ++ai)
#pragma unroll
            for (int m = 0; m < 4; ++m) { float* rowp = C + (size_t)(u.orow + ai * HALF + wr * 64 + m * 16 + fr) * ldc + u.ocol + wc * 32 + 4 * fq;
#pragma unroll
                for (int bj = 0; bj < 2; ++bj)
#pragma unroll
                    for (int n = 0; n < 2; ++n) *(f32x4*)(rowp + bj * HALF + n * 16) = acc[ai][bj][m][n]; }
    }
};
struct EpiResid {
    static constexpr bool PERM = true;
    const float* x; bf16* out; const float* mod; int goff;
    __device__ __forceinline__ void operator()(const f32x4 (&acc)[2][2][4][2], const Unit& u, int wr, int wc, int fr, int fq) const {
        const int b = u.orow / SEQ; const float* gp = mod + (size_t)b * 6144 + goff + u.ocol + wc * 32 + 8 * fq;
        f32x4 gv[2][2];
#pragma unroll
        for (int bj = 0; bj < 2; ++bj)
#pragma unroll
            for (int n = 0; n < 2; ++n) gv[bj][n] = *(const f32x4*)(gp + bj * HALF + 4 * n);
#pragma unroll
        for (int ai = 0; ai < 2; ++ai)
#pragma unroll
            for (int mp = 0; mp < 4; mp += 2) {
                f32x4 xv[2][2][2];
#pragma unroll
                for (int mm = 0; mm < 2; ++mm) { const size_t off = (size_t)(u.orow + ai * HALF + wr * 64 + (mp + mm) * 16 + fr) * DM + u.ocol + wc * 32 + 8 * fq;
#pragma unroll
                    for (int bj = 0; bj < 2; ++bj)
#pragma unroll
                        for (int n = 0; n < 2; ++n) xv[mm][bj][n] = *(const f32x4*)(x + off + bj * HALF + 4 * n); }
#pragma unroll
                for (int mm = 0; mm < 2; ++mm) { const size_t off = (size_t)(u.orow + ai * HALF + wr * 64 + (mp + mm) * 16 + fr) * DM + u.ocol + wc * 32 + 8 * fq;
#pragma unroll
                    for (int bj = 0; bj < 2; ++bj) { const f32x4 o0 = xv[mm][bj][0] + gv[bj][0] * acc[ai][bj][mp + mm][0], o1 = xv[mm][bj][1] + gv[bj][1] * acc[ai][bj][mp + mm][1];
                        *(u32x4*)(out + off + bj * HALF) = (u32x4){pk2(o0[0], o0[1]), pk2(o0[2], o0[3]), pk2(o1[0], o1[1]), pk2(o1[2], o1[3])}; } }
            }
    }
};
struct EpiSwiglu {
    static constexpr bool PERM = true;
    bf16* act;
    __device__ __forceinline__ void operator()(const f32x4 (&acc)[2][2][4][2], const Unit& u, int wr, int wc, int fr, int fq) const {
#pragma unroll
        for (int ai = 0; ai < 2; ++ai)
#pragma unroll
            for (int m = 0; m < 4; ++m) { const int lr = ai * HALF + wr * 64 + m * 16 + fr; if (lr < u.nvalid) {
                float o[8];
#pragma unroll
                for (int n = 0; n < 2; ++n)
#pragma unroll
                    for (int i = 0; i < 4; ++i) { const float a = acc[ai][0][m][n][i], c = acc[ai][1][m][n][i]; o[4 * n + i] = a * sigmoidf_(a) * c; }
                u32x4 w; w.x = pk2(o[0], o[1]); w.y = pk2(o[2], o[3]); w.z = pk2(o[4], o[5]); w.w = pk2(o[6], o[7]);
                *(u32x4*)(act + (size_t)(u.orow + lr) * 256 + u.ocol + wc * 32 + 8 * fq) = w; } }
    }
};
struct EpiLora {
    static constexpr bool PERM = true;
    const float* w0; const float* a0; const float* k_a; bf16* EE; bf16* XK; const bf16* KKN; bf16* BV; bf16* GG;
    __device__ __forceinline__ void operator()(const f32x4 (&acc)[2][2][4][2], const Unit& u, int wr, int wc, int fr, int fq) const {
        const int br = u.ocol >> 9;
        const int cbase = (u.ocol & 511) + wc * 32 + 8 * fq;
        const size_t rbase = (size_t)(u.orow + wr * 64 + fr) * 512 + cbase;
        if (br == 0) {
#pragma unroll
            for (int bj = 0; bj < 2; ++bj) {
                const f32x4 pa = *(const f32x4*)(w0 + cbase + bj * HALF), pb = *(const f32x4*)(w0 + cbase + bj * HALF + 4);
#pragma unroll
                for (int ai = 0; ai < 2; ++ai)
#pragma unroll
                    for (int m = 0; m < 4; ++m) {
                        float e[8];
#pragma unroll
                        for (int i = 0; i < 4; ++i) {
                            { const float z = -(pa[i] + acc[ai][bj][m][0][i]); const float sp = fmaxf(z, 0.f) + __logf(1.0f + __expf(-fabsf(z))); e[i] = __expf(-sp - 0.5f); }
                            { const float z = -(pb[i] + acc[ai][bj][m][1][i]); const float sp = fmaxf(z, 0.f) + __logf(1.0f + __expf(-fabsf(z))); e[4 + i] = __expf(-sp - 0.5f); }
                        }
                        u32x4 w; w.x = pk2(e[0], e[1]); w.y = pk2(e[2], e[3]); w.z = pk2(e[4], e[5]); w.w = pk2(e[6], e[7]);
                        *(u32x4*)(EE + rbase + (size_t)(ai * HALF + m * 16) * 512 + bj * HALF) = w;
                    }
            }
        } else if (br == 1) {
#pragma unroll
            for (int bj = 0; bj < 2; ++bj) {
                const f32x4 pa = *(const f32x4*)(a0 + cbase + bj * HALF), pb = *(const f32x4*)(a0 + cbase + bj * HALF + 4);
#pragma unroll
                for (int ai = 0; ai < 2; ++ai)
#pragma unroll
                    for (int m = 0; m < 4; ++m) {
                        float av[8];
#pragma unroll
                        for (int i = 0; i < 4; ++i) { av[i] = sigmoidf_(pa[i] + acc[ai][bj][m][0][i]); av[4 + i] = sigmoidf_(pb[i] + acc[ai][bj][m][1][i]); }
                        u32x4 w; w.x = pk2(av[0], av[1]); w.y = pk2(av[2], av[3]); w.z = pk2(av[4], av[5]); w.w = pk2(av[6], av[7]);
                        *(u32x4*)(BV + rbase + (size_t)(ai * HALF + m * 16) * 512 + bj * HALF) = w;
                    }
            }
        } else {
#pragma unroll
            for (int bj = 0; bj < 2; ++bj)
#pragma unroll
                for (int ai = 0; ai < 2; ++ai)
#pragma unroll
                    for (int m = 0; m < 4; ++m) {
                        const f32x4 v0 = acc[ai][bj][m][0], v1 = acc[ai][bj][m][1];
                        u32x4 w; w.x = pk2(v0[0], v0[1]); w.y = pk2(v0[2], v0[3]); w.z = pk2(v1[0], v1[1]); w.w = pk2(v1[2], v1[3]);
                        *(u32x4*)(GG + rbase + (size_t)(ai * HALF + m * 16) * 512 + bj * HALF) = w;
                    }
        }
    }
};
}

#define XB_TMO      128
#define XB_XCNT(j)  (256  + 64 * (j))
#define XB_XSUB(j)  (1280 + 64 * (j))
#define XB_XGEN(j)  (2304 + 64 * (j))
#define XB_TOP      3328
#define XB_TOPGEN   3392
#define XCD_BAR_WORDS 3456
#define XB_SPIN_CAP (1u << 22)
__device__ __forceinline__ unsigned xb_ld(unsigned* p)              { return __hip_atomic_load(p, __ATOMIC_RELAXED, __HIP_MEMORY_SCOPE_AGENT); }
__device__ __forceinline__ unsigned xb_add(unsigned* p, unsigned v) { return __hip_atomic_fetch_add(p, v, __ATOMIC_RELAXED, __HIP_MEMORY_SCOPE_AGENT); }
__device__ __forceinline__ unsigned xb_xcc_id() { return (unsigned)__builtin_amdgcn_s_getreg((3 << 11) | 20) & 0xFu; }
#define XB_SPIN(cond, bar) do { unsigned _sp = 0; while (cond) { __builtin_amdgcn_s_sleep(1); \
    if ((++_sp & 255u) == 0u) { if (xb_ld(&(bar)[XB_TMO])) break; if (_sp > XB_SPIN_CAP) { atomicAdd(&(bar)[XB_TMO], 1u); break; } } } } while (0)
struct XcdBarrier { unsigned* bar; unsigned x; volatile LAS unsigned* st; };
__device__ __forceinline__ XcdBarrier xcd_barrier_post(unsigned* bar, volatile LAS unsigned* st) {
    XcdBarrier b; b.bar = bar; b.x = xb_xcc_id(); b.st = st;
    if (threadIdx.x == 0) (void)xb_add(&bar[XB_XCNT(b.x)], 1u);
    return b;
}
__device__ __forceinline__ void xcd_barrier_complete(unsigned* bar, unsigned x, unsigned& nloc, unsigned& nx) {
    const unsigned G = gridDim.x * gridDim.y * gridDim.z;
    unsigned sum, cnt, mine, sp = 0u;
    for (;;) {
        sum = 0u; cnt = 0u; mine = 0u;
#pragma unroll
        for (unsigned j = 0; j < 16; ++j) { const unsigned c = xb_ld(&bar[XB_XCNT(j)]); sum += c; cnt += (c > 0u) ? 1u : 0u; mine = (j == x) ? c : mine; }
        if (sum == G) break;
        __builtin_amdgcn_s_sleep(1);
        if ((++sp & 255u) == 0u) { if (xb_ld(&bar[XB_TMO])) break; if (sp > XB_SPIN_CAP) { atomicAdd(&bar[XB_TMO], 1u); break; } }
    }
    nloc = mine > 0u ? mine : 1u; nx = cnt > 0u ? cnt : 1u;
}
__device__ __forceinline__ void xcd_barrier(const XcdBarrier& b) {
    asm volatile("s_waitcnt vmcnt(0)" ::: "memory");
    __syncthreads();
    if (threadIdx.x == 0) {
        unsigned* bar = b.bar;
        __builtin_amdgcn_s_waitcnt(0);
        unsigned nloc = b.st[0], nx = b.st[1];
        if (nloc == 0u) { xcd_barrier_complete(bar, b.x, nloc, nx); b.st[0] = nloc; b.st[1] = nx; }
        const unsigned old = xb_add(&bar[XB_XSUB(b.x)], 1u);
        const unsigned gen = old / nloc;
        if (old + 1u == (gen + 1u) * nloc) {
            __builtin_amdgcn_fence(__ATOMIC_RELEASE, "agent");
            asm volatile("s_waitcnt vmcnt(0)" ::: "memory");
            const unsigned og = xb_add(&bar[XB_TOP], 1u);
            const unsigned tg = og / nx;
            if (og + 1u == (tg + 1u) * nx) xb_add(&bar[XB_TOPGEN], 1u);
            else XB_SPIN(xb_ld(&bar[XB_TOPGEN]) == tg, bar);
            __builtin_amdgcn_fence(__ATOMIC_ACQUIRE, "agent");
            xb_add(&bar[XB_XGEN(b.x)], 1u);
            asm volatile("s_waitcnt vmcnt(0)" ::: "memory");
        } else {
            XB_SPIN(xb_ld(&bar[XB_XGEN(b.x)]) == gen, bar);
            __builtin_amdgcn_fence(__ATOMIC_ACQUIRE, "agent");
            asm volatile("s_waitcnt vmcnt(0)" ::: "memory");
        }
    }
    __syncthreads();
}

struct Args { const float* in[33]; float* out; unsigned char* ws; int ph_lo, ph_hi, probe, pad; };

#define LDS_WAIT() asm volatile("s_waitcnt lgkmcnt(0)" ::: "memory")

__device__ __forceinline__ void p0_transpose_item(const float* W, int K, int Nsrc, bf16* WT, int dest_row0, int k0, int n0, LAS float* scr, int lane) {
    const int c4 = 4 * (lane & 15), kr = lane >> 4; const bool ok = (n0 + c4) < Nsrc;
    f32x4 tv[16];
#pragma unroll
    for (int i = 0; i < 16; ++i) { const int kk = 4 * i + kr; tv[i] = ok ? __builtin_nontemporal_load((const f32x4*)(W + (size_t)(k0 + kk) * Nsrc + n0 + c4)) : (f32x4){0.f, 0.f, 0.f, 0.f}; }
#pragma unroll
    for (int i = 0; i < 16; ++i) { const int kk = 4 * i + kr; LAS float* d = scr + kk * 65 + c4; d[0] = tv[i].x; d[1] = tv[i].y; d[2] = tv[i].z; d[3] = tv[i].w; }
    LDS_WAIT(); asm volatile("" ::: "memory");
    const int c = lane & 7;
#pragma unroll
    for (int j = 0; j < 8; ++j) { const int n = (lane >> 3) + 8 * j; const LAS float* sp = scr + (8 * c) * 65 + n;
        u32x4 o; o.x = pk2(sp[0 * 65], sp[1 * 65]); o.y = pk2(sp[2 * 65], sp[3 * 65]); o.z = pk2(sp[4 * 65], sp[5 * 65]); o.w = pk2(sp[6 * 65], sp[7 * 65]);
        *(u32x4*)(WT + (size_t)(dest_row0 + n) * K + k0 + 8 * c) = o; }
    LDS_WAIT(); asm volatile("" ::: "memory");
}
struct P0Item { const float* src; bf16* dst; int K, Nsrc, dest_row0, k0, n0; };
__device__ __forceinline__ P0Item p0_expert_desc(const Args& args, unsigned char* ws, int e, int q) {
    P0Item it;
    if (q < 128) {
        const int which = q >> 6, qq = q & 63, kb = qq / 4, nb = qq % 4, n0 = 64 * nb;
        it.src = (e < 256) ? args.in[which ? 28 : 27] + (size_t)e * 1024 * 256 : args.in[which ? 31 : 30];
        it.dst = (bf16*)(ws + WS_W13T) + (size_t)e * 512 * 1024; it.K = 1024; it.Nsrc = 256; it.dest_row0 = (n0 >> 7) * 256 + (n0 & 127) + which * 128; it.k0 = 64 * kb; it.n0 = n0;
    } else {
        const int qq = q - 128, kb = qq / 16, nb = qq % 16;
        it.src = (e < 256) ? args.in[29] + (size_t)e * 256 * 1024 : args.in[32];
        it.dst = (bf16*)(ws + WS_W2T) + (size_t)e * 1024 * 256; it.K = 256; it.Nsrc = 1024; it.dest_row0 = 64 * nb; it.k0 = 64 * kb; it.n0 = 64 * nb;
    }
    return it;
}
__device__ __forceinline__ void p0_expert_item(const Args& args, unsigned char* ws, int e, int q, LAS float* scr, int lane) {
    const P0Item it = p0_expert_desc(args, ws, e, q);
    p0_transpose_item(it.src, it.K, it.Nsrc, it.dst, it.dest_row0, it.k0, it.n0, scr, lane);
}
__device__ __forceinline__ void p0_expert_wave(const Args& args, unsigned char* ws, int e, int qbeg, int qend, int wave, LAS float* scr, int lane) {
    const int c4 = 4 * (lane & 15), kr = lane >> 4, c = lane & 7;
    LAS unsigned* S = (LAS unsigned*)scr;
    f32x4 tv[16];
    P0Item cur = p0_expert_desc(args, ws, e, qbeg + wave);
#pragma unroll
    for (int i = 0; i < 16; ++i) tv[i] = __builtin_nontemporal_load((const f32x4*)(cur.src + (size_t)(cur.k0 + 8 * (i >> 1) + 2 * kr + (i & 1)) * cur.Nsrc + cur.n0 + c4));
    auto step = [&](int q) {
#pragma unroll
        for (int i = 0; i < 8; ++i) { LAS unsigned* d = S + c4 * 33 + 4 * i + kr;
            d[0] = pk2(tv[2 * i].x, tv[2 * i + 1].x); d[33] = pk2(tv[2 * i].y, tv[2 * i + 1].y); d[66] = pk2(tv[2 * i].z, tv[2 * i + 1].z); d[99] = pk2(tv[2 * i].w, tv[2 * i + 1].w); }
        const P0Item nxt = p0_expert_desc(args, ws, e, (q + 8 < qend) ? q + 8 : q);
#pragma unroll
        for (int i = 0; i < 16; ++i) tv[i] = __builtin_nontemporal_load((const f32x4*)(nxt.src + (size_t)(nxt.k0 + 8 * (i >> 1) + 2 * kr + (i & 1)) * nxt.Nsrc + nxt.n0 + c4));
        LDS_WAIT(); asm volatile("" ::: "memory");
#pragma unroll
        for (int j = 0; j < 8; ++j) { const int n = (lane >> 3) + 8 * j; const LAS unsigned* sp = S + n * 33 + 4 * c;
            u32x4 o; o.x = sp[0]; o.y = sp[1]; o.z = sp[2]; o.w = sp[3];
            __builtin_nontemporal_store(o, (u32x4*)(cur.dst + (size_t)(cur.dest_row0 + n) * cur.K + cur.k0 + 8 * c)); }
        LDS_WAIT(); asm volatile("" ::: "memory");
        cur = nxt;
    };
    step(qbeg + wave);
#pragma unroll 1
    for (int q = qbeg + wave + 8; q < qend; q += 8) step(q);
}
__device__ __forceinline__ float wave_sum(float v) {
#pragma unroll
    for (int o = 1; o < 64; o <<= 1) v += __shfl_xor(v, o);
    return v;
}
__device__ __forceinline__ void norm_mod_rows16(const float* xbase, const float* g, const float* shift, const float* scale, bf16* obase, int lane) {
    f32x4 gs[4], sh[4];
#pragma unroll
    for (int j = 0; j < 4; ++j) { gs[j] = ((const f32x4*)g)[lane + 64 * j] * (((const f32x4*)scale)[lane + 64 * j] + 1.0f); sh[j] = ((const f32x4*)shift)[lane + 64 * j]; }
#pragma unroll 1
    for (int r = 0; r < 16; r += 2) {
        const f32x4* x0 = (const f32x4*)(xbase + (size_t)r * DM) + lane; const f32x4* x1 = x0 + DM / 4;
        f32x4 v0[4], v1[4]; float s0 = 0.f, s1 = 0.f;
#pragma unroll
        for (int j = 0; j < 4; ++j) { v0[j] = x0[64 * j]; v1[j] = x1[64 * j]; }
#pragma unroll
        for (int j = 0; j < 4; ++j) { s0 += (v0[j].x * v0[j].x + v0[j].y * v0[j].y) + (v0[j].z * v0[j].z + v0[j].w * v0[j].w); s1 += (v1[j].x * v1[j].x + v1[j].y * v1[j].y) + (v1[j].z * v1[j].z + v1[j].w * v1[j].w); }
        const float r0 = 1.0f / sqrtf(wave_sum(s0) * (1.f / DM) + 1e-6f), r1 = 1.0f / sqrtf(wave_sum(s1) * (1.f / DM) + 1e-6f);
        unsigned long long* o0 = (unsigned long long*)(obase + (size_t)r * DM) + lane; unsigned long long* o1 = o0 + DM / 4;
#pragma unroll
        for (int j = 0; j < 4; ++j) {
            const f32x4 y0 = v0[j] * r0 * gs[j] + sh[j], y1 = v1[j] * r1 * gs[j] + sh[j];
            o0[64 * j] = (unsigned long long)pk2(y0.x, y0.y) | ((unsigned long long)pk2(y0.z, y0.w) << 32);
            o1[64 * j] = (unsigned long long)pk2(y1.x, y1.y) | ((unsigned long long)pk2(y1.z, y1.w) << 32);
        }
    }
}

__device__ __forceinline__ void norm_mod_rows16_bf(const bf16* xbase, const float* g, const float* shift, const float* scale, bf16* obase, int lane) {
    f32x4 gs[4], sh[4];
#pragma unroll
    for (int j = 0; j < 4; ++j) { gs[j] = ((const f32x4*)g)[lane + 64 * j] * (((const f32x4*)scale)[lane + 64 * j] + 1.0f); sh[j] = ((const f32x4*)shift)[lane + 64 * j]; }
#pragma unroll 1
    for (int r = 0; r < 16; r += 2) {
        const u32x2* x0 = (const u32x2*)(xbase + (size_t)r * DM) + lane; const u32x2* x1 = x0 + DM / 4;
        u32x2 w0[4], w1[4]; f32x4 v0[4], v1[4]; float s0 = 0.f, s1 = 0.f;
#pragma unroll
        for (int j = 0; j < 4; ++j) { w0[j] = x0[64 * j]; w1[j] = x1[64 * j]; }
#pragma unroll
        for (int j = 0; j < 4; ++j) { v0[j] = (f32x4){lo16(w0[j].x), hi16(w0[j].x), lo16(w0[j].y), hi16(w0[j].y)}; v1[j] = (f32x4){lo16(w1[j].x), hi16(w1[j].x), lo16(w1[j].y), hi16(w1[j].y)};
            s0 += (v0[j].x * v0[j].x + v0[j].y * v0[j].y) + (v0[j].z * v0[j].z + v0[j].w * v0[j].w); s1 += (v1[j].x * v1[j].x + v1[j].y * v1[j].y) + (v1[j].z * v1[j].z + v1[j].w * v1[j].w); }
        const float r0 = 1.0f / sqrtf(wave_sum(s0) * (1.f / DM) + 1e-6f), r1 = 1.0f / sqrtf(wave_sum(s1) * (1.f / DM) + 1e-6f);
        unsigned long long* o0 = (unsigned long long*)(obase + (size_t)r * DM) + lane; unsigned long long* o1 = o0 + DM / 4;
#pragma unroll
        for (int j = 0; j < 4; ++j) {
            const f32x4 y0 = v0[j] * r0 * gs[j] + sh[j], y1 = v1[j] * r1 * gs[j] + sh[j];
            o0[64 * j] = (unsigned long long)pk2(y0.x, y0.y) | ((unsigned long long)pk2(y0.z, y0.w) << 32);
            o1[64 * j] = (unsigned long long)pk2(y1.x, y1.y) | ((unsigned long long)pk2(y1.z, y1.w) << 32);
        }
    }
}

__device__ __forceinline__ float quad_sum(float x) {
    x += __builtin_bit_cast(float, __builtin_amdgcn_update_dpp(0, __builtin_bit_cast(int, x), 0xB1, 0xF, 0xF, true));
    x += __builtin_bit_cast(float, __builtin_amdgcn_update_dpp(0, __builtin_bit_cast(int, x), 0x4E, 0xF, 0xF, true));
    return x;
}
__device__ __forceinline__ float red16(float x) { x += __shfl_xor(x, 1); x += __shfl_xor(x, 2); x += __shfl_xor(x, 4); x += __shfl_xor(x, 8); return x; }
__device__ __forceinline__ float red8(float x) { x += __shfl_xor(x, 1); x += __shfl_xor(x, 2); x += __shfl_xor(x, 4); return x; }

constexpr int CP = 80;
constexpr int MB = 64 * CP * 2;
#define CMAT(i) ((LAS bf16*)(lds + (i) * MB))
__device__ __forceinline__ f32x4 mm_tile(const LAS bf16* A, const LAS bf16* Bt, int m0, int n0, int fr, int fq, f32x4 acc) {
#pragma unroll
    for (int ks = 0; ks < 2; ++ks) {
        const bf16x8 a = *(const LAS bf16x8*)(A + (m0 + fr) * CP + 32 * ks + 8 * fq), b = *(const LAS bf16x8*)(Bt + (n0 + fr) * CP + 32 * ks + 8 * fq);
        acc = __builtin_amdgcn_mfma_f32_16x16x32_bf16(a, b, acc, 0, 0, 0);
    }
    return acc;
}
__device__ __forceinline__ void tstore(LAS bf16* dst, int m0, int n0, int fr, int fq, f32x4 v) {
    u32x2 w; w.x = pk2(v[0], v[1]); w.y = pk2(v[2], v[3]);
    *(LAS u32x2*)(dst + (n0 + fr) * CP + m0 + 4 * fq) = w;
}
__device__ __forceinline__ void nstore(LAS bf16* dst, int m0, int n0, int fr, int fq, f32x4 v) {
#pragma unroll
    for (int r = 0; r < 4; ++r) dst[(m0 + 4 * fq + r) * CP + n0 + fr] = (bf16)f2bf(v[r]);
}
__device__ __forceinline__ void scan_job(LAS unsigned char* lds, int job, const unsigned char* ws, const float* r_k, const float* ln_w, const float* ln_b, const float* k_k, const float* k_a, int tid, int lane, int wave, int pmode) {
#define REPS(k) for (int _rp = 0; _rp < ((pmode == 10 + (k)) ? 5 : 1); ++_rp)
    const bf16* XR = (const bf16*)(ws + WS_XR); const bf16* EE = (const bf16*)(ws + WS_EE); const bf16* XK = (const bf16*)(ws + WS_XK);
    const bf16* XV = (const bf16*)(ws + WS_XV); const bf16* KKN = (const bf16*)(ws + WS_KKN); const bf16* BV = (const bf16*)(ws + WS_BV);
    const bf16* GG = (const bf16*)(ws + WS_GG); bf16* YC = (bf16*)(ws + WS_H);
    asm volatile("" : "+v"(tid), "+v"(lane));
    const int b = job >> 3, h = job & 7;
    const int fr = lane & 15, fq = lane >> 4;
    const int tm0 = 16 * (wave >> 1), tn0 = 32 * (wave & 1);
    const int et = tid >> 3, ej = 8 * (tid & 7);
    LAS bf16* Kt = CMAT(0); LAS bf16* Rt = CMAT(1); LAS bf16* Kh = CMAT(2); LAS bf16* Bh = CMAT(3); LAS bf16* KgT = CMAT(4); LAS bf16* BgT = CMAT(5); LAS bf16* VT = CMAT(6);
    LAS bf16* Akk = CMAT(7); LAS bf16* Lm = CMAT(8); LAS bf16* LT = CMAT(9); LAS bf16* Ark = CMAT(10); LAS bf16* Arb = CMAT(11);
    LAS float* Ebuf = (LAS float*)(lds + 7 * MB);
    LAS float* Ybuf = (LAS float*)(lds + 2 * MB);
    LAS float* gCv = (LAS float*)(lds + TAB_OFF);
    LAS float* bonv = gCv + 64;
    LAS float* Wtot = gCv + 128;
    const size_t mbase = (size_t)b * SEQ;
    f32x4 Sreg[2]; Sreg[0] = (f32x4){0.f, 0.f, 0.f, 0.f}; Sreg[1] = Sreg[0];
    for (int i = tid; i < MB / 4; i += 512) ((LAS unsigned*)(lds + 14 * MB))[i] = 0u;
    u32x4 ld[6];
    auto issue = [&](int c) {
        const size_t off = (mbase + 64 * c + et) * 512 + h * 64 + ej;
        ld[0] = *(const u32x4*)(XR + off); ld[1] = *(const u32x4*)(EE + off); ld[2] = *(const u32x4*)(XK + off);
        ld[3] = *(const u32x4*)(XV + off); ld[4] = *(const u32x4*)(BV + off); ld[5] = *(const u32x4*)(GG + off);
    };
    LAS float* rkl = gCv + 640; LAS float* lwl = gCv + 704; LAS float* lbl = gCv + 768;
    LAS float* kkl = gCv + 832; LAS float* kal = gCv + 896;
    if (tid < 64) { rkl[tid] = r_k[h * 64 + tid]; lwl[tid] = ln_w[h * 64 + tid]; lbl[tid] = ln_b[h * 64 + tid]; kkl[tid] = k_k[h * 64 + tid]; kal[tid] = k_a[h * 64 + tid]; }
    issue(0);
    __syncthreads();
#pragma unroll 1
    for (int c = 0; c < SEQ / 64; ++c) {
        LAS bf16* S0c = CMAT(14);
        float rr[8], ee[8], kk2[8], vv[8], kn[8], bb[8];
        {
            float n2 = 0.f;
#pragma unroll
            for (int i = 0; i < 4; ++i) { const unsigned w0 = ld[0][i], w1 = ld[1][i], w2 = ld[2][i], w3 = ld[3][i], w4 = ld[4][i];
                rr[2 * i] = lo16(w0); rr[2 * i + 1] = hi16(w0); ee[2 * i] = lo16(w1); ee[2 * i + 1] = hi16(w1); kk2[2 * i] = lo16(w2); kk2[2 * i + 1] = hi16(w2);
                vv[2 * i] = lo16(w3); vv[2 * i + 1] = hi16(w3); bb[2 * i] = lo16(w4); bb[2 * i + 1] = hi16(w4); }
#pragma unroll
            for (int i = 0; i < 8; ++i) { kn[i] = kk2[i] * kkl[ej + i]; n2 += kn[i] * kn[i]; }
            const float inv = 1.0f / fmaxf(sqrtf(red8(n2)), 1e-12f);
#pragma unroll
            for (int i = 0; i < 8; ++i) { kn[i] *= inv; kk2[i] *= 1.0f + (bb[i] - 1.0f) * kal[ej + i]; bb[i] *= kn[i]; }
        }
        const u32x4 gw = ld[5];
        REPS(0) {
        float cum[8];
#pragma unroll
        for (int i = 0; i < 8; ++i) cum[i] = ee[i];
#pragma unroll
        for (int o = 8; o < 64; o <<= 1) {
#pragma unroll
            for (int i = 0; i < 8; ++i) { const float y = __shfl_up(cum[i], o); if (lane >= o) cum[i] += y; } }
        if (lane >= 56) { *(LAS f32x4*)(Wtot + wave * 64 + ej) = (f32x4){cum[0], cum[1], cum[2], cum[3]}; *(LAS f32x4*)(Wtot + wave * 64 + ej + 4) = (f32x4){cum[4], cum[5], cum[6], cum[7]}; }
        __syncthreads();
        {
            float off[8], cumC[8];
#pragma unroll
            for (int i = 0; i < 8; ++i) { off[i] = 0.f; cumC[i] = 0.f; }
#pragma unroll
            for (int w = 0; w < 8; ++w) { const f32x4 a = *(const LAS f32x4*)(Wtot + w * 64 + ej), bq = *(const LAS f32x4*)(Wtot + w * 64 + ej + 4);
                const float tv[8] = {a.x, a.y, a.z, a.w, bq.x, bq.y, bq.z, bq.w};
#pragma unroll
                for (int i = 0; i < 8; ++i) { cumC[i] += tv[i]; off[i] += (w < wave) ? tv[i] : 0.f; } }
            float bsum = 0.f;
            unsigned pkt[4], prt[4], pkh[4], pbh[4], pkg[4], pbg[4], pvn[4]; float okt[8], ort[8], okh[8], obh[8], okg[8], obg[8];
#pragma unroll
            for (int i = 0; i < 8; ++i) {
                const float cm = cum[i] + off[i], cc = cumC[i];
                const float g = __expf(-cm), gp = __expf(ee[i] - cm), gi = __expf(cm), gc = __expf(cm - cc);
                okt[i] = kn[i] * gp; ort[i] = rr[i] * g; okh[i] = kk2[i] * gi; obh[i] = bb[i] * gi; okg[i] = kk2[i] * gc; obg[i] = bb[i] * gc;
                if (et == 63) gCv[ej + i] = __expf(-cc);
                bsum += rr[i] * kk2[i] * rkl[ej + i];
            }
#pragma unroll
            for (int i = 0; i < 4; ++i) { pkt[i] = pk2(okt[2 * i], okt[2 * i + 1]); prt[i] = pk2(ort[2 * i], ort[2 * i + 1]); pkh[i] = pk2(okh[2 * i], okh[2 * i + 1]); pbh[i] = pk2(obh[2 * i], obh[2 * i + 1]);
                pkg[i] = pk2(okg[2 * i], okg[2 * i + 1]); pbg[i] = pk2(obg[2 * i], obg[2 * i + 1]); pvn[i] = pk2(vv[2 * i], vv[2 * i + 1]); }
            *(LAS u32x4*)(Kt + et * CP + ej) = (u32x4){pkt[0], pkt[1], pkt[2], pkt[3]}; *(LAS u32x4*)(Rt + et * CP + ej) = (u32x4){prt[0], prt[1], prt[2], prt[3]};
            *(LAS u32x4*)(Kh + et * CP + ej) = (u32x4){pkh[0], pkh[1], pkh[2], pkh[3]}; *(LAS u32x4*)(Bh + et * CP + ej) = (u32x4){pbh[0], pbh[1], pbh[2], pbh[3]};
            *(LAS u32x4*)(CMAT(9) + et * CP + ej) = (u32x4){pkg[0], pkg[1], pkg[2], pkg[3]}; *(LAS u32x4*)(CMAT(10) + et * CP + ej) = (u32x4){pbg[0], pbg[1], pbg[2], pbg[3]};
            *(LAS u32x4*)(CMAT(11) + et * CP + ej) = (u32x4){pvn[0], pvn[1], pvn[2], pvn[3]};
            bsum = red8(bsum);
            if ((tid & 7) == 0) bonv[et] = bsum;
        }
        __syncthreads();
        {
            const int tj = tid & 63, tb = 8 * (tid >> 6);
#pragma unroll
            for (int mtx = 0; mtx < 3; ++mtx) {
                const LAS bf16* src = CMAT(9 + mtx); LAS bf16* dst = CMAT(4 + mtx); unsigned e[8];
#pragma unroll
                for (int i = 0; i < 8; ++i) e[i] = src[(tb + i) * CP + tj];
                *(LAS u32x4*)(dst + tj * CP + tb) = (u32x4){e[0] | (e[1] << 16), e[2] | (e[3] << 16), e[4] | (e[5] << 16), e[6] | (e[7] << 16)};
            }
        }
        __syncthreads();
        }
        if (c + 1 < SEQ / 64) issue(c + 1);
        const f32x4 z4 = (f32x4){0.f, 0.f, 0.f, 0.f};
        REPS(1) {
#pragma unroll
        for (int tt = 0; tt < 2; ++tt) {
            const int m0 = tm0, n0 = tn0 + 16 * tt;
            f32x4 a1 = z4, a2 = z4, a3 = z4, a4 = z4, a5 = z4;
            if (m0 <= n0) { a1 = mm_tile(Kh, Kt, m0, n0, fr, fq, z4); a2 = mm_tile(Bh, Kt, m0, n0, fr, fq, z4); a4 = mm_tile(Kh, Rt, m0, n0, fr, fq, z4); a5 = mm_tile(Bh, Rt, m0, n0, fr, fq, z4); }
            if (m0 >= n0) a3 = mm_tile(Kt, Bh, m0, n0, fr, fq, z4);
#pragma unroll
            for (int r = 0; r < 4; ++r) { const int mi = m0 + 4 * fq + r, ni = n0 + fr;
                if (!(mi < ni)) { a1[r] = 0.f; a2[r] = 0.f; } if (!(mi <= ni)) { a4[r] = 0.f; a5[r] = 0.f; } if (!(ni < mi)) a3[r] = 0.f; }
            tstore(Akk, m0, n0, fr, fq, a1); tstore(Lm, m0, n0, fr, fq, a2); tstore(LT, m0, n0, fr, fq, a3); tstore(Ark, m0, n0, fr, fq, a4); tstore(Arb, m0, n0, fr, fq, a5);
        }
        __syncthreads();
        }
        REPS(2) {
            LAS bf16* Pw = CMAT(2); LAS bf16* PwT = CMAT(3); LAS bf16* Tm = CMAT(12);
#pragma unroll
            for (int tt = 0; tt < 2; ++tt) { const int m0 = tm0, n0 = tn0 + 16 * tt;
                const f32x4 p2 = mm_tile(Lm, LT, m0, n0, fr, fq, z4); tstore(PwT, m0, n0, fr, fq, p2); nstore(Pw, m0, n0, fr, fq, p2); }
            const u32x4 lw = *(const LAS u32x4*)(Lm + et * CP + ej); const unsigned lwa[4] = {lw.x, lw.y, lw.z, lw.w}; unsigned o[4];
#pragma unroll
            for (int i = 0; i < 4; ++i) { const float x0 = ((ej + 2 * i) == et ? 1.f : 0.f) - lo16(lwa[i]), x1 = ((ej + 2 * i + 1) == et ? 1.f : 0.f) - hi16(lwa[i]); o[i] = pk2(x0, x1); }
            *(LAS u32x4*)(Tm + et * CP + ej) = (u32x4){o[0], o[1], o[2], o[3]};
        __syncthreads();
        }
        REPS(3)
#pragma unroll 1
        for (int sidx = 0; sidx < 5; ++sidx) {
            LAS bf16* Pw = CMAT((sidx & 1) ? 8 : 2); LAS bf16* PwT = CMAT((sidx & 1) ? 9 : 3); LAS bf16* PwN = CMAT((sidx & 1) ? 2 : 8); LAS bf16* PwNT = CMAT((sidx & 1) ? 3 : 9);
            LAS bf16* Tm = CMAT(12 + (sidx & 1)); LAS bf16* TmN = CMAT(13 - (sidx & 1));
            const LAS bf16* fa = PwT + (tm0 + fr) * CP + 8 * fq; const LAS bf16* fb = Pw + (tm0 + fr) * CP + 8 * fq;
            const bf16x8 aT0 = *(const LAS bf16x8*)fa, aT1 = *(const LAS bf16x8*)(fa + 32), aP0 = *(const LAS bf16x8*)fb, aP1 = *(const LAS bf16x8*)(fb + 32);
            bf16x8 bT[2][2], bP[2][2]; u32x2 tw[2];
#pragma unroll
            for (int tt = 0; tt < 2; ++tt) { const int n0 = tn0 + 16 * tt;
                const LAS bf16* ft = Tm + (n0 + fr) * CP + 8 * fq; const LAS bf16* fp = PwT + (n0 + fr) * CP + 8 * fq;
                bT[tt][0] = *(const LAS bf16x8*)ft; bT[tt][1] = *(const LAS bf16x8*)(ft + 32); bP[tt][0] = *(const LAS bf16x8*)fp; bP[tt][1] = *(const LAS bf16x8*)(fp + 32);
                tw[tt] = *(const LAS u32x2*)(Tm + (n0 + fr) * CP + tm0 + 4 * fq); }
            f32x4 at[2], pt[2];
#pragma unroll
            for (int tt = 0; tt < 2; ++tt) {
                at[tt] = __builtin_amdgcn_mfma_f32_16x16x32_bf16(aT0, bT[tt][0], z4, 0, 0, 0); pt[tt] = __builtin_amdgcn_mfma_f32_16x16x32_bf16(aP0, bP[tt][0], z4, 0, 0, 0); }
#pragma unroll
            for (int tt = 0; tt < 2; ++tt) {
                at[tt] = __builtin_amdgcn_mfma_f32_16x16x32_bf16(aT1, bT[tt][1], at[tt], 0, 0, 0); pt[tt] = __builtin_amdgcn_mfma_f32_16x16x32_bf16(aP1, bP[tt][1], pt[tt], 0, 0, 0); }
#pragma unroll
            for (int tt = 0; tt < 2; ++tt) { const int m0 = tm0, n0 = tn0 + 16 * tt;
                at[tt][0] += lo16(tw[tt].x); at[tt][1] += hi16(tw[tt].x); at[tt][2] += lo16(tw[tt].y); at[tt][3] += hi16(tw[tt].y);
                tstore(TmN, m0, n0, fr, fq, at[tt]); tstore(PwNT, m0, n0, fr, fq, pt[tt]); nstore(PwN, m0, n0, fr, fq, pt[tt]);
            }
            __syncthreads();
        }
        LAS bf16* TmF = CMAT(13);
        LAS bf16* UT = CMAT(8); LAS bf16* SAT = CMAT(9);
        REPS(4) {
#pragma unroll
        for (int tt = 0; tt < 2; ++tt) { const int m0 = tm0, n0 = tn0 + 16 * tt;
            f32x4 a = mm_tile(Kt, S0c, m0, n0, fr, fq, z4); a = mm_tile(Akk, VT, m0, n0, fr, fq, a); tstore(UT, m0, n0, fr, fq, a); }
        __syncthreads();
        }
        REPS(5) {
#pragma unroll
        for (int tt = 0; tt < 2; ++tt) { const int m0 = tm0, n0 = tn0 + 16 * tt; tstore(SAT, m0, n0, fr, fq, mm_tile(TmF, UT, m0, n0, fr, fq, z4)); }
        __syncthreads();
        }
        REPS(6) {
#pragma unroll
        for (int tt = 0; tt < 2; ++tt) { const int m0 = tm0, n0 = tn0 + 16 * tt;
            f32x4 y = mm_tile(Rt, S0c, m0, n0, fr, fq, z4); y = mm_tile(Ark, VT, m0, n0, fr, fq, y); const f32x4 y2 = mm_tile(Arb, SAT, m0, n0, fr, fq, z4);
#pragma unroll
            for (int r = 0; r < 4; ++r) Ybuf[(m0 + 4 * fq + r) * 64 + n0 + fr] = y[r] - y2[r];
            f32x4 sn = mm_tile(KgT, VT, m0, n0, fr, fq, z4); const f32x4 s2 = mm_tile(BgT, SAT, m0, n0, fr, fq, z4);
            const f32x4 gc4 = *(const LAS f32x4*)(gCv + m0 + 4 * fq);
            sn = gc4 * Sreg[tt] + sn - s2; Sreg[tt] = sn;
        }
        __syncthreads();
#pragma unroll
        for (int tt = 0; tt < 2; ++tt) tstore(S0c, tm0, tn0 + 16 * tt, fr, fq, Sreg[tt]);
        }
        REPS(7) {
            const f32x4 ya = *(const LAS f32x4*)(Ybuf + et * 64 + ej), yb = *(const LAS f32x4*)(Ybuf + et * 64 + ej + 4);
            float y[8] = {ya.x, ya.y, ya.z, ya.w, yb.x, yb.y, yb.z, yb.w};
            float sm = 0.f;
#pragma unroll
            for (int i = 0; i < 8; ++i) sm += y[i];
            const float mean = red8(sm) * (1.f / 64.f); float sq = 0.f;
#pragma unroll
            for (int i = 0; i < 8; ++i) { y[i] -= mean; sq += y[i] * y[i]; }
            const float rs = 1.0f / sqrtf(red8(sq) * (1.f / 64.f) + 64e-5f);
            const float bon = bonv[et];
            const size_t mrow = mbase + 64 * c + et;
            const unsigned gwa[4] = {gw.x, gw.y, gw.z, gw.w};
            unsigned o[4];
#pragma unroll
            for (int i = 0; i < 4; ++i) {
                const float o0 = ((y[2 * i] * rs) * lwl[ej + 2 * i] + lbl[ej + 2 * i] + vv[2 * i] * bon) * lo16(gwa[i]), o1 = ((y[2 * i + 1] * rs) * lwl[ej + 2 * i + 1] + lbl[ej + 2 * i + 1] + vv[2 * i + 1] * bon) * hi16(gwa[i]);
                o[i] = pk2(o0, o1); }
            *(u32x4*)(YC + mrow * 1024 + h * 64 + ej) = (u32x4){o[0], o[1], o[2], o[3]};
        }
    }
    __syncthreads();
}

__device__ __forceinline__ unsigned sortable(float f) { const unsigned u = __float_as_uint(f); return (u & 0x80000000u) ? ~u : (u | 0x80000000u); }
#define MFMA32(a, b, c) __builtin_amdgcn_mfma_f32_32x32x16_bf16((a), (b), (c), 0, 0, 0)
__device__ __forceinline__ int wave_sum_i(int v) {
    v += __builtin_amdgcn_update_dpp(0, v, 0xB1, 0xF, 0xF, true);
    v += __builtin_amdgcn_update_dpp(0, v, 0x4E, 0xF, 0xF, true);
    v += __builtin_amdgcn_update_dpp(0, v, 0x141, 0xF, 0xF, true);
    v += __builtin_amdgcn_update_dpp(0, v, 0x140, 0xF, 0xF, true);
    v += __builtin_amdgcn_update_dpp(0, v, 0x142, 0xA, 0xF, true);
    v += __builtin_amdgcn_update_dpp(0, v, 0x143, 0xC, 0xF, true);
    return __builtin_amdgcn_readlane(v, 63);
}
__device__ __forceinline__ int wave_prefix_i(int v) {
    v += __builtin_amdgcn_update_dpp(0, v, 0x111, 0xF, 0xF, false);
    v += __builtin_amdgcn_update_dpp(0, v, 0x112, 0xF, 0xF, false);
    v += __builtin_amdgcn_update_dpp(0, v, 0x114, 0xF, 0xF, false);
    v += __builtin_amdgcn_update_dpp(0, v, 0x118, 0xF, 0xF, false);
    v += __builtin_amdgcn_update_dpp(0, v, 0x142, 0xA, 0xF, false);
    v += __builtin_amdgcn_update_dpp(0, v, 0x143, 0xC, 0xF, false);
    return v;
}
constexpr int HWORDS = 2368;
template <int NR>
__device__ __forceinline__ void radix_pass(const unsigned (&k)[NR], LAS unsigned* H, int lane, int shift, unsigned binmask, bool pred, int pshift, unsigned pval, int need, int& Bout, int& above_out, int& inbin_out) {
    const u32x4 z = (u32x4){0u, 0u, 0u, 0u};
#pragma unroll
    for (int q = 0; q < 9; ++q) ((LAS u32x4*)H)[lane + 64 * q] = z;
    asm volatile("" ::: "memory");
#pragma unroll
    for (int i = 0; i < NR; ++i) {
        const unsigned bin = (k[i] >> shift) & binmask; unsigned a = bin + 4u * (bin >> 5);
        if (pred) a = ((k[i] >> pshift) == pval) ? a : (2304u + (unsigned)lane);
        __hip_atomic_fetch_add(H + a, 1u, __ATOMIC_RELAXED, __HIP_MEMORY_SCOPE_WORKGROUP);
    }
    asm volatile("s_waitcnt lgkmcnt(0)" ::: "memory");
    const int blk = 63 - lane;
    int tot = 0;
#pragma unroll
    for (int q = 0; q < 8; ++q) { const u32x4 v = ((const LAS u32x4*)(H + 36 * blk))[q]; tot += (int)(v.x + v.y + v.z + v.w); }
    const int inc = wave_prefix_i(tot);
    const int A = inc - tot;
    const unsigned long long cross = __ballot(A < need && inc >= need);
    const int Ll = __builtin_ctzll(cross);
    const int Aab = __builtin_amdgcn_readlane(A, Ll);
    const int Bblk = 63 - Ll;
    const int h = (lane < 32) ? (int)H[36 * Bblk + 31 - lane] : 0;
    const int inc2 = wave_prefix_i(h);
    const int a2 = inc2 - h;
    const unsigned long long cross2 = __ballot(lane < 32 && (Aab + a2 < need) && (Aab + inc2 >= need));
    const int js = __builtin_ctzll(cross2);
    Bout = 32 * Bblk + 31 - js; above_out = Aab + __builtin_amdgcn_readlane(a2, js); inbin_out = __builtin_amdgcn_readlane(h, js);
}
template <int NR>
__device__ __forceinline__ void radix_pass1(const unsigned (&k)[NR], LAS unsigned* H, int lane, int need, int& Bout, int& above_out, int& inbin_out) {
    const u32x4 z = (u32x4){0u, 0u, 0u, 0u};
#pragma unroll
    for (int q = 0; q < 9; ++q) ((LAS u32x4*)H)[lane + 64 * q] = z;
    asm volatile("" ::: "memory");
#pragma unroll
    for (int i = 0; i < NR; ++i) { const unsigned vb = ((k[i] >> 24) << 3) | (unsigned)(lane & 7); __hip_atomic_fetch_add(H + vb + 4u * (vb >> 5), 1u, __ATOMIC_RELAXED, __HIP_MEMORY_SCOPE_WORKGROUP); }
    asm volatile("s_waitcnt lgkmcnt(0)" ::: "memory");
    const int blk = 63 - lane;
    int tot = 0;
#pragma unroll
    for (int q = 0; q < 8; ++q) { const u32x4 v = ((const LAS u32x4*)(H + 36 * blk))[q]; tot += (int)(v.x + v.y + v.z + v.w); }
    const int inc = wave_prefix_i(tot);
    const int A = inc - tot;
    const unsigned long long cross = __ballot(A < need && inc >= need);
    const int Ll = __builtin_ctzll(cross);
    const int Aab = __builtin_amdgcn_readlane(A, Ll);
    const int Bblk = 63 - Ll;
    int h = 0;
    if (lane < 4) { const LAS u32x4* hp = (const LAS u32x4*)(H + 36 * Bblk + 8 * (3 - lane)); const u32x4 v0 = hp[0], v1 = hp[1]; h = (int)(v0.x + v0.y + v0.z + v0.w + v1.x + v1.y + v1.z + v1.w); }
    const int inc2 = wave_prefix_i(h);
    const int a2 = inc2 - h;
    const unsigned long long cross2 = __ballot(lane < 4 && (Aab + a2 < need) && (Aab + inc2 >= need));
    const int js = __builtin_ctzll(cross2);
    Bout = 4 * Bblk + 3 - js; above_out = Aab + __builtin_amdgcn_readlane(a2, js); inbin_out = __builtin_amdgcn_readlane(h, js);
}
template <int NR>
__device__ __forceinline__ void dsa_select2(const LAS unsigned* SC, LAS unsigned* MK, LAS unsigned* HB, int sub, int wave, int lane, int nk, int pmode) {
    unsigned ka[NR], kb[NR];
    const int qa = 2 * wave, qb2 = 2 * wave + 1;
#pragma unroll
    for (int i = 0; i < NR; ++i) { const int idx = 64 * i + lane; const bool ok = idx < nk; ka[i] = ok ? SC[qa * 2048 + idx] : 0u; kb[i] = ok ? SC[qb2 * 2048 + idx] : 0u; }
    __syncthreads();
    LAS unsigned* H = HB + wave * HWORDS;
#pragma unroll
    for (int which = 0; which < 2; ++which) {
        const unsigned (&k)[NR] = which ? kb : ka;
        unsigned Tt = 0x80000000u; int need = 1;
        if (pmode != 23) {
            int B, ab, cb; unsigned prefix; bool fin = false;
            radix_pass1<NR>(k, H, lane, 256, B, ab, cb);
            need = 256 - ab; prefix = (unsigned)B;
            if (need == cb && prefix != 0u) { Tt = (prefix << 24) - 1u; need = 0; fin = true; }
            if (!fin) { radix_pass<NR>(k, H, lane, 13, 2047u, true, 24, prefix, need, B, ab, cb);
                need -= ab; prefix = (prefix << 11) | (unsigned)B;
                if (need == cb) { Tt = (prefix << 13) - 1u; need = 0; fin = true; } }
            if (!fin) { radix_pass<NR>(k, H, lane, 2, 2047u, true, 13, prefix, need, B, ab, cb);
                need -= ab; prefix = (prefix << 11) | (unsigned)B;
                if (need == cb) { Tt = (prefix << 2) - 1u; need = 0; fin = true; } }
            if (!fin) { radix_pass<NR>(k, H, lane, 0, 3u, true, 2, prefix, need, B, ab, cb);
                need -= ab; Tt = (prefix << 2) | (unsigned)B; }
        }
        if (pmode != 22) {
        LAS unsigned long long* mrow = (LAS unsigned long long*)(MK + (16 * sub + 2 * wave + which) * 64);
#pragma unroll
        for (int i = 0; i < NR; ++i) {
            const unsigned kvv = k[i];
            const unsigned long long gt = __ballot(kvv > Tt), eq = __ballot(kvv == Tt);
            const int ne = __builtin_popcountll(eq);
            unsigned long long take;
            if (ne <= need) { take = eq; need -= ne; }
            else { take = 0ull; unsigned long long e2 = eq; for (int z = 0; z < need; ++z) { const unsigned long long lb = e2 & (~e2 + 1ull); take |= lb; e2 ^= lb; } need = 0; }
            if (lane == 0) mrow[i] = gt | take;
        }
        if (lane >= NR && lane < 32) mrow[lane] = 0ull;
        }
    }
}
__device__ __forceinline__ void dsa_unit(LAS unsigned char* lds, int b, int qb, const unsigned char* ws, const float* at_out_g, int tid, int lane, int wave, int pmode) {
    const bf16* P = (const bf16*)(ws + WS_P); const bf16* VF = (const bf16*)(ws + WS_VF); const bf16* KF = (const bf16*)(ws + WS_KF); const bf16* KIF = (const bf16*)(ws + WS_KIF); bf16* YC = (bf16*)(ws + WS_H);
    asm volatile("" : "+v"(tid), "+v"(lane));
    const int t0 = qb * 32, nk = t0 + 32, nkt = nk >> 5;
    LAS unsigned* SC = (LAS unsigned*)lds;
    LAS unsigned* MK = (LAS unsigned*)(lds + MASK_OFF);
    const size_t rowbase = (size_t)b * SEQ;
    const int l32 = lane & 31, hi = lane >> 5;
    f32x16 zero16;
#pragma unroll
    for (int i = 0; i < 16; ++i) zero16[i] = 0.f;
    if (qb >= 8 && pmode != 4) {
        for (int sub = 0; sub < 2; ++sub) {
            if (pmode != 6) {
            bf16x8 aq[2][4]; float wq[2][4][4];
#pragma unroll
            for (int mt = 0; mt < 2; ++mt) {
#pragma unroll
                for (int s = 0; s < 4; ++s) aq[mt][s] = *(const bf16x8*)(P + (rowbase + t0 + 16 * sub + 8 * mt + (l32 & 7)) * NP + C_QI + (l32 >> 3) * 64 + 16 * s + 8 * hi);
#pragma unroll
                for (int j = 0; j < 4; ++j) { const u32x2 w = *(const u32x2*)(P + (rowbase + t0 + 16 * sub + 8 * mt + 4 * hi + j) * NP + C_WI);
                    wq[mt][j][0] = lo16(w.x) * 0.0625f; wq[mt][j][1] = hi16(w.x) * 0.0625f; wq[mt][j][2] = lo16(w.y) * 0.0625f; wq[mt][j][3] = hi16(w.y) * 0.0625f; }
            }
            bf16x8 bkA[4], bkB[4];
#define SC_LOAD(BK_, kt_) do { const int _kt = (kt_) < nkt ? (kt_) : nkt - 1; \
                _Pragma("unroll") for (int s = 0; s < 4; ++s) BK_[s] = *(const bf16x8*)(KIF + ((((size_t)b * 64 + _kt) * 4 + s) * 64 + lane) * 8); } while (0)
#define SC_STEP(BK_, kt_) do { const bool _ok = (kt_) < nkt; { \
                _Pragma("unroll") for (int mt = 0; mt < 2; ++mt) { \
                    f32x16 acc = zero16; \
                    _Pragma("unroll") for (int s = 0; s < 4; ++s) acc = MFMA32(aq[mt][s], BK_[s], acc); \
                    _Pragma("unroll") for (int j = 0; j < 4; ++j) { \
                        float sc = 0.f; \
                        _Pragma("unroll") for (int g = 0; g < 4; ++g) sc += wq[mt][j][g] * fmaxf(acc[4 * g + j], 0.f); \
                        const int ql = 8 * mt + 4 * hi + j, tq = t0 + 16 * sub + ql, key = 32 * (kt_) + l32; \
                        unsigned u = sortable(sc); if (key > tq) u = 0u; \
                        if (_ok) SC[ql * 2048 + key] = u; } } } } while (0)
            for (int _rp = 0; _rp < (pmode == 20 ? 5 : 1); ++_rp) {
            SC_LOAD(bkA, wave);
            for (int kt = wave; kt < nkt; kt += 16) {
                SC_LOAD(bkB, kt + 8); __builtin_amdgcn_sched_barrier(0); SC_STEP(bkA, kt);
                SC_LOAD(bkA, kt + 16); __builtin_amdgcn_sched_barrier(0); SC_STEP(bkB, kt + 8);
            }
            }
#undef SC_LOAD
#undef SC_STEP
            }
            __syncthreads();
            if (pmode != 5) { const int nr8 = (nk + 511) >> 9;
              if (nr8 == 1) dsa_select2<8>(SC, MK, SC, sub, wave, lane, nk, pmode); else if (nr8 == 2) dsa_select2<16>(SC, MK, SC, sub, wave, lane, nk, pmode);
              else if (nr8 == 3) dsa_select2<24>(SC, MK, SC, sub, wave, lane, nk, pmode); else dsa_select2<32>(SC, MK, SC, sub, wave, lane, nk, pmode); }
            __syncthreads();
        }
    } else {
        for (int idx = tid; idx < 32 * 64; idx += 512) { const int qq = idx >> 6, w = idx & 63, tq = t0 + qq, lo = 32 * w;
            const unsigned m = (lo + 31 <= tq) ? 0xffffffffu : (lo > tq ? 0u : ((1u << (tq - lo + 1)) - 1u)); MK[idx] = m; }
        __syncthreads();
    }
    if (pmode != 3 && pmode != 5 && pmode != 6 && pmode < 20) {
        const int hd = wave;
        bf16x8 qf[4];
#pragma unroll
        for (int s = 0; s < 4; ++s) qf[s] = *(const bf16x8*)(P + (rowbase + t0 + l32) * NP + C_Q + 64 * hd + 16 * s + 8 * hi);
        f32x16 o0 = zero16, o1 = zero16; float lrun = 0.f;
        const bf16* Kb = KF + ((size_t)(b * 8 + hd) * 64) * 4 * 64 * 8 + (size_t)lane * 8;
        const bf16* Vb = VF + ((size_t)(b * 8 + hd) * 64) * 4 * 64 * 8 + (size_t)lane * 8;
        bf16x8 kf0[4], kf1[4], vf0[2][2], vf1[2][2];
#define ATT_LOAD(KF_, VF_, kt_) do { const int _kt = (kt_) < nkt ? (kt_) : nkt - 1; \
            _Pragma("unroll") for (int s = 0; s < 4; ++s) KF_[s] = *(const bf16x8*)(Kb + ((size_t)_kt * 4 + s) * 512); \
            _Pragma("unroll") for (int dt = 0; dt < 2; ++dt) _Pragma("unroll") for (int s2 = 0; s2 < 2; ++s2) VF_[dt][s2] = *(const bf16x8*)(Vb + (((size_t)_kt * 2 + dt) * 2 + s2) * 512); } while (0)
#define ATT_STEP(KF_, VF_, kt_) do { \
            f32x16 sacc = zero16; \
            _Pragma("unroll") for (int s = 0; s < 4; ++s) sacc = MFMA32(KF_[s], qf[s], sacc); \
            const int _kc = (kt_) < nkt ? (kt_) : nkt - 1; \
            unsigned mw = MK[l32 * 64 + _kc] >> (4 * hi); mw = ((kt_) < nkt) ? mw : 0u;     \
            float pv[16]; \
            _Pragma("unroll") for (int r = 0; r < 16; ++r) { const int sb = ((int)(mw << (31 - (8 * (r >> 2) + (r & 3))))) >> 31; \
                pv[r] = __int_as_float(__float_as_int(__builtin_amdgcn_exp2f(sacc[r])) & sb); lrun += pv[r]; } \
            bf16x8 pf[2]; \
            _Pragma("unroll") for (int s2 = 0; s2 < 2; ++s2) { u32x4 t; t.x = pk2(pv[8 * s2], pv[8 * s2 + 1]); t.y = pk2(pv[8 * s2 + 2], pv[8 * s2 + 3]); t.z = pk2(pv[8 * s2 + 4], pv[8 * s2 + 5]); t.w = pk2(pv[8 * s2 + 6], pv[8 * s2 + 7]); pf[s2] = __builtin_bit_cast(bf16x8, t); } \
            _Pragma("unroll") for (int s2 = 0; s2 < 2; ++s2) { o0 = MFMA32(VF_[0][s2], pf[s2], o0); o1 = MFMA32(VF_[1][s2], pf[s2], o1); } } while (0)
        ATT_LOAD(kf0, vf0, 0);
        for (int kt = 0; kt < nkt; kt += 2) {
            ATT_LOAD(kf1, vf1, kt + 1); __builtin_amdgcn_sched_barrier(0); ATT_STEP(kf0, vf0, kt);
            ATT_LOAD(kf0, vf0, kt + 2); __builtin_amdgcn_sched_barrier(0); ATT_STEP(kf1, vf1, kt + 1);
        }
#undef ATT_LOAD
#undef ATT_STEP
        lrun += __shfl_xor(lrun, 32);
        const float inv = 1.0f / lrun;
        float ss = 0.f;
#pragma unroll
        for (int r = 0; r < 16; ++r) { o0[r] *= inv; o1[r] *= inv; ss += o0[r] * o0[r] + o1[r] * o1[r]; }
        ss += __shfl_xor(ss, 32);
        const float rs = 1.0f / sqrtf(ss * (1.f / 64.f) + 1e-6f);
        bf16* orow = YC + (rowbase + t0 + l32) * 1024 + 512 + 64 * hd;
        f32x4 ogv[2][4];
#pragma unroll
        for (int dt = 0; dt < 2; ++dt)
#pragma unroll
            for (int g = 0; g < 4; ++g) ogv[dt][g] = *(const f32x4*)(at_out_g + hd * 64 + 32 * dt + 8 * g + 4 * hi);
#pragma unroll
        for (int dt = 0; dt < 2; ++dt)
#pragma unroll
            for (int g = 0; g < 4; ++g) { const int d = 32 * dt + 8 * g + 4 * hi; const f32x4 og = ogv[dt][g];
                float v0, v1, v2, v3;
                if (dt == 0) { v0 = o0[4 * g]; v1 = o0[4 * g + 1]; v2 = o0[4 * g + 2]; v3 = o0[4 * g + 3]; } else { v0 = o1[4 * g]; v1 = o1[4 * g + 1]; v2 = o1[4 * g + 2]; v3 = o1[4 * g + 3]; }
                u32x2 w; w.x = pk2(v0 * rs * og.x, v1 * rs * og.y); w.y = pk2(v2 * rs * og.z, v3 * rs * og.w);
                *(u32x2*)(orow + d) = w; }
    }
    __syncthreads();
}

__device__ __forceinline__ void moe_tables(LAS int* tab, const unsigned* ctl, int tid) {
    LAS int* cnt = tab; LAS int* cum = tab + 260; LAS int* tcum = tab + 520;
    if (tid < 64) {
        int c[4], tl[4]; int sc = 0, stl = 0;
#pragma unroll
        for (int i = 0; i < 4; ++i) { c[i] = (int)__hip_atomic_load(ctl + CW_CNT + 4 * tid + i, __ATOMIC_RELAXED, __HIP_MEMORY_SCOPE_AGENT); tl[i] = (c[i] + 255) >> 8; sc += c[i]; stl += tl[i]; }
        int ic = sc, it = stl;
#pragma unroll
        for (int o = 1; o < 64; o <<= 1) { const int a = __shfl_up(ic, o), bq = __shfl_up(it, o); if (tid >= o) { ic += a; it += bq; } }
        int ec = ic - sc, et = it - stl;
#pragma unroll
        for (int i = 0; i < 4; ++i) { cnt[4 * tid + i] = c[i]; cum[4 * tid + i] = ec; tcum[4 * tid + i] = et; ec += c[i]; et += tl[i]; }
        if (tid == 63) { cnt[256] = T; cum[256] = T * 8; tcum[256] = et; tcum[257] = et + T / 256; cum[257] = T * 8 + T; }
    }
    __syncthreads();
    LAS unsigned short* t2e = (LAS unsigned short*)(tab + 800);
    if (tid <= 256) { const int t0 = tcum[tid], t1 = tcum[tid + 1]; for (int j = t0; j < t1; ++j) t2e[j] = (unsigned short)tid; }
    __syncthreads();
}
__device__ __forceinline__ int find_expert(const LAS int* tcum, int tile) {
    return (int)((const LAS unsigned short*)(tcum - 520 + 800))[tile];
}
struct LdsGather {
    static constexpr bool GATHER = true;
    const LAS unsigned* tabl;
    __device__ __forceinline__ unsigned rowoff(int ui, int r) const { return tabl[ui * 256 + r]; }
};
struct Fc1Order {
    const LAS int* tab; int total, G, c;
    __device__ bool next(int i, pg8::Unit& u) const {
        const long L = (long)i * G + c; if (L >= total) return false;
        const int tile = (int)(L >> 1), pn = (int)(L & 1);
        const LAS int* cnt = tab; const LAS int* cum = tab + 260; const LAS int* tcum = tab + 520;
        const int e = __builtin_amdgcn_readfirstlane(find_expert(tcum, tile)), j = tile - __builtin_amdgcn_readfirstlane(tcum[e]);
        u.arow = 0; u.brow = e * 512 + 256 * pn; u.orow = __builtin_amdgcn_readfirstlane(cum[e]) + 256 * j; u.ocol = 128 * pn; const int rem = __builtin_amdgcn_readfirstlane(cnt[e]) - 256 * j; u.nvalid = rem < 256 ? rem : 256; u.aux = 0; return true;
    }
};
struct Fc2Order {
    const LAS int* tab; int total, G, c;
    __device__ bool next(int i, pg8::Unit& u) const {
        const long L = (long)i * G + c; if (L >= total) return false;
        const int tile = (int)(L >> 2), pn = (int)(L & 3);
        const LAS int* cnt = tab; const LAS int* cum = tab + 260; const LAS int* tcum = tab + 520;
        const int e = __builtin_amdgcn_readfirstlane(find_expert(tcum, tile)), j = tile - __builtin_amdgcn_readfirstlane(tcum[e]);
        u.arow = __builtin_amdgcn_readfirstlane(cum[e]) + 256 * j; u.brow = e * 1024 + 256 * pn; u.orow = u.arow; u.ocol = 256 * pn; const int rem = __builtin_amdgcn_readfirstlane(cnt[e]) - 256 * j; u.nvalid = rem < 256 ? rem : 256; u.aux = 0; return true;
    }
};

constexpr int NPHASE = 14;
__global__ void __launch_bounds__(512, 2) fwd_kernel(Args args) {
    extern __shared__ __attribute__((aligned(16))) unsigned char lds_raw[];
    LAS unsigned char* lds = (LAS unsigned char*)lds_raw;
    volatile LAS unsigned* MISC = (volatile LAS unsigned*)(lds + MISC_OFF);
    const int tid = threadIdx.x, lane = tid & 63, wave = __builtin_amdgcn_readfirstlane(tid >> 6);
    const int G = gridDim.x; const int bx = blockIdx.x; const int vcu = (G % 8 == 0) ? (bx % 8) * (G / 8) + bx / 8 : bx;
    unsigned char* ws = args.ws;
    unsigned* ctl = (unsigned*)(ws + WS_CTL);
    if (tid < 64) MISC[tid] = 0u;
    __syncthreads();
    XcdBarrier bar; bar.bar = ctl + CW_BAR; bar.x = 0; bar.st = nullptr;
    if (!MK_PER_PHASE) bar = xcd_barrier_post(ctl + CW_BAR, MISC + 8);
    const int lo = args.ph_lo, hi = args.ph_hi;
#ifdef PROBE_SUB
#define PMODE (args.probe ? PROBE_SUB : 0)
#else
#define PMODE 0
#endif
#ifndef PHASE_MASK
#define PHASE_MASK 0xffffffffu
#endif
#define IN(k) (((PHASE_MASK >> (k)) & 1u) && lo <= (k) && (k) < hi)
#ifndef REPEAT_MASK
#define REPEAT_MASK 0u
#endif
#define NREP(k) (1 + (int)((REPEAT_MASK >> (k)) & 1u))
#define SEAM(k) do { if (IN(k) && IN((k) + 1)) xcd_barrier(bar); } while (0)
    const float* x = args.in[0];
    float* mod = (float*)(ws + WS_MOD);
    const int gw = vcu * 8 + wave, NGW = G * 8;
    const bool conv_split = (G == 256); const int conv_base = conv_split ? 64 : 0;

    if (IN(0)) for (int rep = 0; rep < NREP(0); ++rep) {
        __syncthreads();
        if (vcu < 192) {
            LAS float* cact = (LAS float*)lds;
            const float* c = args.in[1];
            { float cv[32];
#pragma unroll
              for (int j = 0; j < 32; ++j) cv[j] = c[tid + 512 * j];
              __builtin_amdgcn_sched_barrier(0);
#pragma unroll
              for (int j = 0; j < 32; ++j) { const int i = tid + 512 * j, b = i >> 10, k = i & 1023; cact[k * 16 + b] = cv[j] / (1.0f + __expf(-cv[j])); } }
            __syncthreads();
            const float* w_ada = args.in[3]; const float* b_ada = args.in[4];
            const int j0 = vcu * 32, col = lane & 31, kh = lane >> 5;
            float acc[16];
#pragma unroll
            for (int b = 0; b < 16; ++b) acc[b] = 0.f;
#pragma unroll 8
            for (int kk = 0; kk < 64; ++kk) { const int k = 128 * wave + 2 * kk + kh; const float wv = w_ada[(size_t)k * 6144 + j0 + col];
                const LAS f32x4* cp = (const LAS f32x4*)(cact + k * 16);
#pragma unroll
                for (int q4 = 0; q4 < 4; ++q4) { const f32x4 cv = cp[q4]; acc[4 * q4] += cv.x * wv; acc[4 * q4 + 1] += cv.y * wv; acc[4 * q4 + 2] += cv.z * wv; acc[4 * q4 + 3] += cv.w * wv; } }
            LAS float* part = (LAS float*)(lds + 65536);
#pragma unroll
            for (int b = 0; b < 16; ++b) { const float v = acc[b] + __shfl_xor(acc[b], 32); if (lane < 32) part[(wave * 16 + b) * 32 + col] = v; }
            __syncthreads();
            { const int b = tid >> 5, cc = tid & 31; float s = b_ada[j0 + cc];
#pragma unroll
              for (int w = 0; w < 8; ++w) s += part[(w * 16 + b) * 32 + cc];
              mod[(size_t)b * 6144 + j0 + cc] = s; }
            __syncthreads();
        }
        {
            bf16* WLT = (bf16*)(ws + WS_WLT); const float* w2 = args.in[10]; const float* a2 = args.in[12]; const float* g2 = args.in[13];
            for (int idx = vcu * 512 + tid; idx < 1536 * 256; idx += G * 512) { const int n = idx >> 8, k = idx & 255, br = n >> 9, c = n & 511; float v = 0.f;
                if (br == 0) { if (k < 64) v = w2[k * 512 + c]; } else if (br == 1) { if (k >= 64 && k < 128) v = a2[(k - 64) * 512 + c]; } else { if (k >= 128) v = g2[(k - 128) * 512 + c]; }
                WLT[idx] = (bf16)f2bf(v); }
        }
        LAS float* scr = (LAS float*)(lds + wave * 16640);
        constexpr int I_IN = 16 * 60, I_OUT = 16 * 16, I_R = 16 * 4, I_SMALL = I_IN + I_OUT + I_R, I_E = 192, NITEMS = I_SMALL + 257 * I_E;
#ifndef CONV_IN_P5
#define CONV_IN_P5 1
#endif
        const bool p0_split = CONV_IN_P5 && G == 256;
        for (int it = p0_split ? ((vcu >= 192) ? (vcu - 192) * 8 + wave : NITEMS) : gw; it < (CONV_IN_P5 ? I_SMALL : NITEMS); it += p0_split ? 512 : NGW) {
            int r = it;
            if (r < I_IN) { const int kb = r / 60, nb = r % 60; p0_transpose_item(args.in[7], 1024, IN_COLS, (bf16*)(ws + WS_WINT), 64 * nb, 64 * kb, 64 * nb, scr, lane); continue; } r -= I_IN;
            if (r < I_OUT) { const int kb = r / 16, nb = r % 16; p0_transpose_item(args.in[24], 1024, 1024, (bf16*)(ws + WS_WOUTT), 64 * nb, 64 * kb, 64 * nb, scr, lane); continue; } r -= I_OUT;
            if (r < I_R) { const int kb = r / 4, nb = r % 4; p0_transpose_item(args.in[25], 1024, 256, (bf16*)(ws + WS_WRT), 64 * nb, 64 * kb, 64 * nb, scr, lane); continue; } r -= I_R;
            p0_expert_item(args, ws, r / I_E, r % I_E, scr, lane);
        }
    }
    SEAM(0);
    if (IN(1)) for (int rep = 0; rep < NREP(1); ++rep) {
        bf16* H = (bf16*)(ws + WS_H);
        for (int m = gw * 16; m < T; m += NGW * 16) { const int b = m / SEQ; const float* mb = mod + (size_t)b * 6144; norm_mod_rows16(x + (size_t)m * DM, args.in[5], mb, mb + 1024, H + (size_t)m * DM, lane); }
    }
    SEAM(1);
    if (IN(2)) for (int rep = 0; rep < NREP(2); ++rep) {
        pg8::Gemm g{(const bf16*)(ws + WS_H), (const bf16*)(ws + WS_WINT), 1024}; pg8::StaticOrder S; S.init(T, NP, G, bx);
        pg8::EpiBf16 E{(bf16*)(ws + WS_P), NP, 0};
        pg8::gemm_phase<pg8::EpiBf16, pg8::StaticOrder, true, true, pg8::NoGather>(lds, g, S, E, pg8::NoGather{});
        if (conv_split && bx >= 128) {
            __syncthreads();
            const int un = bx - 128; int ln = lane; asm volatile("" : "+v"(ln));
            p0_expert_wave(args, ws, un / 6, 32 * (un % 6), 32 * (un % 6) + 32, wave, (LAS float*)(lds + wave * 16640), ln);
        }
    }
    SEAM(2);
    if (IN(3)) for (int rep = 0; rep < NREP(3); ++rep) {
        bf16* P = (bf16*)(ws + WS_P);
        bf16* XR = (bf16*)(ws + WS_XR); bf16* XK = (bf16*)(ws + WS_XK); bf16* XV = (bf16*)(ws + WS_XV); bf16* KKN = (bf16*)(ws + WS_KKN); bf16* LORA = (bf16*)(ws + WS_LORA); bf16* VF = (bf16*)(ws + WS_VF); bf16* KF = (bf16*)(ws + WS_KF); bf16* KIF = (bf16*)(ws + WS_KIF);
        const float* mu = args.in[8]; const float* k_k = args.in[14]; const int* positions = (const int*)args.in[2];
        const float* qg = args.in[19]; const float* kg = args.in[20]; const float* ilw = args.in[21]; const float* ilb = args.in[22];
        LAS bf16* vbuf = (LAS bf16*)lds;
        float mu0[8], mu1[8], mu2[8], mu3[8], kkc[8], g1[8], g2[8], frq[8];
        const int ri = lane & 3;
#pragma unroll
        for (int i = 0; i < 8; ++i) { mu0[i] = mu[8 * lane + i]; mu1[i] = mu[512 + 8 * lane + i]; mu2[i] = mu[1024 + 8 * lane + i]; mu3[i] = (lane < 32) ? mu[1536 + 8 * lane + i] : 0.f;
            kkc[i] = k_k[8 * lane + i]; const float* gsrc = (lane < 32) ? qg : kg; g1[i] = gsrc[8 * ri + i]; g2[i] = gsrc[32 + 8 * ri + i];
            frq[i] = exp2f(-(float)(8 * ri + i) * (13.287712379549449f / 32.0f)) * 0.15915494309189535f; }
        struct Tok { u32x4 c0, c1, c2, c3, p0, p1, p2, p3, qa, qb, va, ia, ib; float pos; };
        auto load_tok = [&](size_t m, Tok& t) {
            const bf16* prow = P + m * NP; const bool has_prev = (m % SEQ) != 0; const bf16* pp = has_prev ? prow - NP : prow;
            t.c0 = *(const u32x4*)(prow + 8 * lane); t.c1 = *(const u32x4*)(prow + 512 + 8 * lane); t.c2 = *(const u32x4*)(prow + 1024 + 8 * lane);
            t.p0 = *(const u32x4*)(pp + 8 * lane); t.p1 = *(const u32x4*)(pp + 512 + 8 * lane); t.p2 = *(const u32x4*)(pp + 1024 + 8 * lane);
            if (lane < 32) { t.c3 = *(const u32x4*)(prow + 1536 + 8 * lane); t.p3 = *(const u32x4*)(pp + 1536 + 8 * lane); } else { t.c3 = (u32x4){0u, 0u, 0u, 0u}; t.p3 = t.c3; }
            if (!has_prev) { const u32x4 z = (u32x4){0u, 0u, 0u, 0u}; t.p0 = z; t.p1 = z; t.p2 = z; t.p3 = z; }
            const int qkb = ((lane < 32) ? C_Q : C_K) + 64 * ((lane & 31) >> 2) + 8 * ri;
            t.qa = *(const u32x4*)(prow + qkb); t.qb = *(const u32x4*)(prow + qkb + 32);
            t.va = *(const u32x4*)(prow + C_V + 8 * lane);
            const int ib0 = (lane < 16) ? (C_QI + 64 * (lane >> 2) + 8 * ri) : (C_KI + 8 * ri);
            if (lane < 20) { t.ia = *(const u32x4*)(prow + ib0); t.ib = *(const u32x4*)(prow + ib0 + 32); } else { t.ia = (u32x4){0u, 0u, 0u, 0u}; t.ib = t.ia; }
            t.pos = (float)positions[m];
        };
        auto unpack8 = [&](const u32x4& w, float (&o)[8]) { o[0] = lo16(w.x); o[1] = hi16(w.x); o[2] = lo16(w.y); o[3] = hi16(w.y); o[4] = lo16(w.z); o[5] = hi16(w.z); o[6] = lo16(w.w); o[7] = hi16(w.w); };
        auto pack8 = [&](const float (&o)[8]) { return (u32x4){pk2(o[0], o[1]), pk2(o[2], o[3]), pk2(o[4], o[5]), pk2(o[6], o[7])}; };
        auto proc_tok = [&](size_t m, int tl, const Tok& t) {
            bf16* prow = P + m * NP; const int sq = (int)(m % SEQ), bb = (int)(m / SEQ);
            float c[8], p[8], x[8];
            unpack8(t.c0, c); unpack8(t.p0, p);
#pragma unroll
            for (int i = 0; i < 8; ++i) x[i] = c[i] + (p[i] - c[i]) * mu0[i];
            *(u32x4*)(XR + m * 512 + 8 * lane) = pack8(x);
            unpack8(t.c1, c); unpack8(t.p1, p);
#pragma unroll
            for (int i = 0; i < 8; ++i) x[i] = c[i] + (p[i] - c[i]) * mu1[i];
            *(u32x4*)(XK + m * 512 + 8 * lane) = pack8(x);
            unpack8(t.c2, c); unpack8(t.p2, p);
#pragma unroll
            for (int i = 0; i < 8; ++i) x[i] = c[i] + (p[i] - c[i]) * mu2[i];
            *(u32x4*)(XV + m * 512 + 8 * lane) = pack8(x);
            if (lane < 32) {
                unpack8(t.c3, c); unpack8(t.p3, p);
#pragma unroll
                for (int i = 0; i < 8; ++i) { const float ps = c[i] + (p[i] - c[i]) * mu3[i]; x[i] = (lane < 8) ? tanhf(ps) : ((lane < 16) ? ps : sigmoidf_(ps)); }
                *(u32x4*)(LORA + m * 256 + 8 * lane) = pack8(x);
            }
            float cs[8], sn[8];
#pragma unroll
            for (int i = 0; i < 8; ++i) { float rev = t.pos * frq[i]; rev -= rintf(rev); sn[i] = __builtin_amdgcn_sinf(rev); cs[i] = __builtin_amdgcn_cosf(rev); }
            {
                float x1[8], x2[8]; unpack8(t.qa, x1); unpack8(t.qb, x2);
                float ssq = 0.f;
#pragma unroll
                for (int i = 0; i < 8; ++i) ssq += x1[i] * x1[i] + x2[i] * x2[i];
                ssq += __shfl_xor(ssq, 1); ssq += __shfl_xor(ssq, 2);
                float rstd = 1.0f / sqrtf(ssq * (1.f / 64.f) + 1e-6f); if (lane < 32) rstd *= 0.125f * 1.4426950408889634f;
                float y1[8], y2[8];
#pragma unroll
                for (int i = 0; i < 8; ++i) { const float a = x1[i] * rstd * g1[i], bq = x2[i] * rstd * g2[i]; y1[i] = a * cs[i] - bq * sn[i]; y2[i] = bq * cs[i] + a * sn[i]; }
                const u32x4 o1 = pack8(y1), o2 = pack8(y2);
                if (lane < 32) { const int qkb = C_Q + 64 * (lane >> 2) + 8 * ri; *(u32x4*)(prow + qkb) = o1; *(u32x4*)(prow + qkb + 32) = o2; }
                else {
                    bf16* kfb = KF + (((size_t)(bb * 8 + ((lane - 32) >> 2)) * 64 + (sq >> 5)) * 4) * 512 + (sq & 31) * 8;
                    *(u32x4*)(kfb + ((ri >> 1) * 64 + (ri & 1) * 32) * 8) = o1;
                    *(u32x4*)(kfb + ((2 + (ri >> 1)) * 64 + (ri & 1) * 32) * 8) = o2;
                }
            }
            *(LAS u32x4*)(vbuf + tl * 512 + 8 * lane) = t.va;
            if (lane < 20) {
                float x1[8], x2[8]; unpack8(t.ia, x1); unpack8(t.ib, x2);
                float sm = 0.f;
#pragma unroll
                for (int i = 0; i < 8; ++i) sm += x1[i] + x2[i];
                sm += __shfl_xor(sm, 1); sm += __shfl_xor(sm, 2);
                const bool iski = lane >= 16;
                const float mean = iski ? sm * (1.f / 64.f) : 0.f; float vq = 0.f;
#pragma unroll
                for (int i = 0; i < 8; ++i) { x1[i] -= mean; x2[i] -= mean; vq += x1[i] * x1[i] + x2[i] * x2[i]; }
                vq += __shfl_xor(vq, 1); vq += __shfl_xor(vq, 2);
                const float rstd = iski ? 1.0f / sqrtf(vq * (1.f / 64.f) + 1e-6f) : 1.0f;
                float y1[8], y2[8];
#pragma unroll
                for (int i = 0; i < 8; ++i) { float a = x1[i] * rstd, bq = x2[i] * rstd;
                    if (iski) { a = a * ilw[8 * ri + i] + ilb[8 * ri + i]; bq = bq * ilw[32 + 8 * ri + i] + ilb[32 + 8 * ri + i]; }
                    y1[i] = a * cs[i] - bq * sn[i]; y2[i] = bq * cs[i] + a * sn[i]; }
                const u32x4 o1 = pack8(y1), o2 = pack8(y2);
                if (!iski) { const int ib0 = C_QI + 64 * (lane >> 2) + 8 * ri; *(u32x4*)(prow + ib0) = o1; *(u32x4*)(prow + ib0 + 32) = o2; }
                else {
                    bf16* kfb = KIF + (((size_t)bb * 64 + (sq >> 5)) * 4) * 512 + (sq & 31) * 8;
                    *(u32x4*)(kfb + ((ri >> 1) * 64 + (ri & 1) * 32) * 8) = o1;
                    *(u32x4*)(kfb + ((2 + (ri >> 1)) * 64 + (ri & 1) * 32) * 8) = o2;
                }
            }
        };
        for (int tile = vcu; tile < T / 64; tile += G) {
#pragma unroll 1
            for (int i = 0; i < 8; i += 2) {
                const int tl = wave * 8 + i; const size_t m = (size_t)tile * 64 + tl;
                Tok ta, tb; load_tok(m, ta); load_tok(m + 1, tb);
                proc_tok(m, tl, ta); proc_tok(m + 1, tl + 1, tb);
            }
            __syncthreads();
            {
                const size_t m0 = (size_t)tile * 64; const int b = (int)(m0 / SEQ), s0 = (int)(m0 % SEQ);
                const int h = tid >> 6, d = tid & 63, dt = d >> 5, dl = d & 31;
#pragma unroll
                for (int ktl = 0; ktl < 2; ++ktl)
#pragma unroll
                    for (int s2 = 0; s2 < 2; ++s2)
#pragma unroll
                        for (int hh = 0; hh < 2; ++hh) {
                            const int tb = 32 * ktl + 16 * s2 + 4 * hh; unsigned e[8];
#pragma unroll
                            for (int i = 0; i < 4; ++i) { e[i] = vbuf[(tb + i) * 512 + tid]; e[4 + i] = vbuf[(tb + 8 + i) * 512 + tid]; }
                            u32x4 w; w.x = e[0] | (e[1] << 16); w.y = e[2] | (e[3] << 16); w.z = e[4] | (e[5] << 16); w.w = e[6] | (e[7] << 16);
                            *(u32x4*)(VF + ((((((size_t)(b * 8 + h) * 64 + (s0 >> 5) + ktl) * 2 + dt) * 2 + s2) * 64) + hh * 32 + dl) * 8) = w;
                        }
            }
            __syncthreads();
        }
    }
    SEAM(3);
    if (IN(4)) for (int rep = 0; rep < NREP(4); ++rep) {
        pg8::Gemm g{(const bf16*)(ws + WS_LORA), (const bf16*)(ws + WS_WLT), 256}; pg8::StaticOrder S; S.init(T, 1536, G, bx);
        pg8::EpiLora E{args.in[9], args.in[11], args.in[15], (bf16*)(ws + WS_EE), (bf16*)(ws + WS_XK), (const bf16*)(ws + WS_KKN), (bf16*)(ws + WS_BV), (bf16*)(ws + WS_GG)};
        pg8::gemm_phase<pg8::EpiLora, pg8::StaticOrder, true, true, pg8::NoGather>(lds, g, S, E, pg8::NoGather{});
    }
    SEAM(4);
    if (IN(5)) for (int rep = 0; rep < NREP(5); ++rep) {
        const int myx = (int)(xb_xcc_id() & 7u);
        for (int d = 0; d < 8; ++d) {
            const int qx = (myx + d) & 7;
            for (;;) {
                if (tid == 0) MISC[0] = atomicAdd(ctl + CW_QUEUE + 256 * (rep + 2 * args.probe) + 16 * qx, 1u);
                __syncthreads();
                int item = (int)MISC[0];
                __syncthreads();
#ifdef PROBE_SUB
                if (args.probe) { if (PROBE_SUB == 1 || (PROBE_SUB >= 10 && PROBE_SUB < 20)) { if (item >= 16) break; } else item += 16; }
#endif
#if CONV_IN_P5
                if (item >= 16 + 165) break;
                if (item >= 16) {
                    const int sl = item - 16, c5 = sl / 5;
                    if (sl - 5 * c5 == 4) {
                        const int e = conv_base + qx + 8 * c5;
                        if (e < 257) { int ln = lane; asm volatile("" : "+v"(ln)); p0_expert_wave(args, ws, e, 0, 192, wave, (LAS float*)(lds + wave * 16640), ln); }
                        continue;
                    }
                    item = 16 + sl - c5;
                    if (item >= 16 + 128) continue;
                }
#else
                if (item >= 16 + 128) break;
#endif
#ifndef NO_SCAN
                if (item < 16) scan_job(lds, 16 * qx + item, ws, args.in[16], args.in[17], args.in[18], args.in[14], args.in[15], tid, lane, wave, PMODE);
#endif
#ifndef NO_DSA
                if (item >= 16) { const int u = item - 16; dsa_unit(lds, 2 * qx + (u >> 6), 63 - (u & 63), ws, args.in[23], tid, lane, wave, PMODE); }
#endif
            }
        }
    }
    SEAM(5);
    if (IN(6)) for (int rep = 0; rep < NREP(6); ++rep) {
        pg8::Gemm g{(const bf16*)(ws + WS_H), (const bf16*)(ws + WS_WOUTT), 1024}; pg8::StaticOrder S; S.init(T, 1024, G, bx);
        pg8::EpiResid E{x, (bf16*)(ws + WS_X1B), mod, 2048};
        pg8::gemm_phase<pg8::EpiResid, pg8::StaticOrder, true, true, pg8::NoGather>(lds, g, S, E, pg8::NoGather{});
    }
    SEAM(6);
    if (IN(7)) for (int rep = 0; rep < NREP(7); ++rep) {
        bf16* H = (bf16*)(ws + WS_H);
        for (int m = gw * 16; m < T; m += NGW * 16) { const int b = m / SEQ; const float* mb = mod + (size_t)b * 6144; norm_mod_rows16_bf((const bf16*)(ws + WS_X1B) + (size_t)m * DM, args.in[6], mb + 3072, mb + 4096, H + (size_t)m * DM, lane); }
    }
    SEAM(7);
    if (IN(8)) for (int rep = 0; rep < NREP(8); ++rep) {
        pg8::Gemm g{(const bf16*)(ws + WS_H), (const bf16*)(ws + WS_WRT), 1024}; pg8::StaticOrder S; S.init(T, 256, G, bx);
        pg8::EpiF32 E{(float*)(ws + WS_LOGIT), 256};
        pg8::gemm_phase<pg8::EpiF32, pg8::StaticOrder, true, true, pg8::NoGather>(lds, g, S, E, pg8::NoGather{});
        if (conv_split && bx >= 128) {
            __syncthreads();
            int ln = lane; asm volatile("" : "+v"(ln));
#pragma unroll 1
            for (int j = 0; j < 2; ++j) { const int un = 128 + 2 * (bx - 128) + j; p0_expert_wave(args, ws, un / 6, 32 * (un % 6), 32 * (un % 6) + 32, wave, (LAS float*)(lds + wave * 16640), ln); }
        }
    }
    SEAM(8);
    if (IN(9)) for (int rep = 0; rep < NREP(9); ++rep) {
        const float* LG = (const float*)(ws + WS_LOGIT); const float* rbias = args.in[26];
        unsigned* SEL = (unsigned*)(ws + WS_SEL); float* GWt = (float*)(ws + WS_GW); int* HG = (int*)(ws + WS_HG);
        LAS int* hist = (LAS int*)lds;
        if (tid < 256) hist[tid] = 0;
        __syncthreads();
        const f32x4 bv = *(const f32x4*)(rbias + 4 * lane);
        constexpr int NT = 4;
#pragma unroll 1
        for (int i16 = 0; i16 < 16; i16 += NT) {
            const int m0 = vcu * 128 + wave * 16 + i16;
            f32x4 lg[NT];
#pragma unroll
            for (int t = 0; t < NT; ++t) lg[t] = *(const f32x4*)(LG + (size_t)(m0 + t) * 256 + 4 * lane);
            float sc[NT][4], bs[NT][4], gs[NT];
#pragma unroll
            for (int t = 0; t < NT; ++t) {
#pragma unroll
                for (int i = 0; i < 4; ++i) { sc[t][i] = sigmoidf_(lg[t][i]); bs[t][i] = sc[t][i] + bv[i]; }
            }
            {
                float a1[NT], a2[NT];
#pragma unroll
                for (int t = 0; t < NT; ++t) { a1[t] = fmaxf(bs[t][0], bs[t][1]); a2[t] = fminf(bs[t][0], bs[t][1]);
                    const float b1 = fmaxf(bs[t][2], bs[t][3]), b2 = fminf(bs[t][2], bs[t][3]); const float n1 = fmaxf(a1[t], b1), n2 = fmaxf(fminf(a1[t], b1), fmaxf(a2[t], b2)); a1[t] = n1; a2[t] = n2; }
#pragma unroll
                for (int o = 1; o < 8; o <<= 1) {
#pragma unroll
                    for (int t = 0; t < NT; ++t) { const float b1 = __shfl_xor(a1[t], o), b2 = __shfl_xor(a2[t], o); const float n1 = fmaxf(a1[t], b1), n2 = fmaxf(fminf(a1[t], b1), fmaxf(a2[t], b2)); a1[t] = n1; a2[t] = n2; }
                }
#pragma unroll
                for (int t = 0; t < NT; ++t) gs[t] = a1[t] + a2[t];
            }
            const int mygrp = lane >> 3;
            int rank[NT];
#pragma unroll
            for (int t = 0; t < NT; ++t) rank[t] = 0;
#pragma unroll
            for (int g = 0; g < 8; ++g) {
#pragma unroll
                for (int t = 0; t < NT; ++t) { const float og = __shfl(gs[t], 8 * g); rank[t] += (og > gs[t] || (og == gs[t] && g < mygrp)) ? 1 : 0; }
            }
            unsigned long long key[NT][4];
#pragma unroll
            for (int t = 0; t < NT; ++t) {
#pragma unroll
                for (int i = 0; i < 4; ++i) key[t][i] = (rank[t] < 4) ? (((unsigned long long)sortable(bs[t][i]) << 32) | (unsigned)(255 - (4 * lane + i))) : 0ull;
            }
            int my_e[NT]; float my_s[NT], ssum[NT];
#pragma unroll
            for (int t = 0; t < NT; ++t) { my_e[t] = 0; my_s[t] = 0.f; ssum[t] = 0.f; }
#pragma unroll 1
            for (int r = 0; r < 8; ++r) {
                unsigned long long best[NT];
#pragma unroll
                for (int t = 0; t < NT; ++t) { best[t] = key[t][0] > key[t][1] ? key[t][0] : key[t][1]; const unsigned long long b2 = key[t][2] > key[t][3] ? key[t][2] : key[t][3]; best[t] = best[t] > b2 ? best[t] : b2; }
#pragma unroll
                for (int o = 1; o < 64; o <<= 1) {
#pragma unroll
                    for (int t = 0; t < NT; ++t) { const unsigned long long ob = __shfl_xor(best[t], o); best[t] = ob > best[t] ? ob : best[t]; }
                }
#pragma unroll
                for (int t = 0; t < NT; ++t) {
                    const int e = 255 - (int)(best[t] & 0xffffffffull);
                    const int ol = e >> 2, oi = e & 3;
                    float sv = (oi == 0) ? sc[t][0] : (oi == 1) ? sc[t][1] : (oi == 2) ? sc[t][2] : sc[t][3];
                    sv = __shfl(sv, ol);
                    if (lane == ol) {
#pragma unroll
                        for (int i = 0; i < 4; ++i) if (i == oi) key[t][i] = 0ull;
                    }
                    ssum[t] += sv;
                    if (lane == r) { my_e[t] = e; my_s[t] = sv; }
                }
            }
            if (lane < 8) {
#pragma unroll
                for (int t = 0; t < NT; ++t) {
                    const int lpos = __hip_atomic_fetch_add(hist + my_e[t], 1, __ATOMIC_RELAXED, __HIP_MEMORY_SCOPE_WORKGROUP);
                    SEL[(size_t)(m0 + t) * 8 + lane] = (unsigned)my_e[t] | ((unsigned)lpos << 8);
                    GWt[(size_t)(m0 + t) * 8 + lane] = my_s[t] / ssum[t] * 2.5f;
                }
            }
        }
        __syncthreads();
        if (tid < 256) HG[vcu * 256 + tid] = hist[tid];
        __syncthreads();
    }
    SEAM(9);
    if (IN(10)) for (int rep = 0; rep < NREP(10); ++rep) {
        unsigned* SEL = (unsigned*)(ws + WS_SEL); const int* HG = (const int*)(ws + WS_HG); int* TOKL = (int*)(ws + WS_TOKL);
        LAS int* basel = (LAS int*)lds;
        {
            const int e = tid & 255, half = tid >> 8; int bsum = 0, tsum = 0;
#pragma unroll 16
            for (int w = 0; w < 128; ++w) { const int wg = half * 128 + w; const int v = HG[wg * 256 + e]; tsum += v; bsum += (wg < vcu) ? v : 0; }
            basel[half * 256 + e] = bsum; basel[512 + half * 256 + e] = tsum;
        }
        __syncthreads();
        if (tid < 256) { const int bsum = basel[tid] + basel[256 + tid], tsum = basel[512 + tid] + basel[768 + tid]; basel[1024 + tid] = bsum; if (vcu == 0) ctl[CW_CNT + tid] = (unsigned)tsum; }
        __syncthreads();
#pragma unroll
        for (int k2 = 0; k2 < 2; ++k2) { const int idx = tid + 512 * k2; const int m = vcu * 128 + (idx >> 3);
            const unsigned se = SEL[(size_t)m * 8 + (idx & 7)]; const int e = (int)(se & 255u), pos = basel[1024 + e] + (int)(se >> 8);
            SEL[(size_t)m * 8 + (idx & 7)] = (unsigned)e | ((unsigned)pos << 8); TOKL[(size_t)e * ECAP + pos] = m; }
        __syncthreads();
    }
    SEAM(10);
    if (IN(11)) for (int rep = 0; rep < NREP(11); ++rep) {
        LAS int* tab = (LAS int*)(lds + TAB_OFF);
        moe_tables(tab, ctl, tid);
        const LAS int* cnt = tab; const LAS int* cum = tab + 260; const LAS int* tcum = tab + 520;
        const int total = 2 * __builtin_amdgcn_readfirstlane(tcum[257]);
        LAS unsigned* gtab = (LAS unsigned*)(lds + 131072);
        {
            const int* TOKL = (const int*)(ws + WS_TOKL);
            for (int i = tid >> 8; ; i += 2) { const int uix = vcu + i * G; if (uix >= total || i >= 22) break;
                const int tile = uix >> 1, e = find_expert(tcum, tile), j = tile - tcum[e], r = tid & 255, rem = cnt[e] - 256 * j;
                int tok; if (e < 256) tok = TOKL[(size_t)e * ECAP + 256 * j + (r < rem ? r : 0)]; else tok = 256 * j + r;
                gtab[i * 256 + r] = (unsigned)tok * 2048u; }
        }
        __syncthreads();
        Fc1Order S; S.tab = tab; S.total = total; S.G = G; S.c = vcu;
        LdsGather am; am.tabl = gtab;
        pg8::Gemm g{(const bf16*)(ws + WS_H), (const bf16*)(ws + WS_W13T), 1024};
        pg8::EpiSwiglu E{(bf16*)(ws + WS_ACT)};
        pg8::gemm_phase<pg8::EpiSwiglu, Fc1Order, true, true, LdsGather>(lds, g, S, E, am);
        (void)cum;
    }
    SEAM(11);
    if (IN(12)) for (int rep = 0; rep < NREP(12); ++rep) {
        LAS int* tab = (LAS int*)(lds + TAB_OFF);
        moe_tables(tab, ctl, tid);
        Fc2Order S; S.tab = tab; S.total = 4 * __builtin_amdgcn_readfirstlane(tab[520 + 257]); S.G = G; S.c = vcu;
        pg8::Gemm g{(const bf16*)(ws + WS_ACT), (const bf16*)(ws + WS_W2T), 256};
        pg8::EpiFp8 E{(unsigned char*)(ws + WS_Y), 1024, (PMODE == 7) ? 100000 : 0};
        pg8::gemm_phase<pg8::EpiFp8, Fc2Order, true, true, pg8::NoGather>(lds, g, S, E, pg8::NoGather{});
    }
    SEAM(12);
    if (IN(13)) for (int rep = 0; rep < NREP(13); ++rep) {
        LAS int* tab = (LAS int*)(lds + TAB_OFF);
        moe_tables(tab, ctl, tid);
        const LAS int* cum = tab + 260;
        const unsigned char* Y = (const unsigned char*)(ws + WS_Y); const unsigned* SEL = (const unsigned*)(ws + WS_SEL); const float* GWt = (const float*)(ws + WS_GW);
        for (int m = gw; m < T; m += NGW) {
            const int b = m / SEQ; const float* g2 = mod + (size_t)b * 6144 + 5120;
            float acc[16];
            u32x4 yv[9]; float wv[9];
            yv[0] = __builtin_nontemporal_load((const u32x4*)(Y + ((size_t)T * 8 + m) * 1024 + 16 * lane)); wv[0] = 1.0f;
#pragma unroll
            for (int j = 0; j < 8; ++j) {
                const unsigned se = SEL[(size_t)m * 8 + j]; wv[1 + j] = GWt[(size_t)m * 8 + j];
                const int e = (int)(se & 255u), pos = (int)(se >> 8);
                yv[1 + j] = __builtin_nontemporal_load((const u32x4*)(Y + ((size_t)cum[e] + pos) * 1024 + 16 * lane));
            }
#pragma unroll
            for (int i = 0; i < 16; ++i) acc[i] = 0.f;
#pragma unroll
            for (int j = 0; j < 9; ++j) {
                const float w = wv[j]; const unsigned dw[4] = {yv[j].x, yv[j].y, yv[j].z, yv[j].w};
#pragma unroll
                for (int q4 = 0; q4 < 4; ++q4) { const f32x2 lo = __builtin_amdgcn_cvt_pk_f32_fp8((int)dw[q4], false), hi2 = __builtin_amdgcn_cvt_pk_f32_fp8((int)dw[q4], true);
                    acc[4 * q4] += w * lo.x; acc[4 * q4 + 1] += w * lo.y; acc[4 * q4 + 2] += w * hi2.x; acc[4 * q4 + 3] += w * hi2.y; }
            }
            float* orow = args.out + (size_t)m * DM + 16 * lane;
            const u32x4* xr1 = (const u32x4*)((const bf16*)(ws + WS_X1B) + (size_t)m * DM + 16 * lane); const u32x4 xa = xr1[0], xb = xr1[1];
            const unsigned xw[8] = {xa.x, xa.y, xa.z, xa.w, xb.x, xb.y, xb.z, xb.w};
#pragma unroll
            for (int q4 = 0; q4 < 4; ++q4) { const f32x4 gv = *(const f32x4*)(g2 + 16 * lane + 4 * q4);
                f32x4 o; o.x = lo16(xw[2 * q4]) + gv.x * acc[4 * q4]; o.y = hi16(xw[2 * q4]) + gv.y * acc[4 * q4 + 1]; o.z = lo16(xw[2 * q4 + 1]) + gv.z * acc[4 * q4 + 2]; o.w = hi16(xw[2 * q4 + 1]) + gv.w * acc[4 * q4 + 3];
                *(f32x4*)(orow + 4 * q4) = o; }
        }
    }
#undef IN
#undef SEAM
}

extern "C" void kernel_launch(void* const* d_in, const int* in_sizes, int n_in, void* d_out, int out_size, void* d_ws, size_t ws_size, hipStream_t stream) {
    static int grid = 0;
    if (grid == 0) {
        if (n_in != 33 || out_size != T * DM || ws_size < WS_END) { fprintf(stderr, "kernel_launch: unexpected shapes (n_in %d out %d ws %zu)\n", n_in, out_size, ws_size); grid = -1; return; }
        int dev = 0, cus = 0, per_cu = 0;
        hipGetDevice(&dev); hipDeviceGetAttribute(&cus, hipDeviceAttributeMultiprocessorCount, dev);
        hipFuncSetAttribute((const void*)fwd_kernel, hipFuncAttributeMaxDynamicSharedMemorySize, LDS_BYTES);
        hipOccupancyMaxActiveBlocksPerMultiprocessor(&per_cu, (const void*)fwd_kernel, 512, LDS_BYTES);
        (void)hipGetLastError();
        if (per_cu < 1) fprintf(stderr, "kernel_launch: occupancy query says %d\n", per_cu);
        grid = cus;
    }
    if (grid < 0) return;
    hipMemsetAsync((char*)d_ws + WS_CTL, 0, CTL_BYTES, stream);
    Args a{};
    for (int i = 0; i < 33; ++i) a.in[i] = (const float*)d_in[i];
    a.out = (float*)d_out; a.ws = (unsigned char*)d_ws;
#if MK_PER_PHASE
    for (int p = 0; p < NPHASE; ++p) { a.ph_lo = p; a.ph_hi = p + 1; hipLaunchKernelGGL(fwd_kernel, dim3(grid), dim3(512), LDS_BYTES, stream, a); }
#else
    a.ph_lo = 0; a.ph_hi = NPHASE;
    void* kargs[] = {&a};
    hipError_t e = hipLaunchCooperativeKernel((const void*)fwd_kernel, dim3(grid), dim3(512), kargs, LDS_BYTES, stream);
    if (e != hipSuccess) fprintf(stderr, "cooperative launch failed: %s (grid %d)\n", hipGetErrorString(e), grid);
#ifdef PROBE_PHASE
    a.ph_lo = PROBE_PHASE; a.ph_hi = PROBE_PHASE + 1; a.probe = 1; hipLaunchKernelGGL(fwd_kernel, dim3(grid), dim3(512), LDS_BYTES, stream, a);
#endif
#endif
}
```

```cpp
#include <hip/hip_runtime.h>
#include <type_traits>
#include <cstdio>
#include <cstdint>

#ifndef MK_PER_PHASE
#define MK_PER_PHASE 0
#endif

#define LAS __attribute__((address_space(3)))
#define GAS __attribute__((address_space(1)))
typedef unsigned short bf16;
typedef short bf16x8 __attribute__((ext_vector_type(8)));
typedef float f32x4 __attribute__((ext_vector_type(4)));
typedef float f32x16 __attribute__((ext_vector_type(16)));
typedef unsigned u32x4 __attribute__((ext_vector_type(4)));
typedef unsigned u32x2 __attribute__((ext_vector_type(2)));

constexpr int BATCH = 16, SEQ = 2048, DM = 1024, T = BATCH * SEQ;
constexpr int NP = 3840;
constexpr int IN_COLS = 3652;
constexpr int C_RWR = 0, C_RWK = 512, C_RWV = 1024, C_WL = 1536;
constexpr int C_Q = 1792, C_K = 2304, C_V = 2816, C_QI = 3328, C_KI = 3584, C_WI = 3648;
constexpr int NEXP = 256, ECAP = 32768;

constexpr size_t MiB = 1u << 20;
constexpr size_t WS_CTL = 0, CTL_BYTES = 32768;
constexpr size_t WS_MOD = 1 * MiB;
constexpr size_t WS_WINT = 2 * MiB;
constexpr size_t WS_WOUTT = 10 * MiB;
constexpr size_t WS_WLT = 12 * MiB;
constexpr size_t WS_WRT = 13 * MiB;
constexpr size_t WS_W2T = 16 * MiB;
constexpr size_t WS_W13T = 145 * MiB;
constexpr size_t WS_H = 404 * MiB;
constexpr size_t WS_P = 468 * MiB;
constexpr size_t WS_XR = 708 * MiB, WS_XK = 740 * MiB, WS_XV = 772 * MiB, WS_KKN = 804 * MiB;
constexpr size_t WS_LORA = 836 * MiB;
constexpr size_t WS_EE = 852 * MiB, WS_BV = 884 * MiB, WS_GG = 916 * MiB, WS_VF = 948 * MiB, WS_KF = 980 * MiB, WS_KIF = 1012 * MiB;
constexpr size_t WS_LOGIT = 468 * MiB;
constexpr size_t WS_TOKL = 500 * MiB;
constexpr size_t WS_Y = 145 * MiB;
constexpr size_t WS_ACT = 724 * MiB;
constexpr size_t WS_SEL = 870 * MiB;
constexpr size_t WS_GW = 872 * MiB;
constexpr size_t WS_X1B = 560 * MiB;
constexpr size_t WS_HG = 874 * MiB;
constexpr size_t WS_END = 1024 * MiB;
constexpr int CW_QUEUE = 64, CW_CNT = 1024  , CW_BAR = 4096;

constexpr int RING_BYTES = 153600;
constexpr int MISC_OFF = RING_BYTES;
constexpr int TAB_OFF = RING_BYTES + 256;
constexpr int MASK_OFF = 131072;
constexpr int LDS_BYTES = RING_BYTES + 8192;

__device__ __forceinline__ float bf2f(unsigned h) { return __uint_as_float(h << 16); }
typedef __bf16 bf16v2 __attribute__((ext_vector_type(2)));
typedef float f32x2 __attribute__((ext_vector_type(2)));
__device__ __forceinline__ unsigned pk2(float lo, float hi) { const f32x2 v = {lo, hi}; return __builtin_bit_cast(unsigned, __builtin_convertvector(v, bf16v2)); }
__device__ __forceinline__ unsigned f2bf(float f) { return pk2(f, 0.f) & 0xffffu; }
__device__ __forceinline__ float lo16(unsigned w) { return __uint_as_float(w << 16); }
__device__ __forceinline__ float hi16(unsigned w) { return __uint_as_float(w & 0xffff0000u); }
__device__ __forceinline__ float sigmoidf_(float x) { return 1.0f / (1.0f + __expf(-x)); }

namespace pg8 {
constexpr int BM = 256, BK = 64, HALF = 128, HTB = HALF * BK * 2, STAGE_BYTES = 8 * HTB, NXCD = 8, WGM = 8;
__host__ __device__ __forceinline__ int lds_byte(int r, int c) { const int st = (r >> 4) * 2 + (c >> 5), rr = r & 15, cc = c & 31, ob = rr * 64 + cc * 2; return st * 1024 + (ob ^ (((ob >> 9) & 1) << 5)); }
__host__ __device__ __forceinline__ void stage_rc(int b, int& R, int& C) { const int st = b / 1024, sb = b % 1024, swz = sb ^ (((sb >> 9) & 1) << 5); R = (st >> 1) * 16 + swz / 64; C = (st & 1) * 32 + (swz % 64) / 2; }
__host__ __device__ __forceinline__ int perm32(int rho) { const int n = rho >> 4, i = rho & 15; return 8 * (i >> 2) + 4 * n + (i & 3); }

struct Unit { int arow, brow, orow, ocol, nvalid, aux; };
struct Gemm { const bf16* A; const bf16* Bt; int K; };

struct StaticOrder {
    int nM, nN, nwg, G, c;
    __device__ void init(int M, int N, int G_, int c_) { nM = M / BM; nN = N / BM; nwg = nM * nN; G = G_; c = c_; }
    __device__ bool next(int i, Unit& u) const {
        const long L = (long)i * G + c; if (L >= nwg) return false;
        int wgid = (int)L; { const int q = nwg / NXCD, r = nwg % NXCD, xcd = wgid % NXCD, off = wgid / NXCD; wgid = (xcd < r ? xcd * (q + 1) : r * (q + 1) + (xcd - r) * q) + off; }
        const int nig = WGM * nN, gid = wgid / nig, fm = gid * WGM, gsz = (nM - fm) < WGM ? (nM - fm) : WGM;
        const int pm = fm + ((wgid % nig) % gsz), pn = (wgid % nig) / gsz;
        u.arow = pm * BM; u.brow = pn * BM; u.orow = pm * BM; u.ocol = pn * BM; u.nvalid = BM; u.aux = 0; return true;
    }
};
struct OneUnit { Unit u; __device__ bool next(int i, Unit& o) const { if (i != 0) return false; o = u; return true; } };
struct NoGather { static constexpr bool GATHER = false; __device__ __forceinline__ unsigned rowoff(int, int) const { return 0u; } };

template <class Epi, class Sched, bool ALIGN_EPI, bool SP2, class AMap>
__device__ __forceinline__ void gemm_phase(LAS unsigned char* lds, const Gemm g, const Sched& S, const Epi& E, const AMap& amap) {
    constexpr bool GATHER = AMap::GATHER;
    const int tid = threadIdx.x, wid = __builtin_amdgcn_readfirstlane(tid >> 6), lane = tid & 63, wr = wid >> 2, wc = wid & 3, fr = lane & 15, fq = lane >> 4;
    const int K = g.K, nt = K / BK;
    unsigned voffA[2], voffB[2], voffG[2][2];
    int RA[2], CA[2];
#pragma unroll
    for (int i = 0; i < 2; ++i) { int R, C; stage_rc(tid * 16 + i * 8192, R, C); const int Rb = Epi::PERM ? ((R & ~31) + perm32(R & 31)) : R;
        voffA[i] = (unsigned)(R * K + C) * 2u; voffB[i] = (unsigned)(Rb * K + C) * 2u; RA[i] = R; CA[i] = C; voffG[0][i] = 0u; voffG[1][i] = 0u; }
    unsigned voffGn[2][2] = {{0u, 0u}, {0u, 0u}};
    if constexpr (GATHER) {
#pragma unroll
        for (int h = 0; h < 2; ++h)
#pragma unroll
            for (int i = 0; i < 2; ++i) voffG[h][i] = amap.rowoff(0, h * HALF + RA[i]) + (unsigned)CA[i] * 2u;
    }
    const size_t kstep = (size_t)(BK * 2);
    const size_t hstep = (size_t)HALF * K * 2;
    const size_t rowb = (size_t)K * 2;
    const unsigned ldsw = (unsigned)wid * 1024u;
    const int aoff = lds_byte(wr * 64 + fr, fq * 8), boff = lds_byte(wc * 32 + fr, fq * 8);
#define PG8_SA(b, h) (((b) * 2 + (h)) * HTB)
#define PG8_SB(b, h) ((4 + (b) * 2 + (h)) * HTB)
#define PG8_STAGE(bufoff, gbase, voff) do { _Pragma("unroll") for (int _i = 0; _i < 2; ++_i) \
        __builtin_amdgcn_global_load_lds((const unsigned*)((const char*)(gbase) + (voff)[_i]), (LAS unsigned*)(lds + (bufoff) + ldsw + _i * 8192), 16, 0, 0); } while (0)
#define PG8_STAGEA(bufoff, gbase, h) do { if constexpr (GATHER) { PG8_STAGE(bufoff, gbase, voffG[h]); } else { PG8_STAGE(bufoff, (gbase) + (h) * hstep, voffA); } } while (0)
#define PG8_STAGEAN(bufoff, gbase, h) do { if constexpr (GATHER) { PG8_STAGE(bufoff, gbase, vsel[h]); } else { PG8_STAGE(bufoff, (gbase) + (h) * hstep, voffA); } } while (0)
#define PG8_LDA(dst, b, h) do { _Pragma("unroll") for (int m = 0; m < 4; ++m) _Pragma("unroll") for (int k = 0; k < 2; ++k) dst[m][k] = *(const LAS bf16x8*)(lds + PG8_SA(b, h) + aoff + m * 2048 + k * 1024); } while (0)
#define PG8_LDB(dst, b, h) do { _Pragma("unroll") for (int n = 0; n < 2; ++n) _Pragma("unroll") for (int k = 0; k < 2; ++k) dst[n][k] = *(const LAS bf16x8*)(lds + PG8_SB(b, h) + boff + n * 2048 + k * 1024); } while (0)
#define PG8_MMA(ai, bj, At, Bt) do { __builtin_amdgcn_s_setprio(1); _Pragma("unroll") for (int m = 0; m < 4; ++m) _Pragma("unroll") for (int n = 0; n < 2; ++n) _Pragma("unroll") for (int k = 0; k < 2; ++k) \
        acc[ai][bj][m][n] = __builtin_amdgcn_mfma_f32_16x16x32_bf16(Bt[n][k], At[m][k], acc[ai][bj][m][n], 0, 0, 0); __builtin_amdgcn_s_setprio(0); } while (0)
#define PG8_WAIT_V(n) asm volatile("s_waitcnt vmcnt(" #n ")" ::: "memory")
#define PG8_WAIT_L(n) asm volatile("s_waitcnt lgkmcnt(" #n ")" ::: "memory")
#define PG8_BAR __builtin_amdgcn_s_barrier()
#define PG8_SCHED __builtin_amdgcn_sched_barrier(0)
    Unit cur, nxt; int ui = 0;
    if (!S.next(0, cur)) return;
    f32x4 acc[2][2][4][2];
#pragma unroll
    for (int a = 0; a < 2; ++a)
#pragma unroll
        for (int b = 0; b < 2; ++b)
#pragma unroll
            for (int m = 0; m < 4; ++m)
#pragma unroll
                for (int n = 0; n < 2; ++n) acc[a][b][m][n] = (f32x4){0.f, 0.f, 0.f, 0.f};
    bf16x8 At[4][2], B0[2][2], B1[2][2];
    const char* cA = (const char*)g.A + (GATHER ? (size_t)0 : (size_t)cur.arow * rowb); const char* cB = (const char*)g.Bt + (size_t)cur.brow * rowb;
    if constexpr (SP2) {
        PG8_STAGE(PG8_SB(0, 0), cB, voffB); PG8_STAGE(PG8_SB(0, 1), cB + hstep, voffB); PG8_STAGEA(PG8_SA(0, 0), cA, 0); PG8_STAGEA(PG8_SA(0, 1), cA, 1);
        if (wr == 1) PG8_BAR;
        PG8_WAIT_V(2); PG8_BAR;
        PG8_STAGE(PG8_SB(1, 0), cB + kstep, voffB); PG8_STAGEA(PG8_SA(1, 0), cA + kstep, 0); PG8_STAGE(PG8_SB(1, 1), cB + hstep + kstep, voffB);
        PG8_WAIT_V(6); PG8_BAR;
    } else {
        PG8_STAGE(PG8_SB(0, 0), cB, voffB); PG8_STAGEA(PG8_SA(0, 0), cA, 0); PG8_STAGE(PG8_SB(0, 1), cB + hstep, voffB); PG8_STAGEA(PG8_SA(0, 1), cA, 1);
        if (wr == 1) PG8_BAR;
        PG8_WAIT_V(4); PG8_BAR;
        PG8_STAGE(PG8_SB(1, 0), cB + kstep, voffB); PG8_STAGEA(PG8_SA(1, 0), cA + kstep, 0); PG8_STAGE(PG8_SB(1, 1), cB + hstep + kstep, voffB);
        PG8_WAIT_V(6); PG8_BAR;
    }
    for (;;) {
        const bool has_next = S.next(ui + 1, nxt);
        if constexpr (GATHER) { if (has_next) {
#pragma unroll
            for (int h = 0; h < 2; ++h)
#pragma unroll
                for (int i = 0; i < 2; ++i) voffGn[h][i] = amap.rowoff(ui + 1, h * HALF + RA[i]) + (unsigned)CA[i] * 2u; } else {
#pragma unroll
            for (int h = 0; h < 2; ++h)
#pragma unroll
                for (int i = 0; i < 2; ++i) voffGn[h][i] = voffG[h][i]; } }
        const char* nA = has_next ? (const char*)g.A + (GATHER ? (size_t)0 : (size_t)nxt.arow * rowb) : cA; const char* nB = has_next ? (const char*)g.Bt + (size_t)nxt.brow * rowb : cB;
#pragma unroll 1
        for (int t = 0; t < nt; t += 2) {
            const bool last = (t == nt - 2);
            const char* a1 = cA + (size_t)(t + 1) * kstep;
            const char* a2 = last ? nA : cA + (size_t)(t + 2) * kstep; const char* b2 = last ? nB : cB + (size_t)(t + 2) * kstep;
            const char* a3 = a2 + kstep; const char* b3 = b2 + kstep;
            unsigned vsel[2][2];
#pragma unroll
            for (int h = 0; h < 2; ++h)
#pragma unroll
                for (int i = 0; i < 2; ++i) vsel[h][i] = last ? voffGn[h][i] : voffG[h][i];
            if constexpr (SP2) {
            PG8_LDB(B0, 0, 0); PG8_LDB(B1, 0, 1); PG8_SCHED; PG8_LDA(At, 0, 0); PG8_STAGEA(PG8_SA(1, 1), a1, 1);
            PG8_WAIT_V(8); PG8_WAIT_L(0); PG8_BAR; PG8_MMA(0, 0, At, B0); PG8_MMA(0, 1, At, B1); PG8_BAR; PG8_SCHED;
            PG8_LDA(At, 0, 1); PG8_STAGE(PG8_SB(0, 0), b2, voffB); PG8_STAGE(PG8_SB(0, 1), b2 + hstep, voffB); PG8_STAGEAN(PG8_SA(0, 0), a2, 0);
            PG8_WAIT_V(8); PG8_WAIT_L(0); PG8_BAR; if (cur.nvalid > HALF) { PG8_MMA(1, 0, At, B0); PG8_MMA(1, 1, At, B1); } PG8_BAR; PG8_SCHED;
            PG8_LDB(B0, 1, 0); PG8_LDB(B1, 1, 1); PG8_SCHED; PG8_LDA(At, 1, 0); PG8_STAGEAN(PG8_SA(0, 1), a2, 1);
            PG8_WAIT_V(8); PG8_WAIT_L(0); PG8_BAR; PG8_MMA(0, 0, At, B0); PG8_MMA(0, 1, At, B1); PG8_BAR; PG8_SCHED;
            PG8_LDA(At, 1, 1); PG8_STAGE(PG8_SB(1, 0), b3, voffB); PG8_STAGE(PG8_SB(1, 1), b3 + hstep, voffB); PG8_STAGEAN(PG8_SA(1, 0), a3, 0);
            PG8_WAIT_V(8); PG8_WAIT_L(0); PG8_BAR; if (cur.nvalid > HALF) { PG8_MMA(1, 0, At, B0); PG8_MMA(1, 1, At, B1); } PG8_BAR; PG8_SCHED;
            } else {
            PG8_LDB(B0, 0, 0); PG8_SCHED; PG8_LDA(At, 0, 0); PG8_STAGEA(PG8_SA(1, 1), a1, 1);
            PG8_WAIT_L(8); PG8_BAR; PG8_WAIT_L(0); PG8_MMA(0, 0, At, B0); PG8_BAR; PG8_SCHED;
            PG8_LDB(B1, 0, 1); PG8_STAGE(PG8_SB(0, 0), b2, voffB);
            PG8_BAR; PG8_WAIT_L(0); PG8_MMA(0, 1, At, B1); PG8_BAR;
            PG8_LDA(At, 0, 1); PG8_STAGEAN(PG8_SA(0, 0), a2, 0);
            PG8_BAR; PG8_WAIT_L(0); PG8_MMA(1, 0, At, B0); PG8_BAR; PG8_SCHED;
            PG8_STAGE(PG8_SB(0, 1), b2 + hstep, voffB);
            PG8_WAIT_V(6); PG8_BAR; PG8_MMA(1, 1, At, B1); PG8_BAR;
            PG8_LDB(B0, 1, 0); PG8_SCHED; PG8_LDA(At, 1, 0); PG8_STAGEAN(PG8_SA(0, 1), a2, 1);
            PG8_WAIT_L(8); PG8_BAR; PG8_WAIT_L(0); PG8_MMA(0, 0, At, B0); PG8_BAR; PG8_SCHED;
            PG8_LDB(B1, 1, 1); PG8_STAGE(PG8_SB(1, 0), b3, voffB);
            PG8_BAR; PG8_WAIT_L(0); PG8_MMA(0, 1, At, B1); PG8_BAR;
            PG8_LDA(At, 1, 1); PG8_STAGEAN(PG8_SA(1, 0), a3, 0);
            PG8_BAR; PG8_WAIT_L(0); PG8_MMA(1, 0, At, B0); PG8_BAR; PG8_SCHED;
            PG8_STAGE(PG8_SB(1, 1), b3 + hstep, voffB);
            PG8_WAIT_V(6); PG8_BAR; PG8_MMA(1, 1, At, B1); PG8_BAR;
            }
        }
        if constexpr (ALIGN_EPI) { if (wr == 0) PG8_BAR; }
        E(acc, cur, wr, wc, fr, fq);
        if (!has_next) break;
#pragma unroll
        for (int a = 0; a < 2; ++a)
#pragma unroll
            for (int b = 0; b < 2; ++b)
#pragma unroll
                for (int m = 0; m < 4; ++m)
#pragma unroll
                    for (int n = 0; n < 2; ++n) acc[a][b][m][n] = (f32x4){0.f, 0.f, 0.f, 0.f};
        cur = nxt; cA = nA; cB = nB; ++ui;
        if constexpr (GATHER) {
#pragma unroll
            for (int h = 0; h < 2; ++h)
#pragma unroll
                for (int i = 0; i < 2; ++i) voffG[h][i] = voffGn[h][i]; }
        if constexpr (ALIGN_EPI) { if (wr == 1) PG8_BAR; }
    }
    PG8_WAIT_V(0);
    if constexpr (!ALIGN_EPI) { if (wr == 0) PG8_BAR; }
    PG8_BAR;
#undef PG8_SA
#undef PG8_SB
#undef PG8_STAGE
#undef PG8_STAGEA
#undef PG8_STAGEAN
#undef PG8_LDA
#undef PG8_LDB
#undef PG8_MMA
#undef PG8_WAIT_V
#undef PG8_WAIT_L
#undef PG8_BAR
#undef PG8_SCHED
}

struct EpiBf16 {
    static constexpr bool PERM = true;
    bf16* O; int ldc; int skip;
    __device__ __forceinline__ void operator()(const f32x4 (&acc)[2][2][4][2], const Unit& u, int wr, int wc, int fr, int fq) const {
#pragma unroll
        for (int ai = 0; ai < 2; ++ai)
#pragma unroll
            for (int m = 0; m < 4; ++m) { const int lr = ai * HALF + wr * 64 + m * 16 + fr; if (lr < u.nvalid - skip) { bf16* rowp = O + (size_t)(u.orow + lr) * ldc + u.ocol + wc * 32 + 8 * fq;
#pragma unroll
                for (int bj = 0; bj < 2; ++bj) { const f32x4 v0 = acc[ai][bj][m][0], v1 = acc[ai][bj][m][1]; u32x4 w; w.x = pk2(v0[0], v0[1]); w.y = pk2(v0[2], v0[3]); w.z = pk2(v1[0], v1[1]); w.w = pk2(v1[2], v1[3]);
                    *(u32x4*)(rowp + bj * HALF) = w; } } }
    }
};
struct EpiFp8 {
    static constexpr bool PERM = true;
    unsigned char* O; int ldc; int skip;
    __device__ __forceinline__ void operator()(const f32x4 (&acc)[2][2][4][2], const Unit& u, int wr, int wc, int fr, int fq) const {
#pragma unroll
        for (int ai = 0; ai < 2; ++ai)
#pragma unroll
            for (int m = 0; m < 4; ++m) { const int lr = ai * HALF + wr * 64 + m * 16 + fr; if (lr < u.nvalid - skip) { unsigned char* rowp = O + (size_t)(u.orow + lr) * ldc + u.ocol + wc * 32 + 8 * fq;
#pragma unroll
                for (int bj = 0; bj < 2; ++bj) { const f32x4 v0 = acc[ai][bj][m][0], v1 = acc[ai][bj][m][1]; int w0 = 0, w1 = 0;
                    w0 = __builtin_amdgcn_cvt_pk_fp8_f32(v0[0], v0[1], w0, false); w0 = __builtin_amdgcn_cvt_pk_fp8_f32(v0[2], v0[3], w0, true);
                    w1 = __builtin_amdgcn_cvt_pk_fp8_f32(v1[0], v1[1], w1, false); w1 = __builtin_amdgcn_cvt_pk_fp8_f32(v1[2], v1[3], w1, true);
                    *(u32x2*)(rowp + bj * HALF) = (u32x2){(unsigned)w0, (unsigned)w1}; } } }
    }
};
struct EpiF32 {
    static constexpr bool PERM = false;
    float* C; int ldc;
    __device__ __forceinline__ void operator()(const f32x4 (&acc)[2][2][4][2], const Unit& u, int wr, int wc, int fr, int fq) const {
#pragma unroll
        for (int ai = 0; ai < 2; ++ai)
#pragma unroll
            for (int m = 0; m < 4; ++m) { float* rowp = C + (size_t)(u.orow + ai * HALF + wr * 64 + m * 16 + fr) * ldc + u.ocol + wc * 32 + 4 * fq;
#pragma unroll
                for (int bj = 0; bj < 2; ++bj)
#pragma unroll
                    for (int n = 0; n < 2; ++n) *(f32x4*)(rowp + bj * HALF + n * 16) = acc[ai][bj][m][n]; }
    }
};
struct EpiResid {
    static constexpr bool PERM = true;
    const float* x; bf16* out; const float* mod; int goff;
    __device__ __forceinline__ void operator()(const f32x4 (&acc)[2][2][4][2], const Unit& u, int wr, int wc, int fr, int fq) const {
        const int b = u.orow / SEQ; const float* gp = mod + (size_t)b * 6144 + goff + u.ocol + wc * 32 + 8 * fq;
        f32x4 gv[2][2];
#pragma unroll
        for (int bj = 0; bj < 2; ++bj)
#pragma unroll
            for (int n = 0; n < 2; ++n) gv[bj][n] = *(const f32x4*)(gp + bj * HALF + 4 * n);
#pragma unroll
        for (int ai = 0; ai < 2; ++ai)
#pragma unroll
            for (int mp = 0; mp < 4; mp += 2) {
                f32x4 xv[2][2][2];
#pragma unroll
                for (int mm = 0; mm < 2; ++mm) { const size_t off = (size_t)(u.orow + ai * HALF + wr * 64 + (mp + mm) * 16 + fr) * DM + u.ocol + wc * 32 + 8 * fq;
#pragma unroll
                    for (int bj = 0; bj < 2; ++bj)
#pragma unroll
                        for (int n = 0; n < 2; ++n) xv[mm][bj][n] = *(const f32x4*)(x + off + bj * HALF + 4 * n); }
#pragma unroll
                for (int mm = 0; mm < 2; ++mm) { const size_t off = (size_t)(u.orow + ai * HALF + wr * 64 + (mp + mm) * 16 + fr) * DM + u.ocol + wc * 32 + 8 * fq;
#pragma unroll
                    for (int bj = 0; bj < 2; ++bj) { const f32x4 o0 = xv[mm][bj][0] + gv[bj][0] * acc[ai][bj][mp + mm][0], o1 = xv[mm][bj][1] + gv[bj][1] * acc[ai][bj][mp + mm][1];
                        *(u32x4*)(out + off + bj * HALF) = (u32x4){pk2(o0[0], o0[1]), pk2(o0[2], o0[3]), pk2(o1[0], o1[1]), pk2(o1[2], o1[3])}; } }
            }
    }
};
struct EpiSwiglu {
    static constexpr bool PERM = true;
    bf16* act;
    __device__ __forceinline__ void operator()(const f32x4 (&acc)[2][2][4][2], const Unit& u, int wr, int wc, int fr, int fq) const {
#pragma unroll
        for (int ai = 0; ai < 2; ++ai)
#pragma unroll
            for (int m = 0; m < 4; ++m) { const int lr = ai * HALF + wr * 64 + m * 16 + fr; if (lr < u.nvalid) {
                float o[8];
#pragma unroll
                for (int n = 0; n < 2; ++n)
#pragma unroll
                    for (int i = 0; i < 4; ++i) { const float a = acc[ai][0][m][n][i], c = acc[ai][1][m][n][i]; o[4 * n + i] = a * sigmoidf_(a) * c; }
                u32x4 w; w.x = pk2(o[0], o[1]); w.y = pk2(o[2], o[3]); w.z = pk2(o[4], o[5]); w.w = pk2(o[6], o[7]);
                *(u32x4*)(act + (size_t)(u.orow + lr) * 256 + u.ocol + wc * 32 + 8 * fq) = w; } }
    }
};
struct EpiLora {
    static constexpr bool PERM = true;
    const float* w0; const float* a0; const float* k_a; bf16* EE; bf16* XK; const bf16* KKN; bf16* BV; bf16* GG;
    __device__ __forceinline__ void operator()(const f32x4 (&acc)[2][2][4][2], const Unit& u, int wr, int wc, int fr, int fq) const {
        const int br = u.ocol >> 9;
        const int cbase = (u.ocol & 511) + wc * 32 + 8 * fq;
        const size_t rbase = (size_t)(u.orow + wr * 64 + fr) * 512 + cbase;
        if (br == 0) {
#pragma unroll
            for (int bj = 0; bj < 2; ++bj) {
                const f32x4 pa = *(const f32x4*)(w0 + cbase + bj * HALF), pb = *(const f32x4*)(w0 + cbase + bj * HALF + 4);
#pragma unroll
                for (int ai = 0; ai < 2; ++ai)
#pragma unroll
                    for (int m = 0; m < 4; ++m) {
                        float e[8];
#pragma unroll
                        for (int i = 0; i < 4; ++i) {
                            { const float z = -(pa[i] + acc[ai][bj][m][0][i]); const float sp = fmaxf(z, 0.f) + __logf(1.0f + __expf(-fabsf(z))); e[i] = __expf(-sp - 0.5f); }
                            { const float z = -(pb[i] + acc[ai][bj][m][1][i]); const float sp = fmaxf(z, 0.f) + __logf(1.0f + __expf(-fabsf(z))); e[4 + i] = __expf(-sp - 0.5f); }
                        }
                        u32x4 w; w.x = pk2(e[0], e[1]); w.y = pk2(e[2], e[3]); w.z = pk2(e[4], e[5]); w.w = pk2(e[6], e[7]);
                        *(u32x4*)(EE + rbase + (size_t)(ai * HALF + m * 16) * 512 + bj * HALF) = w;
                    }
            }
        } else if (br == 1) {
#pragma unroll
            for (int bj = 0; bj < 2; ++bj) {
                const f32x4 pa = *(const f32x4*)(a0 + cbase + bj * HALF), pb = *(const f32x4*)(a0 + cbase + bj * HALF + 4);
#pragma unroll
                for (int ai = 0; ai < 2; ++ai)
#pragma unroll
                    for (int m = 0; m < 4; ++m) {
                        float av[8];
#pragma unroll
                        for (int i = 0; i < 4; ++i) { av[i] = sigmoidf_(pa[i] + acc[ai][bj][m][0][i]); av[4 + i] = sigmoidf_(pb[i] + acc[ai][bj][m][1][i]); }
                        u32x4 w; w.x = pk2(av[0], av[1]); w.y = pk2(av[2], av[3]); w.z = pk2(av[4], av[5]); w.w = pk2(av[6], av[7]);
                        *(u32x4*)(BV + rbase + (size_t)(ai * HALF + m * 16) * 512 + bj * HALF) = w;
                    }
            }
        } else {
#pragma unroll
            for (int bj = 0; bj < 2; ++bj)
#pragma unroll
                for (int ai = 0; ai < 2; ++ai)
#pragma unroll
                    for (int m = 0; m < 4; ++m) {
                        const f32x4 v0 = acc[ai][bj][m][0], v1 = acc[ai][bj][m][1];
                        u32x4 w; w.x = pk2(v0[0], v0[1]); w.y = pk2(v0[2], v0[3]); w.z = pk2(v1[0], v1[1]); w.w = pk2(v1[2], v1[3]);
                        *(u32x4*)(GG + rbase + (size_t)(ai * HALF + m * 16) * 512 + bj * HALF) = w;
                    }
        }
    }
};
}

#define XB_TMO      128
#define XB_XCNT(j)  (256  + 64 * (j))
#define XB_XSUB(j)  (1280 + 64 * (j))
#define XB_XGEN(j)  (2304 + 64 * (j))
#define XB_TOP      3328
#define XB_TOPGEN   3392
#define XCD_BAR_WORDS 3456
#define XB_SPIN_CAP (1u << 22)
__device__ __forceinline__ unsigned xb_ld(unsigned* p)              { return __hip_atomic_load(p, __ATOMIC_RELAXED, __HIP_MEMORY_SCOPE_AGENT); }
__device__ __forceinline__ unsigned xb_add(unsigned* p, unsigned v) { return __hip_atomic_fetch_add(p, v, __ATOMIC_RELAXED, __HIP_MEMORY_SCOPE_AGENT); }
__device__ __forceinline__ unsigned xb_xcc_id() { return (unsigned)__builtin_amdgcn_s_getreg((3 << 11) | 20) & 0xFu; }
#define XB_SPIN(cond, bar) do { unsigned _sp = 0; while (cond) { __builtin_amdgcn_s_sleep(1); \
    if ((++_sp & 255u) == 0u) { if (xb_ld(&(bar)[XB_TMO])) break; if (_sp > XB_SPIN_CAP) { atomicAdd(&(bar)[XB_TMO], 1u); break; } } } } while (0)
struct XcdBarrier { unsigned* bar; unsigned x; volatile LAS unsigned* st; };
__device__ __forceinline__ XcdBarrier xcd_barrier_post(unsigned* bar, volatile LAS unsigned* st) {
    XcdBarrier b; b.bar = bar; b.x = xb_xcc_id(); b.st = st;
    if (threadIdx.x == 0) (void)xb_add(&bar[XB_XCNT(b.x)], 1u);
    return b;
}
__device__ __forceinline__ void xcd_barrier_complete(unsigned* bar, unsigned x, unsigned& nloc, unsigned& nx) {
    const unsigned G = gridDim.x * gridDim.y * gridDim.z;
    unsigned sum, cnt, mine, sp = 0u;
    for (;;) {
        sum = 0u; cnt = 0u; mine = 0u;
#pragma unroll
        for (unsigned j = 0; j < 16; ++j) { const unsigned c = xb_ld(&bar[XB_XCNT(j)]); sum += c; cnt += (c > 0u) ? 1u : 0u; mine = (j == x) ? c : mine; }
        if (sum == G) break;
        __builtin_amdgcn_s_sleep(1);
        if ((++sp & 255u) == 0u) { if (xb_ld(&bar[XB_TMO])) break; if (sp > XB_SPIN_CAP) { atomicAdd(&bar[XB_TMO], 1u); break; } }
    }
    nloc = mine > 0u ? mine : 1u; nx = cnt > 0u ? cnt : 1u;
}
__device__ __forceinline__ void xcd_barrier(const XcdBarrier& b) {
    asm volatile("s_waitcnt vmcnt(0)" ::: "memory");
    __syncthreads();
    if (threadIdx.x == 0) {
        unsigned* bar = b.bar;
        __builtin_amdgcn_s_waitcnt(0);
        unsigned nloc = b.st[0], nx = b.st[1];
        if (nloc == 0u) { xcd_barrier_complete(bar, b.x, nloc, nx); b.st[0] = nloc; b.st[1] = nx; }
        const unsigned old = xb_add(&bar[XB_XSUB(b.x)], 1u);
        const unsigned gen = old / nloc;
        if (old + 1u == (gen + 1u) * nloc) {
            __builtin_amdgcn_fence(__ATOMIC_RELEASE, "agent");
            asm volatile("s_waitcnt vmcnt(0)" ::: "memory");
            const unsigned og = xb_add(&bar[XB_TOP], 1u);
            const unsigned tg = og / nx;
            if (og + 1u == (tg + 1u) * nx) xb_add(&bar[XB_TOPGEN], 1u);
            else XB_SPIN(xb_ld(&bar[XB_TOPGEN]) == tg, bar);
            __builtin_amdgcn_fence(__ATOMIC_ACQUIRE, "agent");
            xb_add(&bar[XB_XGEN(b.x)], 1u);
            asm volatile("s_waitcnt vmcnt(0)" ::: "memory");
        } else {
            XB_SPIN(xb_ld(&bar[XB_XGEN(b.x)]) == gen, bar);
            __builtin_amdgcn_fence(__ATOMIC_ACQUIRE, "agent");
            asm volatile("s_waitcnt vmcnt(0)" ::: "memory");
        }
    }
    __syncthreads();
}

struct Args { const float* in[33]; float* out; unsigned char* ws; int ph_lo, ph_hi, probe, pad; };

#define LDS_WAIT() asm volatile("s_waitcnt lgkmcnt(0)" ::: "memory")

__device__ __forceinline__ void p0_transpose_item(const float* W, int K, int Nsrc, bf16* WT, int dest_row0, int k0, int n0, LAS float* scr, int lane) {
    const int c4 = 4 * (lane & 15), kr = lane >> 4; const bool ok = (n0 + c4) < Nsrc;
    f32x4 tv[16];
#pragma unroll
    for (int i = 0; i < 16; ++i) { const int kk = 4 * i + kr; tv[i] = ok ? __builtin_nontemporal_load((const f32x4*)(W + (size_t)(k0 + kk) * Nsrc + n0 + c4)) : (f32x4){0.f, 0.f, 0.f, 0.f}; }
#pragma unroll
    for (int i = 0; i < 16; ++i) { const int kk = 4 * i + kr; LAS float* d = scr + kk * 65 + c4; d[0] = tv[i].x; d[1] = tv[i].y; d[2] = tv[i].z; d[3] = tv[i].w; }
    LDS_WAIT(); asm volatile("" ::: "memory");
    const int c = lane & 7;
#pragma unroll
    for (int j = 0; j < 8; ++j) { const int n = (lane >> 3) + 8 * j; const LAS float* sp = scr + (8 * c) * 65 + n;
        u32x4 o; o.x = pk2(sp[0 * 65], sp[1 * 65]); o.y = pk2(sp[2 * 65], sp[3 * 65]); o.z = pk2(sp[4 * 65], sp[5 * 65]); o.w = pk2(sp[6 * 65], sp[7 * 65]);
        *(u32x4*)(WT + (size_t)(dest_row0 + n) * K + k0 + 8 * c) = o; }
    LDS_WAIT(); asm volatile("" ::: "memory");
}
struct P0Item { const float* src; bf16* dst; int K, Nsrc, dest_row0, k0, n0; };
__device__ __forceinline__ P0Item p0_expert_desc(const Args& args, unsigned char* ws, int e, int q) {
    P0Item it;
    if (q < 128) {
        const int which = q >> 6, qq = q & 63, kb = qq / 4, nb = qq % 4, n0 = 64 * nb;
        it.src = (e < 256) ? args.in[which ? 28 : 27] + (size_t)e * 1024 * 256 : args.in[which ? 31 : 30];
        it.dst = (bf16*)(ws + WS_W13T) + (size_t)e * 512 * 1024; it.K = 1024; it.Nsrc = 256; it.dest_row0 = (n0 >> 7) * 256 + (n0 & 127) + which * 128; it.k0 = 64 * kb; it.n0 = n0;
    } else {
        const int qq = q - 128, kb = qq / 16, nb = qq % 16;
        it.src = (e < 256) ? args.in[29] + (size_t)e * 256 * 1024 : args.in[32];
        it.dst = (bf16*)(ws + WS_W2T) + (size_t)e * 1024 * 256; it.K = 256; it.Nsrc = 1024; it.dest_row0 = 64 * nb; it.k0 = 64 * kb; it.n0 = 64 * nb;
    }
    return it;
}
__device__ __forceinline__ void p0_expert_item(const Args& args, unsigned char* ws, int e, int q, LAS float* scr, int lane) {
    const P0Item it = p0_expert_desc(args, ws, e, q);
    p0_transpose_item(it.src, it.K, it.Nsrc, it.dst, it.dest_row0, it.k0, it.n0, scr, lane);
}
__device__ __forceinline__ void p0_expert_wave(const Args& args, unsigned char* ws, int e, int qbeg, int qend, int wave, LAS float* scr, int lane) {
    const int c4 = 4 * (lane & 15), kr = lane >> 4, c = lane & 7;
    LAS unsigned* S = (LAS unsigned*)scr;
    f32x4 tv[16];
    P0Item cur = p0_expert_desc(args, ws, e, qbeg + wave);
#pragma unroll
    for (int i = 0; i < 16; ++i) tv[i] = __builtin_nontemporal_load((const f32x4*)(cur.src + (size_t)(cur.k0 + 8 * (i >> 1) + 2 * kr + (i & 1)) * cur.Nsrc + cur.n0 + c4));
    auto step = [&](int q) {
#pragma unroll
        for (int i = 0; i < 8; ++i) { LAS unsigned* d = S + c4 * 33 + 4 * i + kr;
            d[0] = pk2(tv[2 * i].x, tv[2 * i + 1].x); d[33] = pk2(tv[2 * i].y, tv[2 * i + 1].y); d[66] = pk2(tv[2 * i].z, tv[2 * i + 1].z); d[99] = pk2(tv[2 * i].w, tv[2 * i + 1].w); }
        const P0Item nxt = p0_expert_desc(args, ws, e, (q + 8 < qend) ? q + 8 : q);
#pragma unroll
        for (int i = 0; i < 16; ++i) tv[i] = __builtin_nontemporal_load((const f32x4*)(nxt.src + (size_t)(nxt.k0 + 8 * (i >> 1) + 2 * kr + (i & 1)) * nxt.Nsrc + nxt.n0 + c4));
        LDS_WAIT(); asm volatile("" ::: "memory");
#pragma unroll
        for (int j = 0; j < 8; ++j) { const int n = (lane >> 3) + 8 * j; const LAS unsigned* sp = S + n * 33 + 4 * c;
            u32x4 o; o.x = sp[0]; o.y = sp[1]; o.z = sp[2]; o.w = sp[3];
            __builtin_nontemporal_store(o, (u32x4*)(cur.dst + (size_t)(cur.dest_row0 + n) * cur.K + cur.k0 + 8 * c)); }
        LDS_WAIT(); asm volatile("" ::: "memory");
        cur = nxt;
    };
    step(qbeg + wave);
#pragma unroll 1
    for (int q = qbeg + wave + 8; q < qend; q += 8) step(q);
}
__device__ __forceinline__ float wave_sum(float v) {
#pragma unroll
    for (int o = 1; o < 64; o <<= 1) v += __shfl_xor(v, o);
    return v;
}
__device__ __forceinline__ void norm_mod_rows16(const float* xbase, const float* g, const float* shift, const float* scale, bf16* obase, int lane) {
    f32x4 gs[4], sh[4];
#pragma unroll
    for (int j = 0; j < 4; ++j) { gs[j] = ((const f32x4*)g)[lane + 64 * j] * (((const f32x4*)scale)[lane + 64 * j] + 1.0f); sh[j] = ((const f32x4*)shift)[lane + 64 * j]; }
#pragma unroll 1
    for (int r = 0; r < 16; r += 2) {
        const f32x4* x0 = (const f32x4*)(xbase + (size_t)r * DM) + lane; const f32x4* x1 = x0 + DM / 4;
        f32x4 v0[4], v1[4]; float s0 = 0.f, s1 = 0.f;
#pragma unroll
        for (int j = 0; j < 4; ++j) { v0[j] = x0[64 * j]; v1[j] = x1[64 * j]; }
#pragma unroll
        for (int j = 0; j < 4; ++j) { s0 += (v0[j].x * v0[j].x + v0[j].y * v0[j].y) + (v0[j].z * v0[j].z + v0[j].w * v0[j].w); s1 += (v1[j].x * v1[j].x + v1[j].y * v1[j].y) + (v1[j].z * v1[j].z + v1[j].w * v1[j].w); }
        const float r0 = 1.0f / sqrtf(wave_sum(s0) * (1.f / DM) + 1e-6f), r1 = 1.0f / sqrtf(wave_sum(s1) * (1.f / DM) + 1e-6f);
        unsigned long long* o0 = (unsigned long long*)(obase + (size_t)r * DM) + lane; unsigned long long* o1 = o0 + DM / 4;
#pragma unroll
        for (int j = 0; j < 4; ++j) {
            const f32x4 y0 = v0[j] * r0 * gs[j] + sh[j], y1 = v1[j] * r1 * gs[j] + sh[j];
            o0[64 * j] = (unsigned long long)pk2(y0.x, y0.y) | ((unsigned long long)pk2(y0.z, y0.w) << 32);
            o1[64 * j] = (unsigned long long)pk2(y1.x, y1.y) | ((unsigned long long)pk2(y1.z, y1.w) << 32);
        }
    }
}

__device__ __forceinline__ void norm_mod_rows16_bf(const bf16* xbase, const float* g, const float* shift, const float* scale, bf16* obase, int lane) {
    f32x4 gs[4], sh[4];
#pragma unroll
    for (int j = 0; j < 4; ++j) { gs[j] = ((const f32x4*)g)[lane + 64 * j] * (((const f32x4*)scale)[lane + 64 * j] + 1.0f); sh[j] = ((const f32x4*)shift)[lane + 64 * j]; }
#pragma unroll 1
    for (int r = 0; r < 16; r += 2) {
        const u32x2* x0 = (const u32x2*)(xbase + (size_t)r * DM) + lane; const u32x2* x1 = x0 + DM / 4;
        u32x2 w0[4], w1[4]; f32x4 v0[4], v1[4]; float s0 = 0.f, s1 = 0.f;
#pragma unroll
        for (int j = 0; j < 4; ++j) { w0[j] = x0[64 * j]; w1[j] = x1[64 * j]; }
#pragma unroll
        for (int j = 0; j < 4; ++j) { v0[j] = (f32x4){lo16(w0[j].x), hi16(w0[j].x), lo16(w0[j].y), hi16(w0[j].y)}; v1[j] = (f32x4){lo16(w1[j].x), hi16(w1[j].x), lo16(w1[j].y), hi16(w1[j].y)};
            s0 += (v0[j].x * v0[j].x + v0[j].y * v0[j].y) + (v0[j].z * v0[j].z + v0[j].w * v0[j].w); s1 += (v1[j].x * v1[j].x + v1[j].y * v1[j].y) + (v1[j].z * v1[j].z + v1[j].w * v1[j].w); }
        const float r0 = 1.0f / sqrtf(wave_sum(s0) * (1.f / DM) + 1e-6f), r1 = 1.0f / sqrtf(wave_sum(s1) * (1.f / DM) + 1e-6f);
        unsigned long long* o0 = (unsigned long long*)(obase + (size_t)r * DM) + lane; unsigned long long* o1 = o0 + DM / 4;
#pragma unroll
        for (int j = 0; j < 4; ++j) {
            const f32x4 y0 = v0[j] * r0 * gs[j] + sh[j], y1 = v1[j] * r1 * gs[j] + sh[j];
            o0[64 * j] = (unsigned long long)pk2(y0.x, y0.y) | ((unsigned long long)pk2(y0.z, y0.w) << 32);
            o1[64 * j] = (unsigned long long)pk2(y1.x, y1.y) | ((unsigned long long)pk2(y1.z, y1.w) << 32);
        }
    }
}

__device__ __forceinline__ float quad_sum(float x) {
    x += __builtin_bit_cast(float, __builtin_amdgcn_update_dpp(0, __builtin_bit_cast(int, x), 0xB1, 0xF, 0xF, true));
    x += __builtin_bit_cast(float, __builtin_amdgcn_update_dpp(0, __builtin_bit_cast(int, x), 0x4E, 0xF, 0xF, true));
    return x;
}
__device__ __forceinline__ float red16(float x) { x += __shfl_xor(x, 1); x += __shfl_xor(x, 2); x += __shfl_xor(x, 4); x += __shfl_xor(x, 8); return x; }
__device__ __forceinline__ float red8(float x) { x += __shfl_xor(x, 1); x += __shfl_xor(x, 2); x += __shfl_xor(x, 4); return x; }

constexpr int CP = 80;
constexpr int MB = 64 * CP * 2;
#define CMAT(i) ((LAS bf16*)(lds + (i) * MB))
__device__ __forceinline__ f32x4 mm_tile(const LAS bf16* A, const LAS bf16* Bt, int m0, int n0, int fr, int fq, f32x4 acc) {
#pragma unroll
    for (int ks = 0; ks < 2; ++ks) {
        const bf16x8 a = *(const LAS bf16x8*)(A + (m0 + fr) * CP + 32 * ks + 8 * fq), b = *(const LAS bf16x8*)(Bt + (n0 + fr) * CP + 32 * ks + 8 * fq);
        acc = __builtin_amdgcn_mfma_f32_16x16x32_bf16(a, b, acc, 0, 0, 0);
    }
    return acc;
}
__device__ __forceinline__ void tstore(LAS bf16* dst, int m0, int n0, int fr, int fq, f32x4 v) {
    u32x2 w; w.x = pk2(v[0], v[1]); w.y = pk2(v[2], v[3]);
    *(LAS u32x2*)(dst + (n0 + fr) * CP + m0 + 4 * fq) = w;
}
__device__ __forceinline__ void nstore(LAS bf16* dst, int m0, int n0, int fr, int fq, f32x4 v) {
#pragma unroll
    for (int r = 0; r < 4; ++r) dst[(m0 + 4 * fq + r) * CP + n0 + fr] = (bf16)f2bf(v[r]);
}
__device__ __forceinline__ void scan_job(LAS unsigned char* lds, int job, const unsigned char* ws, const float* r_k, const float* ln_w, const float* ln_b, const float* k_k, const float* k_a, int tid, int lane, int wave, int pmode) {
#define REPS(k) for (int _rp = 0; _rp < ((pmode == 10 + (k)) ? 5 : 1); ++_rp)
    const bf16* XR = (const bf16*)(ws + WS_XR); const bf16* EE = (const bf16*)(ws + WS_EE); const bf16* XK = (const bf16*)(ws + WS_XK);
    const bf16* XV = (const bf16*)(ws + WS_XV); const bf16* KKN = (const bf16*)(ws + WS_KKN); const bf16* BV = (const bf16*)(ws + WS_BV);
    const bf16* GG = (const bf16*)(ws + WS_GG); bf16* YC = (bf16*)(ws + WS_H);
    asm volatile("" : "+v"(tid), "+v"(lane));
    const int b = job >> 3, h = job & 7;
    const int fr = lane & 15, fq = lane >> 4;
    const int tm0 = 16 * (wave >> 1), tn0 = 32 * (wave & 1);
    const int et = tid >> 3, ej = 8 * (tid & 7);
    LAS bf16* Kt = CMAT(0); LAS bf16* Rt = CMAT(1); LAS bf16* Kh = CMAT(2); LAS bf16* Bh = CMAT(3); LAS bf16* KgT = CMAT(4); LAS bf16* BgT = CMAT(5); LAS bf16* VT = CMAT(6);
    LAS bf16* Akk = CMAT(7); LAS bf16* Lm = CMAT(8); LAS bf16* LT = CMAT(9); LAS bf16* Ark = CMAT(10); LAS bf16* Arb = CMAT(11);
    LAS float* Ebuf = (LAS float*)(lds + 7 * MB);
    LAS float* Ybuf = (LAS float*)(lds + 2 * MB);
    LAS float* gCv = (LAS float*)(lds + TAB_OFF);
    LAS float* bonv = gCv + 64;
    LAS float* Wtot = gCv + 128;
    const size_t mbase = (size_t)b * SEQ;
    f32x4 Sreg[2]; Sreg[0] = (f32x4){0.f, 0.f, 0.f, 0.f}; Sreg[1] = Sreg[0];
    for (int i = tid; i < MB / 4; i += 512) ((LAS unsigned*)(lds + 14 * MB))[i] = 0u;
    u32x4 ld[6];
    auto issue = [&](int c) {
        const size_t off = (mbase + 64 * c + et) * 512 + h * 64 + ej;
        ld[0] = *(const u32x4*)(XR + off); ld[1] = *(const u32x4*)(EE + off); ld[2] = *(const u32x4*)(XK + off);
        ld[3] = *(const u32x4*)(XV + off); ld[4] = *(const u32x4*)(BV + off); ld[5] = *(const u32x4*)(GG + off);
    };
    LAS float* rkl = gCv + 640; LAS float* lwl = gCv + 704; LAS float* lbl = gCv + 768;
    LAS float* kkl = gCv + 832; LAS float* kal = gCv + 896;
    if (tid < 64) { rkl[tid] = r_k[h * 64 + tid]; lwl[tid] = ln_w[h * 64 + tid]; lbl[tid] = ln_b[h * 64 + tid]; kkl[tid] = k_k[h * 64 + tid]; kal[tid] = k_a[h * 64 + tid]; }
    issue(0);
    __syncthreads();
#pragma unroll 1
    for (int c = 0; c < SEQ / 64; ++c) {
        LAS bf16* S0c = CMAT(14);
        float rr[8], ee[8], kk2[8], vv[8], kn[8], bb[8];
        {
            float n2 = 0.f;
#pragma unroll
            for (int i = 0; i < 4; ++i) { const unsigned w0 = ld[0][i], w1 = ld[1][i], w2 = ld[2][i], w3 = ld[3][i], w4 = ld[4][i];
                rr[2 * i] = lo16(w0); rr[2 * i + 1] = hi16(w0); ee[2 * i] = lo16(w1); ee[2 * i + 1] = hi16(w1); kk2[2 * i] = lo16(w2); kk2[2 * i + 1] = hi16(w2);
                vv[2 * i] = lo16(w3); vv[2 * i + 1] = hi16(w3); bb[2 * i] = lo16(w4); bb[2 * i + 1] = hi16(w4); }
#pragma unroll
            for (int i = 0; i < 8; ++i) { kn[i] = kk2[i] * kkl[ej + i]; n2 += kn[i] * kn[i]; }
            const float inv = 1.0f / fmaxf(sqrtf(red8(n2)), 1e-12f);
#pragma unroll
            for (int i = 0; i < 8; ++i) { kn[i] *= inv; kk2[i] *= 1.0f + (bb[i] - 1.0f) * kal[ej + i]; bb[i] *= kn[i]; }
        }
        const u32x4 gw = ld[5];
        REPS(0) {
        float cum[8];
#pragma unroll
        for (int i = 0; i < 8; ++i) cum[i] = ee[i];
#pragma unroll
        for (int o = 8; o < 64; o <<= 1) {
#pragma unroll
            for (int i = 0; i < 8; ++i) { const float y = __shfl_up(cum[i], o); if (lane >= o) cum[i] += y; } }
        if (lane >= 56) { *(LAS f32x4*)(Wtot + wave * 64 + ej) = (f32x4){cum[0], cum[1], cum[2], cum[3]}; *(LAS f32x4*)(Wtot + wave * 64 + ej + 4) = (f32x4){cum[4], cum[5], cum[6], cum[7]}; }
        __syncthreads();
        {
            float off[8], cumC[8];
#pragma unroll
            for (int i = 0; i < 8; ++i) { off[i] = 0.f; cumC[i] = 0.f; }
#pragma unroll
            for (int w = 0; w < 8; ++w) { const f32x4 a = *(const LAS f32x4*)(Wtot + w * 64 + ej), bq = *(const LAS f32x4*)(Wtot + w * 64 + ej + 4);
                const float tv[8] = {a.x, a.y, a.z, a.w, bq.x, bq.y, bq.z, bq.w};
#pragma unroll
                for (int i = 0; i < 8; ++i) { cumC[i] += tv[i]; off[i] += (w < wave) ? tv[i] : 0.f; } }
            float bsum = 0.f;
            unsigned pkt[4], prt[4], pkh[4], pbh[4], pkg[4], pbg[4], pvn[4]; float okt[8], ort[8], okh[8], obh[8], okg[8], obg[8];
#pragma unroll
            for (int i = 0; i < 8; ++i) {
                const float cm = cum[i] + off[i], cc = cumC[i];
                const float g = __expf(-cm), gp = __expf(ee[i] - cm), gi = __expf(cm), gc = __expf(cm - cc);
                okt[i] = kn[i] * gp; ort[i] = rr[i] * g; okh[i] = kk2[i] * gi; obh[i] = bb[i] * gi; okg[i] = kk2[i] * gc; obg[i] = bb[i] * gc;
                if (et == 63) gCv[ej + i] = __expf(-cc);
                bsum += rr[i] * kk2[i] * rkl[ej + i];
            }
#pragma unroll
            for (int i = 0; i < 4; ++i) { pkt[i] = pk2(okt[2 * i], okt[2 * i + 1]); prt[i] = pk2(ort[2 * i], ort[2 * i + 1]); pkh[i] = pk2(okh[2 * i], okh[2 * i + 1]); pbh[i] = pk2(obh[2 * i], obh[2 * i + 1]);
                pkg[i] = pk2(okg[2 * i], okg[2 * i + 1]); pbg[i] = pk2(obg[2 * i], obg[2 * i + 1]); pvn[i] = pk2(vv[2 * i], vv[2 * i + 1]); }
            *(LAS u32x4*)(Kt + et * CP + ej) = (u32x4){pkt[0], pkt[1], pkt[2], pkt[3]}; *(LAS u32x4*)(Rt + et * CP + ej) = (u32x4){prt[0], prt[1], prt[2], prt[3]};
            *(LAS u32x4*)(Kh + et * CP + ej) = (u32x4){pkh[0], pkh[1], pkh[2], pkh[3]}; *(LAS u32x4*)(Bh + et * CP + ej) = (u32x4){pbh[0], pbh[1], pbh[2], pbh[3]};
            *(LAS u32x4*)(CMAT(9) + et * CP + ej) = (u32x4){pkg[0], pkg[1], pkg[2], pkg[3]}; *(LAS u32x4*)(CMAT(10) + et * CP + ej) = (u32x4){pbg[0], pbg[1], pbg[2], pbg[3]};
            *(LAS u32x4*)(CMAT(11) + et * CP + ej) = (u32x4){pvn[0], pvn[1], pvn[2], pvn[3]};
            bsum = red8(bsum);
            if ((tid & 7) == 0) bonv[et] = bsum;
        }
        __syncthreads();
        {
            const int tj = tid & 63, tb = 8 * (tid >> 6);
#pragma unroll
            for (int mtx = 0; mtx < 3; ++mtx) {
                const LAS bf16* src = CMAT(9 + mtx); LAS bf16* dst = CMAT(4 + mtx); unsigned e[8];
#pragma unroll
                for (int i = 0; i < 8; ++i) e[i] = src[(tb + i) * CP + tj];
                *(LAS u32x4*)(dst + tj * CP + tb) = (u32x4){e[0] | (e[1] << 16), e[2] | (e[3] << 16), e[4] | (e[5] << 16), e[6] | (e[7] << 16)};
            }
        }
        __syncthreads();
        }
        if (c + 1 < SEQ / 64) issue(c + 1);
        const f32x4 z4 = (f32x4){0.f, 0.f, 0.f, 0.f};
        REPS(1) {
#pragma unroll
        for (int tt = 0; tt < 2; ++tt) {
            const int m0 = tm0, n0 = tn0 + 16 * tt;
            f32x4 a1 = z4, a2 = z4, a3 = z4, a4 = z4, a5 = z4;
            if (m0 <= n0) { a1 = mm_tile(Kh, Kt, m0, n0, fr, fq, z4); a2 = mm_tile(Bh, Kt, m0, n0, fr, fq, z4); a4 = mm_tile(Kh, Rt, m0, n0, fr, fq, z4); a5 = mm_tile(Bh, Rt, m0, n0, fr, fq, z4); }
            if (m0 >= n0) a3 = mm_tile(Kt, Bh, m0, n0, fr, fq, z4);
#pragma unroll
            for (int r = 0; r < 4; ++r) { const int mi = m0 + 4 * fq + r, ni = n0 + fr;
                if (!(mi < ni)) { a1[r] = 0.f; a2[r] = 0.f; } if (!(mi <= ni)) { a4[r] = 0.f; a5[r] = 0.f; } if (!(ni < mi)) a3[r] = 0.f; }
            tstore(Akk, m0, n0, fr, fq, a1); tstore(Lm, m0, n0, fr, fq, a2); tstore(LT, m0, n0, fr, fq, a3); tstore(Ark, m0, n0, fr, fq, a4); tstore(Arb, m0, n0, fr, fq, a5);
        }
        __syncthreads();
        }
        REPS(2) {
            LAS bf16* Pw = CMAT(2); LAS bf16* PwT = CMAT(3); LAS bf16* Tm = CMAT(12);
#pragma unroll
            for (int tt = 0; tt < 2; ++tt) { const int m0 = tm0, n0 = tn0 + 16 * tt;
                const f32x4 p2 = mm_tile(Lm, LT, m0, n0, fr, fq, z4); tstore(PwT, m0, n0, fr, fq, p2); nstore(Pw, m0, n0, fr, fq, p2); }
            const u32x4 lw = *(const LAS u32x4*)(Lm + et * CP + ej); const unsigned lwa[4] = {lw.x, lw.y, lw.z, lw.w}; unsigned o[4];
#pragma unroll
            for (int i = 0; i < 4; ++i) { const float x0 = ((ej + 2 * i) == et ? 1.f : 0.f) - lo16(lwa[i]), x1 = ((ej + 2 * i + 1) == et ? 1.f : 0.f) - hi16(lwa[i]); o[i] = pk2(x0, x1); }
            *(LAS u32x4*)(Tm + et * CP + ej) = (u32x4){o[0], o[1], o[2], o[3]};
        __syncthreads();
        }
        REPS(3)
#pragma unroll 1
        for (int sidx = 0; sidx < 5; ++sidx) {
            LAS bf16* Pw = CMAT((sidx & 1) ? 8 : 2); LAS bf16* PwT = CMAT((sidx & 1) ? 9 : 3); LAS bf16* PwN = CMAT((sidx & 1) ? 2 : 8); LAS bf16* PwNT = CMAT((sidx & 1) ? 3 : 9);
            LAS bf16* Tm = CMAT(12 + (sidx & 1)); LAS bf16* TmN = CMAT(13 - (sidx & 1));
            const LAS bf16* fa = PwT + (tm0 + fr) * CP + 8 * fq; const LAS bf16* fb = Pw + (tm0 + fr) * CP + 8 * fq;
            const bf16x8 aT0 = *(const LAS bf16x8*)fa, aT1 = *(const LAS bf16x8*)(fa + 32), aP0 = *(const LAS bf16x8*)fb, aP1 = *(const LAS bf16x8*)(fb + 32);
            bf16x8 bT[2][2], bP[2][2]; u32x2 tw[2];
#pragma unroll
            for (int tt = 0; tt < 2; ++tt) { const int n0 = tn0 + 16 * tt;
                const LAS bf16* ft = Tm + (n0 + fr) * CP + 8 * fq; const LAS bf16* fp = PwT + (n0 + fr) * CP + 8 * fq;
                bT[tt][0] = *(const LAS bf16x8*)ft; bT[tt][1] = *(const LAS bf16x8*)(ft + 32); bP[tt][0] = *(const LAS bf16x8*)fp; bP[tt][1] = *(const LAS bf16x8*)(fp + 32);
                tw[tt] = *(const LAS u32x2*)(Tm + (n0 + fr) * CP + tm0 + 4 * fq); }
            f32x4 at[2], pt[2];
#pragma unroll
            for (int tt = 0; tt < 2; ++tt) {
                at[tt] = __builtin_amdgcn_mfma_f32_16x16x32_bf16(aT0, bT[tt][0], z4, 0, 0, 0); pt[tt] = __builtin_amdgcn_mfma_f32_16x16x32_bf16(aP0, bP[tt][0], z4, 0, 0, 0); }
#pragma unroll
            for (int tt = 0; tt < 2; ++tt) {
                at[tt] = __builtin_amdgcn_mfma_f32_16x16x32_bf16(aT1, bT[tt][1], at[tt], 0, 0, 0); pt[tt] = __builtin_amdgcn_mfma_f32_16x16x32_bf16(aP1, bP[tt][1], pt[tt], 0, 0, 0); }
#pragma unroll
            for (int tt = 0; tt < 2; ++tt) { const int m0 = tm0, n0 = tn0 + 16 * tt;
                at[tt][0] += lo16(tw[tt].x); at[tt][1] += hi16(tw[tt].x); at[tt][2] += lo16(tw[tt].y); at[tt][3] += hi16(tw[tt].y);
                tstore(TmN, m0, n0, fr, fq, at[tt]); tstore(PwNT, m0, n0, fr, fq, pt[tt]); nstore(PwN, m0, n0, fr, fq, pt[tt]);
            }
            __syncthreads();
        }
        LAS bf16* TmF = CMAT(13);
        LAS bf16* UT = CMAT(8); LAS bf16* SAT = CMAT(9);
        REPS(4) {
#pragma unroll
        for (int tt = 0; tt < 2; ++tt) { const int m0 = tm0, n0 = tn0 + 16 * tt;
            f32x4 a = mm_tile(Kt, S0c, m0, n0, fr, fq, z4); a = mm_tile(Akk, VT, m0, n0, fr, fq, a); tstore(UT, m0, n0, fr, fq, a); }
        __syncthreads();
        }
        REPS(5) {
#pragma unroll
        for (int tt = 0; tt < 2; ++tt) { const int m0 = tm0, n0 = tn0 + 16 * tt; tstore(SAT, m0, n0, fr, fq, mm_tile(TmF, UT, m0, n0, fr, fq, z4)); }
        __syncthreads();
        }
        REPS(6) {
#pragma unroll
        for (int tt = 0; tt < 2; ++tt) { const int m0 = tm0, n0 = tn0 + 16 * tt;
            f32x4 y = mm_tile(Rt, S0c, m0, n0, fr, fq, z4); y = mm_tile(Ark, VT, m0, n0, fr, fq, y); const f32x4 y2 = mm_tile(Arb, SAT, m0, n0, fr, fq, z4);
#pragma unroll
            for (int r = 0; r < 4; ++r) Ybuf[(m0 + 4 * fq + r) * 64 + n0 + fr] = y[r] - y2[r];
            f32x4 sn = mm_tile(KgT, VT, m0, n0, fr, fq, z4); const f32x4 s2 = mm_tile(BgT, SAT, m0, n0, fr, fq, z4);
            const f32x4 gc4 = *(const LAS f32x4*)(gCv + m0 + 4 * fq);
            sn = gc4 * Sreg[tt] + sn - s2; Sreg[tt] = sn;
        }
        __syncthreads();
#pragma unroll
        for (int tt = 0; tt < 2; ++tt) tstore(S0c, tm0, tn0 + 16 * tt, fr, fq, Sreg[tt]);
        }
        REPS(7) {
            const f32x4 ya = *(const LAS f32x4*)(Ybuf + et * 64 + ej), yb = *(const LAS f32x4*)(Ybuf + et * 64 + ej + 4);
            float y[8] = {ya.x, ya.y, ya.z, ya.w, yb.x, yb.y, yb.z, yb.w};
            float sm = 0.f;
#pragma unroll
            for (int i = 0; i < 8; ++i) sm += y[i];
            const float mean = red8(sm) * (1.f / 64.f); float sq = 0.f;
#pragma unroll
            for (int i = 0; i < 8; ++i) { y[i] -= mean; sq += y[i] * y[i]; }
            const float rs = 1.0f / sqrtf(red8(sq) * (1.f / 64.f) + 64e-5f);
            const float bon = bonv[et];
            const size_t mrow = mbase + 64 * c + et;
            const unsigned gwa[4] = {gw.x, gw.y, gw.z, gw.w};
            unsigned o[4];
#pragma unroll
            for (int i = 0; i < 4; ++i) {
                const float o0 = ((y[2 * i] * rs) * lwl[ej + 2 * i] + lbl[ej + 2 * i] + vv[2 * i] * bon) * lo16(gwa[i]), o1 = ((y[2 * i + 1] * rs) * lwl[ej + 2 * i + 1] + lbl[ej + 2 * i + 1] + vv[2 * i + 1] * bon) * hi16(gwa[i]);
                o[i] = pk2(o0, o1); }
            *(u32x4*)(YC + mrow * 1024 + h * 64 + ej) = (u32x4){o[0], o[1], o[2], o[3]};
        }
    }
    __syncthreads();
}

__device__ __forceinline__ unsigned sortable(float f) { const unsigned u = __float_as_uint(f); return (u & 0x80000000u) ? ~u : (u | 0x80000000u); }
#define MFMA32(a, b, c) __builtin_amdgcn_mfma_f32_32x32x16_bf16((a), (b), (c), 0, 0, 0)
__device__ __forceinline__ int wave_sum_i(int v) {
    v += __builtin_amdgcn_update_dpp(0, v, 0xB1, 0xF, 0xF, true);
    v += __builtin_amdgcn_update_dpp(0, v, 0x4E, 0xF, 0xF, true);
    v += __builtin_amdgcn_update_dpp(0, v, 0x141, 0xF, 0xF, true);
    v += __builtin_amdgcn_update_dpp(0, v, 0x140, 0xF, 0xF, true);
    v += __builtin_amdgcn_update_dpp(0, v, 0x142, 0xA, 0xF, true);
    v += __builtin_amdgcn_update_dpp(0, v, 0x143, 0xC, 0xF, true);
    return __builtin_amdgcn_readlane(v, 63);
}
__device__ __forceinline__ int wave_prefix_i(int v) {
    v += __builtin_amdgcn_update_dpp(0, v, 0x111, 0xF, 0xF, false);
    v += __builtin_amdgcn_update_dpp(0, v, 0x112, 0xF, 0xF, false);
    v += __builtin_amdgcn_update_dpp(0, v, 0x114, 0xF, 0xF, false);
    v += __builtin_amdgcn_update_dpp(0, v, 0x118, 0xF, 0xF, false);
    v += __builtin_amdgcn_update_dpp(0, v, 0x142, 0xA, 0xF, false);
    v += __builtin_amdgcn_update_dpp(0, v, 0x143, 0xC, 0xF, false);
    return v;
}
constexpr int HWORDS = 2368;
template <int NR>
__device__ __forceinline__ void radix_pass(const unsigned (&k)[NR], LAS unsigned* H, int lane, int shift, unsigned binmask, bool pred, int pshift, unsigned pval, int need, int& Bout, int& above_out, int& inbin_out) {
    const u32x4 z = (u32x4){0u, 0u, 0u, 0u};
#pragma unroll
    for (int q = 0; q < 9; ++q) ((LAS u32x4*)H)[lane + 64 * q] = z;
    asm volatile("" ::: "memory");
#pragma unroll
    for (int i = 0; i < NR; ++i) {
        const unsigned bin = (k[i] >> shift) & binmask; unsigned a = bin + 4u * (bin >> 5);
        if (pred) a = ((k[i] >> pshift) == pval) ? a : (2304u + (unsigned)lane);
        __hip_atomic_fetch_add(H + a, 1u, __ATOMIC_RELAXED, __HIP_MEMORY_SCOPE_WORKGROUP);
    }
    asm volatile("s_waitcnt lgkmcnt(0)" ::: "memory");
    const int blk = 63 - lane;
    int tot = 0;
#pragma unroll
    for (int q = 0; q < 8; ++q) { const u32x4 v = ((const LAS u32x4*)(H + 36 * blk))[q]; tot += (int)(v.x + v.y + v.z + v.w); }
    const int inc = wave_prefix_i(tot);
    const int A = inc - tot;
    const unsigned long long cross = __ballot(A < need && inc >= need);
    const int Ll = __builtin_ctzll(cross);
    const int Aab = __builtin_amdgcn_readlane(A, Ll);
    const int Bblk = 63 - Ll;
    const int h = (lane < 32) ? (int)H[36 * Bblk + 31 - lane] : 0;
    const int inc2 = wave_prefix_i(h);
    const int a2 = inc2 - h;
    const unsigned long long cross2 = __ballot(lane < 32 && (Aab + a2 < need) && (Aab + inc2 >= need));
    const int js = __builtin_ctzll(cross2);
    Bout = 32 * Bblk + 31 - js; above_out = Aab + __builtin_amdgcn_readlane(a2, js); inbin_out = __builtin_amdgcn_readlane(h, js);
}
template <int NR>
__device__ __forceinline__ void radix_pass1(const unsigned (&k)[NR], LAS unsigned* H, int lane, int need, int& Bout, int& above_out, int& inbin_out) {
    const u32x4 z = (u32x4){0u, 0u, 0u, 0u};
#pragma unroll
    for (int q = 0; q < 9; ++q) ((LAS u32x4*)H)[lane + 64 * q] = z;
    asm volatile("" ::: "memory");
#pragma unroll
    for (int i = 0; i < NR; ++i) { const unsigned vb = ((k[i] >> 24) << 3) | (unsigned)(lane & 7); __hip_atomic_fetch_add(H + vb + 4u * (vb >> 5), 1u, __ATOMIC_RELAXED, __HIP_MEMORY_SCOPE_WORKGROUP); }
    asm volatile("s_waitcnt lgkmcnt(0)" ::: "memory");
    const int blk = 63 - lane;
    int tot = 0;
#pragma unroll
    for (int q = 0; q < 8; ++q) { const u32x4 v = ((const LAS u32x4*)(H + 36 * blk))[q]; tot += (int)(v.x + v.y + v.z + v.w); }
    const int inc = wave_prefix_i(tot);
    const int A = inc - tot;
    const unsigned long long cross = __ballot(A < need && inc >= need);
    const int Ll = __builtin_ctzll(cross);
    const int Aab = __builtin_amdgcn_readlane(A, Ll);
    const int Bblk = 63 - Ll;
    int h = 0;
    if (lane < 4) { const LAS u32x4* hp = (const LAS u32x4*)(H + 36 * Bblk + 8 * (3 - lane)); const u32x4 v0 = hp[0], v1 = hp[1]; h = (int)(v0.x + v0.y + v0.z + v0.w + v1.x + v1.y + v1.z + v1.w); }
    const int inc2 = wave_prefix_i(h);
    const int a2 = inc2 - h;
    const unsigned long long cross2 = __ballot(lane < 4 && (Aab + a2 < need) && (Aab + inc2 >= need));
    const int js = __builtin_ctzll(cross2);
    Bout = 4 * Bblk + 3 - js; above_out = Aab + __builtin_amdgcn_readlane(a2, js); inbin_out = __builtin_amdgcn_readlane(h, js);
}
template <int NR>
__device__ __forceinline__ void dsa_select2(const LAS unsigned* SC, LAS unsigned* MK, LAS unsigned* HB, int sub, int wave, int lane, int nk, int pmode) {
    unsigned ka[NR], kb[NR];
    const int qa = 2 * wave, qb2 = 2 * wave + 1;
#pragma unroll
    for (int i = 0; i < NR; ++i) { const int idx = 64 * i + lane; const bool ok = idx < nk; ka[i] = ok ? SC[qa * 2048 + idx] : 0u; kb[i] = ok ? SC[qb2 * 2048 + idx] : 0u; }
    __syncthreads();
    LAS unsigned* H = HB + wave * HWORDS;
#pragma unroll
    for (int which = 0; which < 2; ++which) {
        const unsigned (&k)[NR] = which ? kb : ka;
        unsigned Tt = 0x80000000u; int need = 1;
        if (pmode != 23) {
            int B, ab, cb; unsigned prefix; bool fin = false;
            radix_pass1<NR>(k, H, lane, 256, B, ab, cb);
            need = 256 - ab; prefix = (unsigned)B;
            if (need == cb && prefix != 0u) { Tt = (prefix << 24) - 1u; need = 0; fin = true; }
            if (!fin) { radix_pass<NR>(k, H, lane, 13, 2047u, true, 24, prefix, need, B, ab, cb);
                need -= ab; prefix = (prefix << 11) | (unsigned)B;
                if (need == cb) { Tt = (prefix << 13) - 1u; need = 0; fin = true; } }
            if (!fin) { radix_pass<NR>(k, H, lane, 2, 2047u, true, 13, prefix, need, B, ab, cb);
                need -= ab; prefix = (prefix << 11) | (unsigned)B;
                if (need == cb) { Tt = (prefix << 2) - 1u; need = 0; fin = true; } }
            if (!fin) { radix_pass<NR>(k, H, lane, 0, 3u, true, 2, prefix, need, B, ab, cb);
                need -= ab; Tt = (prefix << 2) | (unsigned)B; }
        }
        if (pmode != 22) {
        LAS unsigned long long* mrow = (LAS unsigned long long*)(MK + (16 * sub + 2 * wave + which) * 64);
#pragma unroll
        for (int i = 0; i < NR; ++i) {
            const unsigned kvv = k[i];
            const unsigned long long gt = __ballot(kvv > Tt), eq = __ballot(kvv == Tt);
            const int ne = __builtin_popcountll(eq);
            unsigned long long take;
            if (ne <= need) { take = eq; need -= ne; }
            else { take = 0ull; unsigned long long e2 = eq; for (int z = 0; z < need; ++z) { const unsigned long long lb = e2 & (~e2 + 1ull); take |= lb; e2 ^= lb; } need = 0; }
            if (lane == 0) mrow[i] = gt | take;
        }
        if (lane >= NR && lane < 32) mrow[lane] = 0ull;
        }
    }
}
__device__ __forceinline__ void dsa_unit(LAS unsigned char* lds, int b, int qb, const unsigned char* ws, const float* at_out_g, int tid, int lane, int wave, int pmode) {
    const bf16* P = (const bf16*)(ws + WS_P); const bf16* VF = (const bf16*)(ws + WS_VF); const bf16* KF = (const bf16*)(ws + WS_KF); const bf16* KIF = (const bf16*)(ws + WS_KIF); bf16* YC = (bf16*)(ws + WS_H);
    asm volatile("" : "+v"(tid), "+v"(lane));
    const int t0 = qb * 32, nk = t0 + 32, nkt = nk >> 5;
    LAS unsigned* SC = (LAS unsigned*)lds;
    LAS unsigned* MK = (LAS unsigned*)(lds + MASK_OFF);
    const size_t rowbase = (size_t)b * SEQ;
    const int l32 = lane & 31, hi = lane >> 5;
    f32x16 zero16;
#pragma unroll
    for (int i = 0; i < 16; ++i) zero16[i] = 0.f;
    if (qb >= 8 && pmode != 4) {
        for (int sub = 0; sub < 2; ++sub) {
            if (pmode != 6) {
            bf16x8 aq[2][4]; float wq[2][4][4];
#pragma unroll
            for (int mt = 0; mt < 2; ++mt) {
#pragma unroll
                for (int s = 0; s < 4; ++s) aq[mt][s] = *(const bf16x8*)(P + (rowbase + t0 + 16 * sub + 8 * mt + (l32 & 7)) * NP + C_QI + (l32 >> 3) * 64 + 16 * s + 8 * hi);
#pragma unroll
                for (int j = 0; j < 4; ++j) { const u32x2 w = *(const u32x2*)(P + (rowbase + t0 + 16 * sub + 8 * mt + 4 * hi + j) * NP + C_WI);
                    wq[mt][j][0] = lo16(w.x) * 0.0625f; wq[mt][j][1] = hi16(w.x) * 0.0625f; wq[mt][j][2] = lo16(w.y) * 0.0625f; wq[mt][j][3] = hi16(w.y) * 0.0625f; }
            }
            bf16x8 bkA[4], bkB[4];
#define SC_LOAD(BK_, kt_) do { const int _kt = (kt_) < nkt ? (kt_) : nkt - 1; \
                _Pragma("unroll") for (int s = 0; s < 4; ++s) BK_[s] = *(const bf16x8*)(KIF + ((((size_t)b * 64 + _kt) * 4 + s) * 64 + lane) * 8); } while (0)
#define SC_STEP(BK_, kt_) do { const bool _ok = (kt_) < nkt; { \
                _Pragma("unroll") for (int mt = 0; mt < 2; ++mt) { \
                    f32x16 acc = zero16; \
                    _Pragma("unroll") for (int s = 0; s < 4; ++s) acc = MFMA32(aq[mt][s], BK_[s], acc); \
                    _Pragma("unroll") for (int j = 0; j < 4; ++j) { \
                        float sc = 0.f; \
                        _Pragma("unroll") for (int g = 0; g < 4; ++g) sc += wq[mt][j][g] * fmaxf(acc[4 * g + j], 0.f); \
                        const int ql = 8 * mt + 4 * hi + j, tq = t0 + 16 * sub + ql, key = 32 * (kt_) + l32; \
                        unsigned u = sortable(sc); if (key > tq) u = 0u; \
                        if (_ok) SC[ql * 2048 + key] = u; } } } } while (0)
            for (int _rp = 0; _rp < (pmode == 20 ? 5 : 1); ++_rp) {
            SC_LOAD(bkA, wave);
            for (int kt = wave; kt < nkt; kt += 16) {
                SC_LOAD(bkB, kt + 8); __builtin_amdgcn_sched_barrier(0); SC_STEP(bkA, kt);
                SC_LOAD(bkA, kt + 16); __builtin_amdgcn_sched_barrier(0); SC_STEP(bkB, kt + 8);
            }
            }
#undef SC_LOAD
#undef SC_STEP
            }
            __syncthreads();
            if (pmode != 5) { const int nr8 = (nk + 511) >> 9;
              if (nr8 == 1) dsa_select2<8>(SC, MK, SC, sub, wave, lane, nk, pmode); else if (nr8 == 2) dsa_select2<16>(SC, MK, SC, sub, wave, lane, nk, pmode);
              else if (nr8 == 3) dsa_select2<24>(SC, MK, SC, sub, wave, lane, nk, pmode); else dsa_select2<32>(SC, MK, SC, sub, wave, lane, nk, pmode); }
            __syncthreads();
        }
    } else {
        for (int idx = tid; idx < 32 * 64; idx += 512) { const int qq = idx >> 6, w = idx & 63, tq = t0 + qq, lo = 32 * w;
            const unsigned m = (lo + 31 <= tq) ? 0xffffffffu : (lo > tq ? 0u : ((1u << (tq - lo + 1)) - 1u)); MK[idx] = m; }
        __syncthreads();
    }
    if (pmode != 3 && pmode != 5 && pmode != 6 && pmode < 20) {
        const int hd = wave;
        bf16x8 qf[4];
#pragma unroll
        for (int s = 0; s < 4; ++s) qf[s] = *(const bf16x8*)(P + (rowbase + t0 + l32) * NP + C_Q + 64 * hd + 16 * s + 8 * hi);
        f32x16 o0 = zero16, o1 = zero16; float lrun = 0.f;
        const bf16* Kb = KF + ((size_t)(b * 8 + hd) * 64) * 4 * 64 * 8 + (size_t)lane * 8;
        const bf16* Vb = VF + ((size_t)(b * 8 + hd) * 64) * 4 * 64 * 8 + (size_t)lane * 8;
        bf16x8 kf0[4], kf1[4], vf0[2][2], vf1[2][2];
#define ATT_LOAD(KF_, VF_, kt_) do { const int _kt = (kt_) < nkt ? (kt_) : nkt - 1; \
            _Pragma("unroll") for (int s = 0; s < 4; ++s) KF_[s] = *(const bf16x8*)(Kb + ((size_t)_kt * 4 + s) * 512); \
            _Pragma("unroll") for (int dt = 0; dt < 2; ++dt) _Pragma("unroll") for (int s2 = 0; s2 < 2; ++s2) VF_[dt][s2] = *(const bf16x8*)(Vb + (((size_t)_kt * 2 + dt) * 2 + s2) * 512); } while (0)
#define ATT_STEP(KF_, VF_, kt_) do { \
            f32x16 sacc = zero16; \
            _Pragma("unroll") for (int s = 0; s < 4; ++s) sacc = MFMA32(KF_[s], qf[s], sacc); \
            const int _kc = (kt_) < nkt ? (kt_) : nkt - 1; \
            unsigned mw = MK[l32 * 64 + _kc] >> (4 * hi); mw = ((kt_) < nkt) ? mw : 0u;     \
            float pv[16]; \
            _Pragma("unroll") for (int r = 0; r < 16; ++r) { const int sb = ((int)(mw << (31 - (8 * (r >> 2) + (r & 3))))) >> 31; \
                pv[r] = __int_as_float(__float_as_int(__builtin_amdgcn_exp2f(sacc[r])) & sb); lrun += pv[r]; } \
            bf16x8 pf[2]; \
            _Pragma("unroll") for (int s2 = 0; s2 < 2; ++s2) { u32x4 t; t.x = pk2(pv[8 * s2], pv[8 * s2 + 1]); t.y = pk2(pv[8 * s2 + 2], pv[8 * s2 + 3]); t.z = pk2(pv[8 * s2 + 4], pv[8 * s2 + 5]); t.w = pk2(pv[8 * s2 + 6], pv[8 * s2 + 7]); pf[s2] = __builtin_bit_cast(bf16x8, t); } \
            _Pragma("unroll") for (int s2 = 0; s2 < 2; ++s2) { o0 = MFMA32(VF_[0][s2], pf[s2], o0); o1 = MFMA32(VF_[1][s2], pf[s2], o1); } } while (0)
        ATT_LOAD(kf0, vf0, 0);
        for (int kt = 0; kt < nkt; kt += 2) {
            ATT_LOAD(kf1, vf1, kt + 1); __builtin_amdgcn_sched_barrier(0); ATT_STEP(kf0, vf0, kt);
            ATT_LOAD(kf0, vf0, kt + 2); __builtin_amdgcn_sched_barrier(0); ATT_STEP(kf1, vf1, kt + 1);
        }
#undef ATT_LOAD
#undef ATT_STEP
        lrun += __shfl_xor(lrun, 32);
        const float inv = 1.0f / lrun;
        float ss = 0.f;
#pragma unroll
        for (int r = 0; r < 16; ++r) { o0[r] *= inv; o1[r] *= inv; ss += o0[r] * o0[r] + o1[r] * o1[r]; }
        ss += __shfl_xor(ss, 32);
        const float rs = 1.0f / sqrtf(ss * (1.f / 64.f) + 1e-6f);
        bf16* orow = YC + (rowbase + t0 + l32) * 1024 + 512 + 64 * hd;
        f32x4 ogv[2][4];
#pragma unroll
        for (int dt = 0; dt < 2; ++dt)
#pragma unroll
            for (int g = 0; g < 4; ++g) ogv[dt][g] = *(const f32x4*)(at_out_g + hd * 64 + 32 * dt + 8 * g + 4 * hi);
#pragma unroll
        for (int dt = 0; dt < 2; ++dt)
#pragma unroll
            for (int g = 0; g < 4; ++g) { const int d = 32 * dt + 8 * g + 4 * hi; const f32x4 og = ogv[dt][g];
                float v0, v1, v2, v3;
                if (dt == 0) { v0 = o0[4 * g]; v1 = o0[4 * g + 1]; v2 = o0[4 * g + 2]; v3 = o0[4 * g + 3]; } else { v0 = o1[4 * g]; v1 = o1[4 * g + 1]; v2 = o1[4 * g + 2]; v3 = o1[4 * g + 3]; }
                u32x2 w; w.x = pk2(v0 * rs * og.x, v1 * rs * og.y); w.y = pk2(v2 * rs * og.z, v3 * rs * og.w);
                *(u32x2*)(orow + d) = w; }
    }
    __syncthreads();
}

__device__ __forceinline__ void moe_tables(LAS int* tab, const unsigned* ctl, int tid) {
    LAS int* cnt = tab; LAS int* cum = tab + 260; LAS int* tcum = tab + 520;
    if (tid < 64) {
        int c[4], tl[4]; int sc = 0, stl = 0;
#pragma unroll
        for (int i = 0; i < 4; ++i) { c[i] = (int)__hip_atomic_load(ctl + CW_CNT + 4 * tid + i, __ATOMIC_RELAXED, __HIP_MEMORY_SCOPE_AGENT); tl[i] = (c[i] + 255) >> 8; sc += c[i]; stl += tl[i]; }
        int ic = sc, it = stl;
#pragma unroll
        for (int o = 1; o < 64; o <<= 1) { const int a = __shfl_up(ic, o), bq = __shfl_up(it, o); if (tid >= o) { ic += a; it += bq; } }
        int ec = ic - sc, et = it - stl;
#pragma unroll
        for (int i = 0; i < 4; ++i) { cnt[4 * tid + i] = c[i]; cum[4 * tid + i] = ec; tcum[4 * tid + i] = et; ec += c[i]; et += tl[i]; }
        if (tid == 63) { cnt[256] = T; cum[256] = T * 8; tcum[256] = et; tcum[257] = et + T / 256; cum[257] = T * 8 + T; }
    }
    __syncthreads();
    LAS unsigned short* t2e = (LAS unsigned short*)(tab + 800);
    if (tid <= 256) { const int t0 = tcum[tid], t1 = tcum[tid + 1]; for (int j = t0; j < t1; ++j) t2e[j] = (unsigned short)tid; }
    __syncthreads();
}
__device__ __forceinline__ int find_expert(const LAS int* tcum, int tile) {
    return (int)((const LAS unsigned short*)(tcum - 520 + 800))[tile];
}
struct LdsGather {
    static constexpr bool GATHER = true;
    const LAS unsigned* tabl;
    __device__ __forceinline__ unsigned rowoff(int ui, int r) const { return tabl[ui * 256 + r]; }
};
struct Fc1Order {
    const LAS int* tab; int total, G, c;
    __device__ bool next(int i, pg8::Unit& u) const {
        const long L = (long)i * G + c; if (L >= total) return false;
        const int tile = (int)(L >> 1), pn = (int)(L & 1);
        const LAS int* cnt = tab; const LAS int* cum = tab + 260; const LAS int* tcum = tab + 520;
        const int e = __builtin_amdgcn_readfirstlane(find_expert(tcum, tile)), j = tile - __builtin_amdgcn_readfirstlane(tcum[e]);
        u.arow = 0; u.brow = e * 512 + 256 * pn; u.orow = __builtin_amdgcn_readfirstlane(cum[e]) + 256 * j; u.ocol = 128 * pn; const int rem = __builtin_amdgcn_readfirstlane(cnt[e]) - 256 * j; u.nvalid = rem < 256 ? rem : 256; u.aux = 0; return true;
    }
};
struct Fc2Order {
    const LAS int* tab; int total, G, c;
    __device__ bool next(int i, pg8::Unit& u) const {
        const long L = (long)i * G + c; if (L >= total) return false;
        const int tile = (int)(L >> 2), pn = (int)(L & 3);
        const LAS int* cnt = tab; const LAS int* cum = tab + 260; const LAS int* tcum = tab + 520;
        const int e = __builtin_amdgcn_readfirstlane(find_expert(tcum, tile)), j = tile - __builtin_amdgcn_readfirstlane(tcum[e]);
        u.arow = __builtin_amdgcn_readfirstlane(cum[e]) + 256 * j; u.brow = e * 1024 + 256 * pn; u.orow = u.arow; u.ocol = 256 * pn; const int rem = __builtin_amdgcn_readfirstlane(cnt[e]) - 256 * j; u.nvalid = rem < 256 ? rem : 256; u.aux = 0; return true;
    }
};

constexpr int NPHASE = 14;
__global__ void __launch_bounds__(512, 2) fwd_kernel(Args args) {
    extern __shared__ __attribute__((aligned(16))) unsigned char lds_raw[];
    LAS unsigned char* lds = (LAS unsigned char*)lds_raw;
    volatile LAS unsigned* MISC = (volatile LAS unsigned*)(lds + MISC_OFF);
    const int tid = threadIdx.x, lane = tid & 63, wave = __builtin_amdgcn_readfirstlane(tid >> 6);
    const int G = gridDim.x; const int bx = blockIdx.x; const int vcu = (G % 8 == 0) ? (bx % 8) * (G / 8) + bx / 8 : bx;
    unsigned char* ws = args.ws;
    unsigned* ctl = (unsigned*)(ws + WS_CTL);
    if (tid < 64) MISC[tid] = 0u;
    __syncthreads();
    XcdBarrier bar; bar.bar = ctl + CW_BAR; bar.x = 0; bar.st = nullptr;
    if (!MK_PER_PHASE) bar = xcd_barrier_post(ctl + CW_BAR, MISC + 8);
    const int lo = args.ph_lo, hi = args.ph_hi;
#ifdef PROBE_SUB
#define PMODE (args.probe ? PROBE_SUB : 0)
#else
#define PMODE 0
#endif
#ifndef PHASE_MASK
#define PHASE_MASK 0xffffffffu
#endif
#define IN(k) (((PHASE_MASK >> (k)) & 1u) && lo <= (k) && (k) < hi)
#ifndef REPEAT_MASK
#define REPEAT_MASK 0u
#endif
#define NREP(k) (1 + (int)((REPEAT_MASK >> (k)) & 1u))
#define SEAM(k) do { if (IN(k) && IN((k) + 1)) xcd_barrier(bar); } while (0)
    const float* x = args.in[0];
    float* mod = (float*)(ws + WS_MOD);
    const int gw = vcu * 8 + wave, NGW = G * 8;
    const bool conv_split = (G == 256); const int conv_base = conv_split ? 64 : 0;

    if (IN(0)) for (int rep = 0; rep < NREP(0); ++rep) {
        __syncthreads();
        if (vcu < 192) {
            LAS float* cact = (LAS float*)lds;
            const float* c = args.in[1];
            { float cv[32];
#pragma unroll
              for (int j = 0; j < 32; ++j) cv[j] = c[tid + 512 * j];
              __builtin_amdgcn_sched_barrier(0);
#pragma unroll
              for (int j = 0; j < 32; ++j) { const int i = tid + 512 * j, b = i >> 10, k = i & 1023; cact[k * 16 + b] = cv[j] / (1.0f + __expf(-cv[j])); } }
            __syncthreads();
            const float* w_ada = args.in[3]; const float* b_ada = args.in[4];
            const int j0 = vcu * 32, col = lane & 31, kh = lane >> 5;
            float acc[16];
#pragma unroll
            for (int b = 0; b < 16; ++b) acc[b] = 0.f;
#pragma unroll 8
            for (int kk = 0; kk < 64; ++kk) { const int k = 128 * wave + 2 * kk + kh; const float wv = w_ada[(size_t)k * 6144 + j0 + col];
                const LAS f32x4* cp = (const LAS f32x4*)(cact + k * 16);
#pragma unroll
                for (int q4 = 0; q4 < 4; ++q4) { const f32x4 cv = cp[q4]; acc[4 * q4] += cv.x * wv; acc[4 * q4 + 1] += cv.y * wv; acc[4 * q4 + 2] += cv.z * wv; acc[4 * q4 + 3] += cv.w * wv; } }
            LAS float* part = (LAS float*)(lds + 65536);
#pragma unroll
            for (int b = 0; b < 16; ++b) { const float v = acc[b] + __shfl_xor(acc[b], 32); if (lane < 32) part[(wave * 16 + b) * 32 + col] = v; }
            __syncthreads();
            { const int b = tid >> 5, cc = tid & 31; float s = b_ada[j0 + cc];
#pragma unroll
              for (int w = 0; w < 8; ++w) s += part[(w * 16 + b) * 32 + cc];
              mod[(size_t)b * 6144 + j0 + cc] = s; }
            __syncthreads();
        }
        {
            bf16* WLT = (bf16*)(ws + WS_WLT); const float* w2 = args.in[10]; const float* a2 = args.in[12]; const float* g2 = args.in[13];
            for (int idx = vcu * 512 + tid; idx < 1536 * 256; idx += G * 512) { const int n = idx >> 8, k = idx & 255, br = n >> 9, c = n & 511; float v = 0.f;
                if (br == 0) { if (k < 64) v = w2[k * 512 + c]; } else if (br == 1) { if (k >= 64 && k < 128) v = a2[(k - 64) * 512 + c]; } else { if (k >= 128) v = g2[(k - 128) * 512 + c]; }
                WLT[idx] = (bf16)f2bf(v); }
        }
        LAS float* scr = (LAS float*)(lds + wave * 16640);
        constexpr int I_IN = 16 * 60, I_OUT = 16 * 16, I_R = 16 * 4, I_SMALL = I_IN + I_OUT + I_R, I_E = 192, NITEMS = I_SMALL + 257 * I_E;
#ifndef CONV_IN_P5
#define CONV_IN_P5 1
#endif
        const bool p0_split = CONV_IN_P5 && G == 256;
        for (int it = p0_split ? ((vcu >= 192) ? (vcu - 192) * 8 + wave : NITEMS) : gw; it < (CONV_IN_P5 ? I_SMALL : NITEMS); it += p0_split ? 512 : NGW) {
            int r = it;
            if (r < I_IN) { const int kb = r / 60, nb = r % 60; p0_transpose_item(args.in[7], 1024, IN_COLS, (bf16*)(ws + WS_WINT), 64 * nb, 64 * kb, 64 * nb, scr, lane); continue; } r -= I_IN;
            if (r < I_OUT) { const int kb = r / 16, nb = r % 16; p0_transpose_item(args.in[24], 1024, 1024, (bf16*)(ws + WS_WOUTT), 64 * nb, 64 * kb, 64 * nb, scr, lane); continue; } r -= I_OUT;
            if (r < I_R) { const int kb = r / 4, nb = r % 4; p0_transpose_item(args.in[25], 1024, 256, (bf16*)(ws + WS_WRT), 64 * nb, 64 * kb, 64 * nb, scr, lane); continue; } r -= I_R;
            p0_expert_item(args, ws, r / I_E, r % I_E, scr, lane);
        }
    }
    SEAM(0);
    if (IN(1)) for (int rep = 0; rep < NREP(1); ++rep) {
        bf16* H = (bf16*)(ws + WS_H);
        for (int m = gw * 16; m < T; m += NGW * 16) { const int b = m / SEQ; const float* mb = mod + (size_t)b * 6144; norm_mod_rows16(x + (size_t)m * DM, args.in[5], mb, mb + 1024, H + (size_t)m * DM, lane); }
    }
    SEAM(1);
    if (IN(2)) for (int rep = 0; rep < NREP(2); ++rep) {
        pg8::Gemm g{(const bf16*)(ws + WS_H), (const bf16*)(ws + WS_WINT), 1024}; pg8::StaticOrder S; S.init(T, NP, G, bx);
        pg8::EpiBf16 E{(bf16*)(ws + WS_P), NP, 0};
        pg8::gemm_phase<pg8::EpiBf16, pg8::StaticOrder, true, true, pg8::NoGather>(lds, g, S, E, pg8::NoGather{});
        if (conv_split && bx >= 128) {
            __syncthreads();
            const int un = bx - 128; int ln = lane; asm volatile("" : "+v"(ln));
            p0_expert_wave(args, ws, un / 6, 32 * (un % 6), 32 * (un % 6) + 32, wave, (LAS float*)(lds + wave * 16640), ln);
        }
    }
    SEAM(2);
    if (IN(3)) for (int rep = 0; rep < NREP(3); ++rep) {
        bf16* P = (bf16*)(ws + WS_P);
        bf16* XR = (bf16*)(ws + WS_XR); bf16* XK = (bf16*)(ws + WS_XK); bf16* XV = (bf16*)(ws + WS_XV); bf16* KKN = (bf16*)(ws + WS_KKN); bf16* LORA = (bf16*)(ws + WS_LORA); bf16* VF = (bf16*)(ws + WS_VF); bf16* KF = (bf16*)(ws + WS_KF); bf16* KIF = (bf16*)(ws + WS_KIF);
        const float* mu = args.in[8]; const float* k_k = args.in[14]; const int* positions = (const int*)args.in[2];
        const float* qg = args.in[19]; const float* kg = args.in[20]; const float* ilw = args.in[21]; const float* ilb = args.in[22];
        LAS bf16* vbuf = (LAS bf16*)lds;
        float mu0[8], mu1[8], mu2[8], mu3[8], kkc[8], g1[8], g2[8], frq[8];
        const int ri = lane & 3;
#pragma unroll
        for (int i = 0; i < 8; ++i) { mu0[i] = mu[8 * lane + i]; mu1[i] = mu[512 + 8 * lane + i]; mu2[i] = mu[1024 + 8 * lane + i]; mu3[i] = (lane < 32) ? mu[1536 + 8 * lane + i] : 0.f;
            kkc[i] = k_k[8 * lane + i]; const float* gsrc = (lane < 32) ? qg : kg; g1[i] = gsrc[8 * ri + i]; g2[i] = gsrc[32 + 8 * ri + i];
            frq[i] = exp2f(-(float)(8 * ri + i) * (13.287712379549449f / 32.0f)) * 0.15915494309189535f; }
        struct Tok { u32x4 c0, c1, c2, c3, p0, p1, p2, p3, qa, qb, va, ia, ib; float pos; };
        auto load_tok = [&](size_t m, Tok& t) {
            const bf16* prow = P + m * NP; const bool has_prev = (m % SEQ) != 0; const bf16* pp = has_prev ? prow - NP : prow;
            t.c0 = *(const u32x4*)(prow + 8 * lane); t.c1 = *(const u32x4*)(prow + 512 + 8 * lane); t.c2 = *(const u32x4*)(prow + 1024 + 8 * lane);
            t.p0 = *(const u32x4*)(pp + 8 * lane); t.p1 = *(const u32x4*)(pp + 512 + 8 * lane); t.p2 = *(const u32x4*)(pp + 1024 + 8 * lane);
            if (lane < 32) { t.c3 = *(const u32x4*)(prow + 1536 + 8 * lane); t.p3 = *(const u32x4*)(pp + 1536 + 8 * lane); } else { t.c3 = (u32x4){0u, 0u, 0u, 0u}; t.p3 = t.c3; }
            if (!has_prev) { const u32x4 z = (u32x4){0u, 0u, 0u, 0u}; t.p0 = z; t.p1 = z; t.p2 = z; t.p3 = z; }
            const int qkb = ((lane < 32) ? C_Q : C_K) + 64 * ((lane & 31) >> 2) + 8 * ri;
            t.qa = *(const u32x4*)(prow + qkb); t.qb = *(const u32x4*)(prow + qkb + 32);
            t.va = *(const u32x4*)(prow + C_V + 8 * lane);
            const int ib0 = (lane < 16) ? (C_QI + 64 * (lane >> 2) + 8 * ri) : (C_KI + 8 * ri);
            if (lane < 20) { t.ia = *(const u32x4*)(prow + ib0); t.ib = *(const u32x4*)(prow + ib0 + 32); } else { t.ia = (u32x4){0u, 0u, 0u, 0u}; t.ib = t.ia; }
            t.pos = (float)positions[m];
        };
        auto unpack8 = [&](const u32x4& w, float (&o)[8]) { o[0] = lo16(w.x); o[1] = hi16(w.x); o[2] = lo16(w.y); o[3] = hi16(w.y); o[4] = lo16(w.z); o[5] = hi16(w.z); o[6] = lo16(w.w); o[7] = hi16(w.w); };
        auto pack8 = [&](const float (&o)[8]) { return (u32x4){pk2(o[0], o[1]), pk2(o[2], o[3]), pk2(o[4], o[5]), pk2(o[6], o[7])}; };
        auto proc_tok = [&](size_t m, int tl, const Tok& t) {
            bf16* prow = P + m * NP; const int sq = (int)(m % SEQ), bb = (int)(m / SEQ);
            float c[8], p[8], x[8];
            unpack8(t.c0, c); unpack8(t.p0, p);
#pragma unroll
            for (int i = 0; i < 8; ++i) x[i] = c[i] + (p[i] - c[i]) * mu0[i];
            *(u32x4*)(XR + m * 512 + 8 * lane) = pack8(x);
            unpack8(t.c1, c); unpack8(t.p1, p);
#pragma unroll
            for (int i = 0; i < 8; ++i) x[i] = c[i] + (p[i] - c[i]) * mu1[i];
            *(u32x4*)(XK + m * 512 + 8 * lane) = pack8(x);
            unpack8(t.c2, c); unpack8(t.p2, p);
#pragma unroll
            for (int i = 0; i < 8; ++i) x[i] = c[i] + (p[i] - c[i]) * mu2[i];
            *(u32x4*)(XV + m * 512 + 8 * lane) = pack8(x);
            if (lane < 32) {
                unpack8(t.c3, c); unpack8(t.p3, p);
#pragma unroll
                for (int i = 0; i < 8; ++i) { const float ps = c[i] + (p[i] - c[i]) * mu3[i]; x[i] = (lane < 8) ? tanhf(ps) : ((lane < 16) ? ps : sigmoidf_(ps)); }
                *(u32x4*)(LORA + m * 256 + 8 * lane) = pack8(x);
            }
            float cs[8], sn[8];
#pragma unroll
            for (int i = 0; i < 8; ++i) { float rev = t.pos * frq[i]; rev -= rintf(rev); sn[i] = __builtin_amdgcn_sinf(rev); cs[i] = __builtin_amdgcn_cosf(rev); }
            {
                float x1[8], x2[8]; unpack8(t.qa, x1); unpack8(t.qb, x2);
                float ssq = 0.f;
#pragma unroll
                for (int i = 0; i < 8; ++i) ssq += x1[i] * x1[i] + x2[i] * x2[i];
                ssq += __shfl_xor(ssq, 1); ssq += __shfl_xor(ssq, 2);
                float rstd = 1.0f / sqrtf(ssq * (1.f / 64.f) + 1e-6f); if (lane < 32) rstd *= 0.125f * 1.4426950408889634f;
                float y1[8], y2[8];
#pragma unroll
                for (int i = 0; i < 8; ++i) { const float a = x1[i] * rstd * g1[i], bq = x2[i] * rstd * g2[i]; y1[i] = a * cs[i] - bq * sn[i]; y2[i] = bq * cs[i] + a * sn[i]; }
                const u32x4 o1 = pack8(y1), o2 = pack8(y2);
                if (lane < 32) { const int qkb = C_Q + 64 * (lane >> 2) + 8 * ri; *(u32x4*)(prow + qkb) = o1; *(u32x4*)(prow + qkb + 32) = o2; }
                else {
                    bf16* kfb = KF + (((size_t)(bb * 8 + ((lane - 32) >> 2)) * 64 + (sq >> 5)) * 4) * 512 + (sq & 31) * 8;
                    *(u32x4*)(kfb + ((ri >> 1) * 64 + (ri & 1) * 32) * 8) = o1;
                    *(u32x4*)(kfb + ((2 + (ri >> 1)) * 64 + (ri & 1) * 32) * 8) = o2;
                }
            }
            *(LAS u32x4*)(vbuf + tl * 512 + 8 * lane) = t.va;
            if (lane < 20) {
                float x1[8], x2[8]; unpack8(t.ia, x1); unpack8(t.ib, x2);
                float sm = 0.f;
#pragma unroll
                for (int i = 0; i < 8; ++i) sm += x1[i] + x2[i];
                sm += __shfl_xor(sm, 1); sm += __shfl_xor(sm, 2);
                const bool iski = lane >= 16;
                const float mean = iski ? sm * (1.f / 64.f) : 0.f; float vq = 0.f;
#pragma unroll
                for (int i = 0; i < 8; ++i) { x1[i] -= mean; x2[i] -= mean; vq += x1[i] * x1[i] + x2[i] * x2[i]; }
                vq += __shfl_xor(vq, 1); vq += __shfl_xor(vq, 2);
                const float rstd = iski ? 1.0f / sqrtf(vq * (1.f / 64.f) + 1e-6f) : 1.0f;
                float y1[8], y2[8];
#pragma unroll
                for (int i = 0; i < 8; ++i) { float a = x1[i] * rstd, bq = x2[i] * rstd;
                    if (iski) { a = a * ilw[8 * ri + i] + ilb[8 * ri + i]; bq = bq * ilw[32 + 8 * ri + i] + ilb[32 + 8 * ri + i]; }
                    y1[i] = a * cs[i] - bq * sn[i]; y2[i] = bq * cs[i] + a * sn[i]; }
                const u32x4 o1 = pack8(y1), o2 = pack8(y2);
                if (!iski) { const int ib0 = C_QI + 64 * (lane >> 2) + 8 * ri; *(u32x4*)(prow + ib0) = o1; *(u32x4*)(prow + ib0 + 32) = o2; }
                else {
                    bf16* kfb = KIF + (((size_t)bb * 64 + (sq >> 5)) * 4) * 512 + (sq & 31) * 8;
                    *(u32x4*)(kfb + ((ri >> 1) * 64 + (ri & 1) * 32) * 8) = o1;
                    *(u32x4*)(kfb + ((2 + (ri >> 1)) * 64 + (ri & 1) * 32) * 8) = o2;
                }
            }
        };
        for (int tile = vcu; tile < T / 64; tile += G) {
#pragma unroll 1
            for (int i = 0; i < 8; i += 2) {
                const int tl = wave * 8 + i; const size_t m = (size_t)tile * 64 + tl;
                Tok ta, tb; load_tok(m, ta); load_tok(m + 1, tb);
                proc_tok(m, tl, ta); proc_tok(m + 1, tl + 1, tb);
            }
            __syncthreads();
            {
                const size_t m0 = (size_t)tile * 64; const int b = (int)(m0 / SEQ), s0 = (int)(m0 % SEQ);
                const int h = tid >> 6, d = tid & 63, dt = d >> 5, dl = d & 31;
#pragma unroll
                for (int ktl = 0; ktl < 2; ++ktl)
#pragma unroll
                    for (int s2 = 0; s2 < 2; ++s2)
#pragma unroll
                        for (int hh = 0; hh < 2; ++hh) {
                            const int tb = 32 * ktl + 16 * s2 + 4 * hh; unsigned e[8];
#pragma unroll
                            for (int i = 0; i < 4; ++i) { e[i] = vbuf[(tb + i) * 512 + tid]; e[4 + i] = vbuf[(tb + 8 + i) * 512 + tid]; }
                            u32x4 w; w.x = e[0] | (e[1] << 16); w.y = e[2] | (e[3] << 16); w.z = e[4] | (e[5] << 16); w.w = e[6] | (e[7] << 16);
                            *(u32x4*)(VF + ((((((size_t)(b * 8 + h) * 64 + (s0 >> 5) + ktl) * 2 + dt) * 2 + s2) * 64) + hh * 32 + dl) * 8) = w;
                        }
            }
            __syncthreads();
        }
    }
    SEAM(3);
    if (IN(4)) for (int rep = 0; rep < NREP(4); ++rep) {
        pg8::Gemm g{(const bf16*)(ws + WS_LORA), (const bf16*)(ws + WS_WLT), 256}; pg8::StaticOrder S; S.init(T, 1536, G, bx);
        pg8::EpiLora E{args.in[9], args.in[11], args.in[15], (bf16*)(ws + WS_EE), (bf16*)(ws + WS_XK), (const bf16*)(ws + WS_KKN), (bf16*)(ws + WS_BV), (bf16*)(ws + WS_GG)};
        pg8::gemm_phase<pg8::EpiLora, pg8::StaticOrder, true, true, pg8::NoGather>(lds, g, S, E, pg8::NoGather{});
    }
    SEAM(4);
    if (IN(5)) for (int rep = 0; rep < NREP(5); ++rep) {
        const int myx = (int)(xb_xcc_id() & 7u);
        for (int d = 0; d < 8; ++d) {
            const int qx = (myx + d) & 7;
            for (;;) {
                if (tid == 0) MISC[0] = atomicAdd(ctl + CW_QUEUE + 256 * (rep + 2 * args.probe) + 16 * qx, 1u);
                __syncthreads();
                int item = (int)MISC[0];
                __syncthreads();
#ifdef PROBE_SUB
                if (args.probe) { if (PROBE_SUB == 1 || (PROBE_SUB >= 10 && PROBE_SUB < 20)) { if (item >= 16) break; } else item += 16; }
#endif
#if CONV_IN_P5
                if (item >= 16 + 165) break;
                if (item >= 16) {
                    const int sl = item - 16, c5 = sl / 5;
                    if (sl - 5 * c5 == 4) {
                        const int e = conv_base + qx + 8 * c5;
                        if (e < 257) { int ln = lane; asm volatile("" : "+v"(ln)); p0_expert_wave(args, ws, e, 0, 192, wave, (LAS float*)(lds + wave * 16640), ln); }
                        continue;
                    }
                    item = 16 + sl - c5;
                    if (item >= 16 + 128) continue;
                }
#else
                if (item >= 16 + 128) break;
#endif
#ifndef NO_SCAN
                if (item < 16) scan_job(lds, 16 * qx + item, ws, args.in[16], args.in[17], args.in[18], args.in[14], args.in[15], tid, lane, wave, PMODE);
#endif
#ifndef NO_DSA
                if (item >= 16) { const int u = item - 16; dsa_unit(lds, 2 * qx + (u >> 6), 63 - (u & 63), ws, args.in[23], tid, lane, wave, PMODE); }
#endif
            }
        }
    }
    SEAM(5);
    if (IN(6)) for (int rep = 0; rep < NREP(6); ++rep) {
        pg8::Gemm g{(const bf16*)(ws + WS_H), (const bf16*)(ws + WS_WOUTT), 1024}; pg8::StaticOrder S; S.init(T, 1024, G, bx);
        pg8::EpiResid E{x, (bf16*)(ws + WS_X1B), mod, 2048};
        pg8::gemm_phase<pg8::EpiResid, pg8::StaticOrder, true, true, pg8::NoGather>(lds, g, S, E, pg8::NoGather{});
    }
    SEAM(6);
    if (IN(7)) for (int rep = 0; rep < NREP(7); ++rep) {
        bf16* H = (bf16*)(ws + WS_H);
        for (int m = gw * 16; m < T; m += NGW * 16) { const int b = m / SEQ; const float* mb = mod + (size_t)b * 6144; norm_mod_rows16_bf((const bf16*)(ws + WS_X1B) + (size_t)m * DM, args.in[6], mb + 3072, mb + 4096, H + (size_t)m * DM, lane); }
    }
    SEAM(7);
    if (IN(8)) for (int rep = 0; rep < NREP(8); ++rep) {
        pg8::Gemm g{(const bf16*)(ws + WS_H), (const bf16*)(ws + WS_WRT), 1024}; pg8::StaticOrder S; S.init(T, 256, G, bx);
        pg8::EpiF32 E{(float*)(ws + WS_LOGIT), 256};
        pg8::gemm_phase<pg8::EpiF32, pg8::StaticOrder, true, true, pg8::NoGather>(lds, g, S, E, pg8::NoGather{});
        if (conv_split && bx >= 128) {
            __syncthreads();
            int ln = lane; asm volatile("" : "+v"(ln));
#pragma unroll 1
            for (int j = 0; j < 2; ++j) { const int un = 128 + 2 * (bx - 128) + j; p0_expert_wave(args, ws, un / 6, 32 * (un % 6), 32 * (un % 6) + 32, wave, (LAS float*)(lds + wave * 16640), ln); }
        }
    }
    SEAM(8);
    if (IN(9)) for (int rep = 0; rep < NREP(9); ++rep) {
        const float* LG = (const float*)(ws + WS_LOGIT); const float* rbias = args.in[26];
        unsigned* SEL = (unsigned*)(ws + WS_SEL); float* GWt = (float*)(ws + WS_GW); int* HG = (int*)(ws + WS_HG);
        LAS int* hist = (LAS int*)lds;
        if (tid < 256) hist[tid] = 0;
        __syncthreads();
        const f32x4 bv = *(const f32x4*)(rbias + 4 * lane);
        constexpr int NT = 4;
        auto dppf = [](float v, auto ctrl) { return __int_as_float(__builtin_amdgcn_update_dpp(0, __float_as_int(v), decltype(ctrl)::value, 0xF, 0xF, true)); };
#pragma unroll 1
        for (int i16 = 0; i16 < 16; i16 += NT) {
            const int m0 = vcu * 128 + wave * 16 + i16;
            f32x4 lg[NT];
#pragma unroll
            for (int t = 0; t < NT; ++t) lg[t] = *(const f32x4*)(LG + (size_t)(m0 + t) * 256 + 4 * lane);
            float sc[NT][4], bs[NT][4], gs[NT];
#pragma unroll
            for (int t = 0; t < NT; ++t) {
#pragma unroll
                for (int i = 0; i < 4; ++i) { sc[t][i] = sigmoidf_(lg[t][i]); bs[t][i] = sc[t][i] + bv[i]; }
            }
            {
                float a1[NT], a2[NT];
#pragma unroll
                for (int t = 0; t < NT; ++t) { a1[t] = fmaxf(bs[t][0], bs[t][1]); a2[t] = fminf(bs[t][0], bs[t][1]);
                    const float b1 = fmaxf(bs[t][2], bs[t][3]), b2 = fminf(bs[t][2], bs[t][3]); const float n1 = fmaxf(a1[t], b1), n2 = fmaxf(fminf(a1[t], b1), fmaxf(a2[t], b2)); a1[t] = n1; a2[t] = n2; }
#pragma unroll
                for (int t = 0; t < NT; ++t) {
                    { const float b1 = dppf(a1[t], std::integral_constant<int, 0xB1>{}), b2 = dppf(a2[t], std::integral_constant<int, 0xB1>{}); const float n1 = fmaxf(a1[t], b1), n2 = fmaxf(fminf(a1[t], b1), fmaxf(a2[t], b2)); a1[t] = n1; a2[t] = n2; }
                    { const float b1 = dppf(a1[t], std::integral_constant<int, 0x4E>{}), b2 = dppf(a2[t], std::integral_constant<int, 0x4E>{}); const float n1 = fmaxf(a1[t], b1), n2 = fmaxf(fminf(a1[t], b1), fmaxf(a2[t], b2)); a1[t] = n1; a2[t] = n2; }
                    { const float b1 = dppf(a1[t], std::integral_constant<int, 0x141>{}), b2 = dppf(a2[t], std::integral_constant<int, 0x141>{}); const float n1 = fmaxf(a1[t], b1), n2 = fmaxf(fminf(a1[t], b1), fmaxf(a2[t], b2)); a1[t] = n1; a2[t] = n2; }
                    gs[t] = a1[t] + a2[t];
                }
            }
            const int mygrp = lane >> 3;
            unsigned key[NT][4];
#pragma unroll
            for (int t = 0; t < NT; ++t) {
                int rank = 0;
#pragma unroll
                for (int g = 0; g < 8; ++g) { const float og = __int_as_float(__builtin_amdgcn_readlane(__float_as_int(gs[t]), 8 * g)); rank += (og > gs[t] || (og == gs[t] && g < mygrp)) ? 1 : 0; }
#pragma unroll
                for (int i = 0; i < 4; ++i) key[t][i] = (rank < 4) ? sortable(bs[t][i]) : 0u;
            }
            int my_e[NT]; float my_s[NT], ssum[NT];
#pragma unroll
            for (int t = 0; t < NT; ++t) { my_e[t] = 0; my_s[t] = 0.f; ssum[t] = 0.f; }
#pragma unroll 1
            for (int r = 0; r < 8; ++r) {
#pragma unroll
                for (int t = 0; t < NT; ++t) {
                    const unsigned lb = max(max(key[t][0], key[t][1]), max(key[t][2], key[t][3]));
                    unsigned v = lb;
                    v = max(v, (unsigned)__builtin_amdgcn_update_dpp(0, (int)v, 0xB1, 0xF, 0xF, true));
                    v = max(v, (unsigned)__builtin_amdgcn_update_dpp(0, (int)v, 0x4E, 0xF, 0xF, true));
                    v = max(v, (unsigned)__builtin_amdgcn_update_dpp(0, (int)v, 0x141, 0xF, 0xF, true));
                    v = max(v, (unsigned)__builtin_amdgcn_update_dpp(0, (int)v, 0x140, 0xF, 0xF, true));
                    v = max(v, (unsigned)__builtin_amdgcn_update_dpp(0, (int)v, 0x142, 0xA, 0xF, true));
                    v = max(v, (unsigned)__builtin_amdgcn_update_dpp(0, (int)v, 0x143, 0xC, 0xF, true));
                    const unsigned M = (unsigned)__builtin_amdgcn_readlane((int)v, 63);
                    const int ol = (int)__builtin_ctzll(__ballot(lb == M));
                    const int oi_l = (key[t][0] == M) ? 0 : (key[t][1] == M) ? 1 : (key[t][2] == M) ? 2 : 3;
                    const float sv_l = (oi_l == 0) ? sc[t][0] : (oi_l == 1) ? sc[t][1] : (oi_l == 2) ? sc[t][2] : sc[t][3];
                    const int oi = __builtin_amdgcn_readlane(oi_l, ol);
                    const float sv = __int_as_float(__builtin_amdgcn_readlane(__float_as_int(sv_l), ol));
                    const int e = 4 * ol + oi;
#pragma unroll
                    for (int i = 0; i < 4; ++i) key[t][i] = (lane == ol && i == oi) ? 0u : key[t][i];
                    ssum[t] += sv;
                    if (lane == r) { my_e[t] = e; my_s[t] = sv; }
                }
            }
            if (lane < 8) {
#pragma unroll
                for (int t = 0; t < NT; ++t) {
                    const int lpos = __hip_atomic_fetch_add(hist + my_e[t], 1, __ATOMIC_RELAXED, __HIP_MEMORY_SCOPE_WORKGROUP);
                    SEL[(size_t)(m0 + t) * 8 + lane] = (unsigned)my_e[t] | ((unsigned)lpos << 8);
                    GWt[(size_t)(m0 + t) * 8 + lane] = my_s[t] / ssum[t] * 2.5f;
                }
            }
        }
        __syncthreads();
        if (tid < 256) HG[vcu * 256 + tid] = hist[tid];
        __syncthreads();
    }
    SEAM(9);
    if (IN(10)) for (int rep = 0; rep < NREP(10); ++rep) {
        unsigned* SEL = (unsigned*)(ws + WS_SEL); const int* HG = (const int*)(ws + WS_HG); int* TOKL = (int*)(ws + WS_TOKL);
        LAS int* basel = (LAS int*)lds;
        {
            const int e = tid & 255, half = tid >> 8; int bsum = 0, tsum = 0;
#pragma unroll 16
            for (int w = 0; w < 128; ++w) { const int wg = half * 128 + w; const int v = HG[wg * 256 + e]; tsum += v; bsum += (wg < vcu) ? v : 0; }
            basel[half * 256 + e] = bsum; basel[512 + half * 256 + e] = tsum;
        }
        __syncthreads();
        if (tid < 256) { const int bsum = basel[tid] + basel[256 + tid], tsum = basel[512 + tid] + basel[768 + tid]; basel[1024 + tid] = bsum; if (vcu == 0) ctl[CW_CNT + tid] = (unsigned)tsum; }
        __syncthreads();
#pragma unroll
        for (int k2 = 0; k2 < 2; ++k2) { const int idx = tid + 512 * k2; const int m = vcu * 128 + (idx >> 3);
            const unsigned se = SEL[(size_t)m * 8 + (idx & 7)]; const int e = (int)(se & 255u), pos = basel[1024 + e] + (int)(se >> 8);
            SEL[(size_t)m * 8 + (idx & 7)] = (unsigned)e | ((unsigned)pos << 8); TOKL[(size_t)e * ECAP + pos] = m; }
        __syncthreads();
    }
    SEAM(10);
    if (IN(11)) for (int rep = 0; rep < NREP(11); ++rep) {
        LAS int* tab = (LAS int*)(lds + TAB_OFF);
        moe_tables(tab, ctl, tid);
        const LAS int* cnt = tab; const LAS int* cum = tab + 260; const LAS int* tcum = tab + 520;
        const int total = 2 * __builtin_amdgcn_readfirstlane(tcum[257]);
        LAS unsigned* gtab = (LAS unsigned*)(lds + 131072);
        {
            const int* TOKL = (const int*)(ws + WS_TOKL);
            for (int i = tid >> 8; ; i += 2) { const int uix = vcu + i * G; if (uix >= total || i >= 22) break;
                const int tile = uix >> 1, e = find_expert(tcum, tile), j = tile - tcum[e], r = tid & 255, rem = cnt[e] - 256 * j;
                int tok; if (e < 256) tok = TOKL[(size_t)e * ECAP + 256 * j + (r < rem ? r : 0)]; else tok = 256 * j + r;
                gtab[i * 256 + r] = (unsigned)tok * 2048u; }
        }
        __syncthreads();
        Fc1Order S; S.tab = tab; S.total = total; S.G = G; S.c = vcu;
        LdsGather am; am.tabl = gtab;
        pg8::Gemm g{(const bf16*)(ws + WS_H), (const bf16*)(ws + WS_W13T), 1024};
        pg8::EpiSwiglu E{(bf16*)(ws + WS_ACT)};
        pg8::gemm_phase<pg8::EpiSwiglu, Fc1Order, true, true, LdsGather>(lds, g, S, E, am);
        (void)cum;
    }
    SEAM(11);
    if (IN(12)) for (int rep = 0; rep < NREP(12); ++rep) {
        LAS int* tab = (LAS int*)(lds + TAB_OFF);
        moe_tables(tab, ctl, tid);
        Fc2Order S; S.tab = tab; S.total = 4 * __builtin_amdgcn_readfirstlane(tab[520 + 257]); S.G = G; S.c = vcu;
        pg8::Gemm g{(const bf16*)(ws + WS_ACT), (const bf16*)(ws + WS_W2T), 256};
        pg8::EpiFp8 E{(unsigned char*)(ws + WS_Y), 1024, (PMODE == 7) ? 100000 : 0};
        pg8::gemm_phase<pg8::EpiFp8, Fc2Order, true, true, pg8::NoGather>(lds, g, S, E, pg8::NoGather{});
    }
    SEAM(12);
    if (IN(13)) for (int rep = 0; rep < NREP(13); ++rep) {
        LAS int* tab = (LAS int*)(lds + TAB_OFF);
        moe_tables(tab, ctl, tid);
        const LAS int* cum = tab + 260;
        const unsigned char* Y = (const unsigned char*)(ws + WS_Y); const unsigned* SEL = (const unsigned*)(ws + WS_SEL); const float* GWt = (const float*)(ws + WS_GW);
        for (int m = gw; m < T; m += NGW) {
            const int b = m / SEQ; const float* g2 = mod + (size_t)b * 6144 + 5120;
            float acc[16];
            u32x4 yv[9]; float wv[9];
            yv[0] = __builtin_nontemporal_load((const u32x4*)(Y + ((size_t)T * 8 + m) * 1024 + 16 * lane)); wv[0] = 1.0f;
#pragma unroll
            for (int j = 0; j < 8; ++j) {
                const unsigned se = SEL[(size_t)m * 8 + j]; wv[1 + j] = GWt[(size_t)m * 8 + j];
                const int e = (int)(se & 255u), pos = (int)(se >> 8);
                yv[1 + j] = __builtin_nontemporal_load((const u32x4*)(Y + ((size_t)cum[e] + pos) * 1024 + 16 * lane));
            }
#pragma unroll
            for (int i = 0; i < 16; ++i) acc[i] = 0.f;
#pragma unroll
            for (int j = 0; j < 9; ++j) {
                const float w = wv[j]; const unsigned dw[4] = {yv[j].x, yv[j].y, yv[j].z, yv[j].w};
#pragma unroll
                for (int q4 = 0; q4 < 4; ++q4) { const f32x2 lo = __builtin_amdgcn_cvt_pk_f32_fp8((int)dw[q4], false), hi2 = __builtin_amdgcn_cvt_pk_f32_fp8((int)dw[q4], true);
                    acc[4 * q4] += w * lo.x; acc[4 * q4 + 1] += w * lo.y; acc[4 * q4 + 2] += w * hi2.x; acc[4 * q4 + 3] += w * hi2.y; }
            }
            float* orow = args.out + (size_t)m * DM + 16 * lane;
            const u32x4* xr1 = (const u32x4*)((const bf16*)(ws + WS_X1B) + (size_t)m * DM + 16 * lane); const u32x4 xa = xr1[0], xb = xr1[1];
            const unsigned xw[8] = {xa.x, xa.y, xa.z, xa.w, xb.x, xb.y, xb.z, xb.w};
#pragma unroll
            for (int q4 = 0; q4 < 4; ++q4) { const f32x4 gv = *(const f32x4*)(g2 + 16 * lane + 4 * q4);
                f32x4 o; o.x = lo16(xw[2 * q4]) + gv.x * acc[4 * q4]; o.y = hi16(xw[2 * q4]) + gv.y * acc[4 * q4 + 1]; o.z = lo16(xw[2 * q4 + 1]) + gv.z * acc[4 * q4 + 2]; o.w = hi16(xw[2 * q4 + 1]) + gv.w * acc[4 * q4 + 3];
                *(f32x4*)(orow + 4 * q4) = o; }
        }
    }
#undef IN
#undef SEAM
}

extern "C" void kernel_launch(void* const* d_in, const int* in_sizes, int n_in, void* d_out, int out_size, void* d_ws, size_t ws_size, hipStream_t stream) {
    static int grid = 0;
    if (grid == 0) {
        if (n_in != 33 || out_size != T * DM || ws_size < WS_END) { fprintf(stderr, "kernel_launch: unexpected shapes (n_in %d out %d ws %zu)\n", n_in, out_size, ws_size); grid = -1; return; }
        int dev = 0, cus = 0, per_cu = 0;
        hipGetDevice(&dev); hipDeviceGetAttribute(&cus, hipDeviceAttributeMultiprocessorCount, dev);
        hipFuncSetAttribute((const void*)fwd_kernel, hipFuncAttributeMaxDynamicSharedMemorySize, LDS_BYTES);
        hipOccupancyMaxActiveBlocksPerMultiprocessor(&per_cu, (const void*)fwd_kernel, 512, LDS_BYTES);
        (void)hipGetLastError();
        if (per_cu < 1) fprintf(stderr, "kernel_launch: occupancy query says %d\n", per_cu);
        grid = cus;
    }
    if (grid < 0) return;
    hipMemsetAsync((char*)d_ws + WS_CTL, 0, CTL_BYTES, stream);
    Args a{};
    for (int i = 0; i < 33; ++i) a.in[i] = (const float*)d_in[i];
    a.out = (float*)d_out; a.ws = (unsigned char*)d_ws;
#if MK_PER_PHASE
    for (int p = 0; p < NPHASE; ++p) { a.ph_lo = p; a.ph_hi = p + 1; hipLaunchKernelGGL(fwd_kernel, dim3(grid), dim3(512), LDS_BYTES, stream, a); }
#else
    a.ph_lo = 0; a.ph_hi = NPHASE;
    void* kargs[] = {&a};
    hipError_t e = hipLaunchCooperativeKernel((const void*)fwd_kernel, dim3(grid), dim3(512), kargs, LDS_BYTES, stream);
    if (e != hipSuccess) fprintf(stderr, "cooperative launch failed: %s (grid %d)\n", hipGetErrorString(e), grid);
#ifdef PROBE_PHASE
    a.ph_lo = PROBE_PHASE; a.ph_hi = PROBE_PHASE + 1; a.probe = 1; hipLaunchKernelGGL(fwd_kernel, dim3(grid), dim3(512), LDS_BYTES, stream, a);
#endif
#endif
}
```

```cpp
#include <hip/hip_runtime.h>
#include <type_traits>
#include <cstdio>
#include <cstdint>

#ifndef MK_PER_PHASE
#define MK_PER_PHASE 0
#endif

#define LAS __attribute__((address_space(3)))
#define GAS __attribute__((address_space(1)))
typedef unsigned short bf16;
typedef short bf16x8 __attribute__((ext_vector_type(8)));
typedef float f32x4 __attribute__((ext_vector_type(4)));
typedef float f32x16 __attribute__((ext_vector_type(16)));
typedef unsigned u32x4 __attribute__((ext_vector_type(4)));
typedef unsigned u32x2 __attribute__((ext_vector_type(2)));

constexpr int BATCH = 16, SEQ = 2048, DM = 1024, T = BATCH * SEQ;
constexpr int NP = 3840;
constexpr int IN_COLS = 3652;
constexpr int C_RWR = 0, C_RWK = 512, C_RWV = 1024, C_WL = 1536;
constexpr int C_Q = 1792, C_K = 2304, C_V = 2816, C_QI = 3328, C_KI = 3584, C_WI = 3648;
constexpr int NEXP = 256, ECAP = 32768;

constexpr size_t MiB = 1u << 20;
constexpr size_t WS_CTL = 0, CTL_BYTES = 32768;
constexpr size_t WS_MOD = 1 * MiB;
constexpr size_t WS_WINT = 2 * MiB;
constexpr size_t WS_WOUTT = 10 * MiB;
constexpr size_t WS_WLT = 12 * MiB;
constexpr size_t WS_WRT = 13 * MiB;
constexpr size_t WS_W2T = 16 * MiB;
constexpr size_t WS_W13T = 145 * MiB;
constexpr size_t WS_H = 404 * MiB;
constexpr size_t WS_P = 468 * MiB;
constexpr size_t WS_XR = 708 * MiB, WS_XK = 740 * MiB, WS_XV = 772 * MiB, WS_KKN = 804 * MiB;
constexpr size_t WS_LORA = 836 * MiB;
constexpr size_t WS_EE = 852 * MiB, WS_BV = 884 * MiB, WS_GG = 916 * MiB, WS_VF = 948 * MiB, WS_KF = 980 * MiB, WS_KIF = 1012 * MiB;
constexpr size_t WS_LOGIT = 468 * MiB;
constexpr size_t WS_TOKL = 500 * MiB;
constexpr size_t WS_Y = 145 * MiB;
constexpr size_t WS_ACT = 724 * MiB;
constexpr size_t WS_SEL = 870 * MiB;
constexpr size_t WS_GW = 872 * MiB;
constexpr size_t WS_X1B = 560 * MiB;
constexpr size_t WS_HG = 874 * MiB;
constexpr size_t WS_END = 1024 * MiB;
constexpr int CW_QUEUE = 64, CW_CNT = 1024  , CW_BAR = 4096;

constexpr int RING_BYTES = 153600;
constexpr int MISC_OFF = RING_BYTES;
constexpr int TAB_OFF = RING_BYTES + 256;
constexpr int MASK_OFF = 131072;
constexpr int LDS_BYTES = RING_BYTES + 8192;

__device__ __forceinline__ float bf2f(unsigned h) { return __uint_as_float(h << 16); }
typedef __bf16 bf16v2 __attribute__((ext_vector_type(2)));
typedef float f32x2 __attribute__((ext_vector_type(2)));
__device__ __forceinline__ unsigned pk2(float lo, float hi) { const f32x2 v = {lo, hi}; return __builtin_bit_cast(unsigned, __builtin_convertvector(v, bf16v2)); }
__device__ __forceinline__ unsigned f2bf(float f) { return pk2(f, 0.f) & 0xffffu; }
__device__ __forceinline__ float lo16(unsigned w) { return __uint_as_float(w << 16); }
__device__ __forceinline__ float hi16(unsigned w) { return __uint_as_float(w & 0xffff0000u); }
__device__ __forceinline__ float sigmoidf_(float x) { return 1.0f / (1.0f + __expf(-x)); }
__device__ __forceinline__ float sigmoid_fast(float x) { return __builtin_amdgcn_rcpf(1.0f + __expf(-x)); }
__device__ __forceinline__ float tanh_fast(float x) { return 1.0f - 2.0f * __builtin_amdgcn_rcpf(1.0f + __expf(2.0f * x)); }

namespace pg8 {
constexpr int BM = 256, BK = 64, HALF = 128, HTB = HALF * BK * 2, STAGE_BYTES = 8 * HTB, NXCD = 8, WGM = 8;
__host__ __device__ __forceinline__ int lds_byte(int r, int c) { const int st = (r >> 4) * 2 + (c >> 5), rr = r & 15, cc = c & 31, ob = rr * 64 + cc * 2; return st * 1024 + (ob ^ (((ob >> 9) & 1) << 5)); }
__host__ __device__ __forceinline__ void stage_rc(int b, int& R, int& C) { const int st = b / 1024, sb = b % 1024, swz = sb ^ (((sb >> 9) & 1) << 5); R = (st >> 1) * 16 + swz / 64; C = (st & 1) * 32 + (swz % 64) / 2; }
__host__ __device__ __forceinline__ int perm32(int rho) { const int n = rho >> 4, i = rho & 15; return 8 * (i >> 2) + 4 * n + (i & 3); }

struct Unit { int arow, brow, orow, ocol, nvalid, aux; };
struct Gemm { const bf16* A; const bf16* Bt; int K; };

struct StaticOrder {
    int nM, nN, nwg, G, c;
    __device__ void init(int M, int N, int G_, int c_) { nM = M / BM; nN = N / BM; nwg = nM * nN; G = G_; c = c_; }
    __device__ bool next(int i, Unit& u) const {
        const long L = (long)i * G + c; if (L >= nwg) return false;
        int wgid = (int)L; { const int q = nwg / NXCD, r = nwg % NXCD, xcd = wgid % NXCD, off = wgid / NXCD; wgid = (xcd < r ? xcd * (q + 1) : r * (q + 1) + (xcd - r) * q) + off; }
        const int nig = WGM * nN, gid = wgid / nig, fm = gid * WGM, gsz = (nM - fm) < WGM ? (nM - fm) : WGM;
        const int pm = fm + ((wgid % nig) % gsz), pn = (wgid % nig) / gsz;
        u.arow = pm * BM; u.brow = pn * BM; u.orow = pm * BM; u.ocol = pn * BM; u.nvalid = BM; u.aux = 0; return true;
    }
};
struct OneUnit { Unit u; __device__ bool next(int i, Unit& o) const { if (i != 0) return false; o = u; return true; } };
struct NoGather { static constexpr bool GATHER = false; __device__ __forceinline__ unsigned rowoff(int, int) const { return 0u; } };

template <class Epi, class Sched, bool ALIGN_EPI, bool SP2, class AMap>
__device__ __forceinline__ void gemm_phase(LAS unsigned char* lds, const Gemm g, const Sched& S, const Epi& E, const AMap& amap) {
    constexpr bool GATHER = AMap::GATHER;
    const int tid = threadIdx.x, wid = __builtin_amdgcn_readfirstlane(tid >> 6), lane = tid & 63, wr = wid >> 2, wc = wid & 3, fr = lane & 15, fq = lane >> 4;
    const int K = g.K, nt = K / BK;
    unsigned voffA[2], voffB[2], voffG[2][2];
    int RA[2], CA[2];
#pragma unroll
    for (int i = 0; i < 2; ++i) { int R, C; stage_rc(tid * 16 + i * 8192, R, C); const int Rb = Epi::PERM ? ((R & ~31) + perm32(R & 31)) : R;
        voffA[i] = (unsigned)(R * K + C) * 2u; voffB[i] = (unsigned)(Rb * K + C) * 2u; RA[i] = R; CA[i] = C; voffG[0][i] = 0u; voffG[1][i] = 0u; }
    unsigned voffGn[2][2] = {{0u, 0u}, {0u, 0u}};
    if constexpr (GATHER) {
#pragma unroll
        for (int h = 0; h < 2; ++h)
#pragma unroll
            for (int i = 0; i < 2; ++i) voffG[h][i] = amap.rowoff(0, h * HALF + RA[i]) + (unsigned)CA[i] * 2u;
    }
    const size_t kstep = (size_t)(BK * 2);
    const size_t hstep = (size_t)HALF * K * 2;
    const size_t rowb = (size_t)K * 2;
    const unsigned ldsw = (unsigned)wid * 1024u;
    const int aoff = lds_byte(wr * 64 + fr, fq * 8), boff = lds_byte(wc * 32 + fr, fq * 8);
#define PG8_SA(b, h) (((b) * 2 + (h)) * HTB)
#define PG8_SB(b, h) ((4 + (b) * 2 + (h)) * HTB)
#define PG8_STAGE(bufoff, gbase, voff) do { _Pragma("unroll") for (int _i = 0; _i < 2; ++_i) \
        __builtin_amdgcn_global_load_lds((const unsigned*)((const char*)(gbase) + (voff)[_i]), (LAS unsigned*)(lds + (bufoff) + ldsw + _i * 8192), 16, 0, 0); } while (0)
#define PG8_STAGEA(bufoff, gbase, h) do { if constexpr (GATHER) { PG8_STAGE(bufoff, gbase, voffG[h]); } else { PG8_STAGE(bufoff, (gbase) + (h) * hstep, voffA); } } while (0)
#define PG8_STAGEAN(bufoff, gbase, h) do { if constexpr (GATHER) { PG8_STAGE(bufoff, gbase, vsel[h]); } else { PG8_STAGE(bufoff, (gbase) + (h) * hstep, voffA); } } while (0)
#define PG8_LDA(dst, b, h) do { _Pragma("unroll") for (int m = 0; m < 4; ++m) _Pragma("unroll") for (int k = 0; k < 2; ++k) dst[m][k] = *(const LAS bf16x8*)(lds + PG8_SA(b, h) + aoff + m * 2048 + k * 1024); } while (0)
#define PG8_LDB(dst, b, h) do { _Pragma("unroll") for (int n = 0; n < 2; ++n) _Pragma("unroll") for (int k = 0; k < 2; ++k) dst[n][k] = *(const LAS bf16x8*)(lds + PG8_SB(b, h) + boff + n * 2048 + k * 1024); } while (0)
#define PG8_MMA(ai, bj, At, Bt) do { __builtin_amdgcn_s_setprio(1); _Pragma("unroll") for (int m = 0; m < 4; ++m) _Pragma("unroll") for (int n = 0; n < 2; ++n) _Pragma("unroll") for (int k = 0; k < 2; ++k) \
        acc[ai][bj][m][n] = __builtin_amdgcn_mfma_f32_16x16x32_bf16(Bt[n][k], At[m][k], acc[ai][bj][m][n], 0, 0, 0); __builtin_amdgcn_s_setprio(0); } while (0)
#define PG8_WAIT_V(n) asm volatile("s_waitcnt vmcnt(" #n ")" ::: "memory")
#define PG8_WAIT_L(n) asm volatile("s_waitcnt lgkmcnt(" #n ")" ::: "memory")
#define PG8_BAR __builtin_amdgcn_s_barrier()
#define PG8_SCHED __builtin_amdgcn_sched_barrier(0)
    Unit cur, nxt; int ui = 0;
    if (!S.next(0, cur)) return;
    f32x4 acc[2][2][4][2];
#pragma unroll
    for (int a = 0; a < 2; ++a)
#pragma unroll
        for (int b = 0; b < 2; ++b)
#pragma unroll
            for (int m = 0; m < 4; ++m)
#pragma unroll
                for (int n = 0; n < 2; ++n) acc[a][b][m][n] = (f32x4){0.f, 0.f, 0.f, 0.f};
    bf16x8 At[4][2], B0[2][2], B1[2][2];
    const char* cA = (const char*)g.A + (GATHER ? (size_t)0 : (size_t)cur.arow * rowb); const char* cB = (const char*)g.Bt + (size_t)cur.brow * rowb;
    if constexpr (SP2) {
        PG8_STAGE(PG8_SB(0, 0), cB, voffB); PG8_STAGE(PG8_SB(0, 1), cB + hstep, voffB); PG8_STAGEA(PG8_SA(0, 0), cA, 0); PG8_STAGEA(PG8_SA(0, 1), cA, 1);
        if (wr == 1) PG8_BAR;
        PG8_WAIT_V(2); PG8_BAR;
        PG8_STAGE(PG8_SB(1, 0), cB + kstep, voffB); PG8_STAGEA(PG8_SA(1, 0), cA + kstep, 0); PG8_STAGE(PG8_SB(1, 1), cB + hstep + kstep, voffB);
        PG8_WAIT_V(6); PG8_BAR;
    } else {
        PG8_STAGE(PG8_SB(0, 0), cB, voffB); PG8_STAGEA(PG8_SA(0, 0), cA, 0); PG8_STAGE(PG8_SB(0, 1), cB + hstep, voffB); PG8_STAGEA(PG8_SA(0, 1), cA, 1);
        if (wr == 1) PG8_BAR;
        PG8_WAIT_V(4); PG8_BAR;
        PG8_STAGE(PG8_SB(1, 0), cB + kstep, voffB); PG8_STAGEA(PG8_SA(1, 0), cA + kstep, 0); PG8_STAGE(PG8_SB(1, 1), cB + hstep + kstep, voffB);
        PG8_WAIT_V(6); PG8_BAR;
    }
    for (;;) {
        const bool has_next = S.next(ui + 1, nxt);
        if constexpr (GATHER) { if (has_next) {
#pragma unroll
            for (int h = 0; h < 2; ++h)
#pragma unroll
                for (int i = 0; i < 2; ++i) voffGn[h][i] = amap.rowoff(ui + 1, h * HALF + RA[i]) + (unsigned)CA[i] * 2u; } else {
#pragma unroll
            for (int h = 0; h < 2; ++h)
#pragma unroll
                for (int i = 0; i < 2; ++i) voffGn[h][i] = voffG[h][i]; } }
        const char* nA = has_next ? (const char*)g.A + (GATHER ? (size_t)0 : (size_t)nxt.arow * rowb) : cA; const char* nB = has_next ? (const char*)g.Bt + (size_t)nxt.brow * rowb : cB;
#pragma unroll 1
        for (int t = 0; t < nt; t += 2) {
            const bool last = (t == nt - 2);
            const char* a1 = cA + (size_t)(t + 1) * kstep;
            const char* a2 = last ? nA : cA + (size_t)(t + 2) * kstep; const char* b2 = last ? nB : cB + (size_t)(t + 2) * kstep;
            const char* a3 = a2 + kstep; const char* b3 = b2 + kstep;
            unsigned vsel[2][2];
#pragma unroll
            for (int h = 0; h < 2; ++h)
#pragma unroll
                for (int i = 0; i < 2; ++i) vsel[h][i] = last ? voffGn[h][i] : voffG[h][i];
            if constexpr (SP2) {
            PG8_LDB(B0, 0, 0); PG8_LDB(B1, 0, 1); PG8_SCHED; PG8_LDA(At, 0, 0); PG8_STAGEA(PG8_SA(1, 1), a1, 1);
            PG8_WAIT_V(8); PG8_WAIT_L(0); PG8_BAR; PG8_MMA(0, 0, At, B0); PG8_MMA(0, 1, At, B1); PG8_BAR; PG8_SCHED;
            PG8_LDA(At, 0, 1); PG8_STAGE(PG8_SB(0, 0), b2, voffB); PG8_STAGE(PG8_SB(0, 1), b2 + hstep, voffB); PG8_STAGEAN(PG8_SA(0, 0), a2, 0);
            PG8_WAIT_V(8); PG8_WAIT_L(0); PG8_BAR; if (cur.nvalid > HALF) { PG8_MMA(1, 0, At, B0); PG8_MMA(1, 1, At, B1); } PG8_BAR; PG8_SCHED;
            PG8_LDB(B0, 1, 0); PG8_LDB(B1, 1, 1); PG8_SCHED; PG8_LDA(At, 1, 0); PG8_STAGEAN(PG8_SA(0, 1), a2, 1);
            PG8_WAIT_V(8); PG8_WAIT_L(0); PG8_BAR; PG8_MMA(0, 0, At, B0); PG8_MMA(0, 1, At, B1); PG8_BAR; PG8_SCHED;
            PG8_LDA(At, 1, 1); PG8_STAGE(PG8_SB(1, 0), b3, voffB); PG8_STAGE(PG8_SB(1, 1), b3 + hstep, voffB); PG8_STAGEAN(PG8_SA(1, 0), a3, 0);
            PG8_WAIT_V(8); PG8_WAIT_L(0); PG8_BAR; if (cur.nvalid > HALF) { PG8_MMA(1, 0, At, B0); PG8_MMA(1, 1, At, B1); } PG8_BAR; PG8_SCHED;
            } else {
            PG8_LDB(B0, 0, 0); PG8_SCHED; PG8_LDA(At, 0, 0); PG8_STAGEA(PG8_SA(1, 1), a1, 1);
            PG8_WAIT_L(8); PG8_BAR; PG8_WAIT_L(0); PG8_MMA(0, 0, At, B0); PG8_BAR; PG8_SCHED;
            PG8_LDB(B1, 0, 1); PG8_STAGE(PG8_SB(0, 0), b2, voffB);
            PG8_BAR; PG8_WAIT_L(0); PG8_MMA(0, 1, At, B1); PG8_BAR;
            PG8_LDA(At, 0, 1); PG8_STAGEAN(PG8_SA(0, 0), a2, 0);
            PG8_BAR; PG8_WAIT_L(0); PG8_MMA(1, 0, At, B0); PG8_BAR; PG8_SCHED;
            PG8_STAGE(PG8_SB(0, 1), b2 + hstep, voffB);
            PG8_WAIT_V(6); PG8_BAR; PG8_MMA(1, 1, At, B1); PG8_BAR;
            PG8_LDB(B0, 1, 0); PG8_SCHED; PG8_LDA(At, 1, 0); PG8_STAGEAN(PG8_SA(0, 1), a2, 1);
            PG8_WAIT_L(8); PG8_BAR; PG8_WAIT_L(0); PG8_MMA(0, 0, At, B0); PG8_BAR; PG8_SCHED;
            PG8_LDB(B1, 1, 1); PG8_STAGE(PG8_SB(1, 0), b3, voffB);
            PG8_BAR; PG8_WAIT_L(0); PG8_MMA(0, 1, At, B1); PG8_BAR;
            PG8_LDA(At, 1, 1); PG8_STAGEAN(PG8_SA(1, 0), a3, 0);
            PG8_BAR; PG8_WAIT_L(0); PG8_MMA(1, 0, At, B0); PG8_BAR; PG8_SCHED;
            PG8_STAGE(PG8_SB(1, 1), b3 + hstep, voffB);
            PG8_WAIT_V(6); PG8_BAR; PG8_MMA(1, 1, At, B1); PG8_BAR;
            }
        }
        if constexpr (ALIGN_EPI) { if (wr == 0) PG8_BAR; }
        E(acc, cur, wr, wc, fr, fq);
        if (!has_next) break;
#pragma unroll
        for (int a = 0; a < 2; ++a)
#pragma unroll
            for (int b = 0; b < 2; ++b)
#pragma unroll
                for (int m = 0; m < 4; ++m)
#pragma unroll
                    for (int n = 0; n < 2; ++n) acc[a][b][m][n] = (f32x4){0.f, 0.f, 0.f, 0.f};
        cur = nxt; cA = nA; cB = nB; ++ui;
        if constexpr (GATHER) {
#pragma unroll
            for (int h = 0; h < 2; ++h)
#pragma unroll
                for (int i = 0; i < 2; ++i) voffG[h][i] = voffGn[h][i]; }
        if constexpr (ALIGN_EPI) { if (wr == 1) PG8_BAR; }
    }
    PG8_WAIT_V(0);
    if constexpr (!ALIGN_EPI) { if (wr == 0) PG8_BAR; }
    PG8_BAR;
#undef PG8_SA
#undef PG8_SB
#undef PG8_STAGE
#undef PG8_STAGEA
#undef PG8_STAGEAN
#undef PG8_LDA
#undef PG8_LDB
#undef PG8_MMA
#undef PG8_WAIT_V
#undef PG8_WAIT_L
#undef PG8_BAR
#undef PG8_SCHED
}

struct EpiBf16 {
    static constexpr bool PERM = true;
    bf16* O; int ldc; int skip;
    __device__ __forceinline__ void operator()(const f32x4 (&acc)[2][2][4][2], const Unit& u, int wr, int wc, int fr, int fq) const {
#pragma unroll
        for (int ai = 0; ai < 2; ++ai)
#pragma unroll
            for (int m = 0; m < 4; ++m) { const int lr = ai * HALF + wr * 64 + m * 16 + fr; if (lr < u.nvalid - skip) { bf16* rowp = O + (size_t)(u.orow + lr) * ldc + u.ocol + wc * 32 + 8 * fq;
#pragma unroll
                for (int bj = 0; bj < 2; ++bj) { const f32x4 v0 = acc[ai][bj][m][0], v1 = acc[ai][bj][m][1]; u32x4 w; w.x = pk2(v0[0], v0[1]); w.y = pk2(v0[2], v0[3]); w.z = pk2(v1[0], v1[1]); w.w = pk2(v1[2], v1[3]);
                    *(u32x4*)(rowp + bj * HALF) = w; } } }
    }
};
struct EpiFp8 {
    static constexpr bool PERM = true;
    unsigned char* O; int ldc; int skip;
    __device__ __forceinline__ void operator()(const f32x4 (&acc)[2][2][4][2], const Unit& u, int wr, int wc, int fr, int fq) const {
#pragma unroll
        for (int ai = 0; ai < 2; ++ai)
#pragma unroll
            for (int m = 0; m < 4; ++m) { const int lr = ai * HALF + wr * 64 + m * 16 + fr; if (lr < u.nvalid - skip) { unsigned char* rowp = O + (size_t)(u.orow + lr) * ldc + u.ocol + wc * 32 + 8 * fq;
#pragma unroll
                for (int bj = 0; bj < 2; ++bj) { const f32x4 v0 = acc[ai][bj][m][0], v1 = acc[ai][bj][m][1]; int w0 = 0, w1 = 0;
                    w0 = __builtin_amdgcn_cvt_pk_fp8_f32(v0[0], v0[1], w0, false); w0 = __builtin_amdgcn_cvt_pk_fp8_f32(v0[2], v0[3], w0, true);
                    w1 = __builtin_amdgcn_cvt_pk_fp8_f32(v1[0], v1[1], w1, false); w1 = __builtin_amdgcn_cvt_pk_fp8_f32(v1[2], v1[3], w1, true);
                    *(u32x2*)(rowp + bj * HALF) = (u32x2){(unsigned)w0, (unsigned)w1}; } } }
    }
};
struct EpiF32 {
    static constexpr bool PERM = false;
    float* C; int ldc;
    __device__ __forceinline__ void operator()(const f32x4 (&acc)[2][2][4][2], const Unit& u, int wr, int wc, int fr, int fq) const {
#pragma unroll
        for (int ai = 0; ai < 2; ++ai)
#pragma unroll
            for (int m = 0; m < 4; ++m) { float* rowp = C + (size_t)(u.orow + ai * HALF + wr * 64 + m * 16 + fr) * ldc + u.ocol + wc * 32 + 4 * fq;
#pragma unroll
                for (int bj = 0; bj < 2; ++bj)
#pragma unroll
                    for (int n = 0; n < 2; ++n) *(f32x4*)(rowp + bj * HALF + n * 16) = acc[ai][bj][m][n]; }
    }
};
struct EpiResid {
    static constexpr bool PERM = true;
    const float* x; bf16* out; const float* mod; int goff;
    __device__ __forceinline__ void operator()(const f32x4 (&acc)[2][2][4][2], const Unit& u, int wr, int wc, int fr, int fq) const {
        const int b = u.orow / SEQ; const float* gp = mod + (size_t)b * 6144 + goff + u.ocol + wc * 32 + 8 * fq;
        f32x4 gv[2][2];
#pragma unroll
        for (int bj = 0; bj < 2; ++bj)
#pragma unroll
            for (int n = 0; n < 2; ++n) gv[bj][n] = *(const f32x4*)(gp + bj * HALF + 4 * n);
#pragma unroll
        for (int ai = 0; ai < 2; ++ai)
#pragma unroll
            for (int mp = 0; mp < 4; mp += 2) {
                f32x4 xv[2][2][2];
#pragma unroll
                for (int mm = 0; mm < 2; ++mm) { const size_t off = (size_t)(u.orow + ai * HALF + wr * 64 + (mp + mm) * 16 + fr) * DM + u.ocol + wc * 32 + 8 * fq;
#pragma unroll
                    for (int bj = 0; bj < 2; ++bj)
#pragma unroll
                        for (int n = 0; n < 2; ++n) xv[mm][bj][n] = *(const f32x4*)(x + off + bj * HALF + 4 * n); }
#pragma unroll
                for (int mm = 0; mm < 2; ++mm) { const size_t off = (size_t)(u.orow + ai * HALF + wr * 64 + (mp + mm) * 16 + fr) * DM + u.ocol + wc * 32 + 8 * fq;
#pragma unroll
                    for (int bj = 0; bj < 2; ++bj) { const f32x4 o0 = xv[mm][bj][0] + gv[bj][0] * acc[ai][bj][mp + mm][0], o1 = xv[mm][bj][1] + gv[bj][1] * acc[ai][bj][mp + mm][1];
                        *(u32x4*)(out + off + bj * HALF) = (u32x4){pk2(o0[0], o0[1]), pk2(o0[2], o0[3]), pk2(o1[0], o1[1]), pk2(o1[2], o1[3])}; } }
            }
    }
};
struct EpiSwiglu {
    static constexpr bool PERM = true;
    bf16* act;
    __device__ __forceinline__ void operator()(const f32x4 (&acc)[2][2][4][2], const Unit& u, int wr, int wc, int fr, int fq) const {
#pragma unroll
        for (int ai = 0; ai < 2; ++ai)
#pragma unroll
            for (int m = 0; m < 4; ++m) { const int lr = ai * HALF + wr * 64 + m * 16 + fr; if (lr < u.nvalid) {
                float o[8];
#pragma unroll
                for (int n = 0; n < 2; ++n)
#pragma unroll
                    for (int i = 0; i < 4; ++i) { const float a = acc[ai][0][m][n][i], c = acc[ai][1][m][n][i]; o[4 * n + i] = a * sigmoid_fast(a) * c; }
                u32x4 w; w.x = pk2(o[0], o[1]); w.y = pk2(o[2], o[3]); w.z = pk2(o[4], o[5]); w.w = pk2(o[6], o[7]);
                *(u32x4*)(act + (size_t)(u.orow + lr) * 256 + u.ocol + wc * 32 + 8 * fq) = w; } }
    }
};
struct EpiLora {
    static constexpr bool PERM = true;
    const float* w0; const float* a0; const float* k_a; bf16* EE; bf16* XK; const bf16* KKN; bf16* BV; bf16* GG;
    __device__ __forceinline__ void operator()(const f32x4 (&acc)[2][2][4][2], const Unit& u, int wr, int wc, int fr, int fq) const {
        const int br = u.ocol >> 9;
        const int cbase = (u.ocol & 511) + wc * 32 + 8 * fq;
        const size_t rbase = (size_t)(u.orow + wr * 64 + fr) * 512 + cbase;
        if (br == 0) {
#pragma unroll
            for (int bj = 0; bj < 2; ++bj) {
                const f32x4 pa = *(const f32x4*)(w0 + cbase + bj * HALF), pb = *(const f32x4*)(w0 + cbase + bj * HALF + 4);
#pragma unroll
                for (int ai = 0; ai < 2; ++ai)
#pragma unroll
                    for (int m = 0; m < 4; ++m) {
                        float e[8];
#pragma unroll
                        for (int i = 0; i < 4; ++i) {
                            e[i] = 0.60653066f * sigmoid_fast(pa[i] + acc[ai][bj][m][0][i]);
                            e[4 + i] = 0.60653066f * sigmoid_fast(pb[i] + acc[ai][bj][m][1][i]);
                        }
                        u32x4 w; w.x = pk2(e[0], e[1]); w.y = pk2(e[2], e[3]); w.z = pk2(e[4], e[5]); w.w = pk2(e[6], e[7]);
                        *(u32x4*)(EE + rbase + (size_t)(ai * HALF + m * 16) * 512 + bj * HALF) = w;
                    }
            }
        } else if (br == 1) {
#pragma unroll
            for (int bj = 0; bj < 2; ++bj) {
                const f32x4 pa = *(const f32x4*)(a0 + cbase + bj * HALF), pb = *(const f32x4*)(a0 + cbase + bj * HALF + 4);
#pragma unroll
                for (int ai = 0; ai < 2; ++ai)
#pragma unroll
                    for (int m = 0; m < 4; ++m) {
                        float av[8];
#pragma unroll
                        for (int i = 0; i < 4; ++i) { av[i] = sigmoid_fast(pa[i] + acc[ai][bj][m][0][i]); av[4 + i] = sigmoid_fast(pb[i] + acc[ai][bj][m][1][i]); }
                        u32x4 w; w.x = pk2(av[0], av[1]); w.y = pk2(av[2], av[3]); w.z = pk2(av[4], av[5]); w.w = pk2(av[6], av[7]);
                        *(u32x4*)(BV + rbase + (size_t)(ai * HALF + m * 16) * 512 + bj * HALF) = w;
                    }
            }
        } else {
#pragma unroll
            for (int bj = 0; bj < 2; ++bj)
#pragma unroll
                for (int ai = 0; ai < 2; ++ai)
#pragma unroll
                    for (int m = 0; m < 4; ++m) {
                        const f32x4 v0 = acc[ai][bj][m][0], v1 = acc[ai][bj][m][1];
                        u32x4 w; w.x = pk2(v0[0], v0[1]); w.y = pk2(v0[2], v0[3]); w.z = pk2(v1[0], v1[1]); w.w = pk2(v1[2], v1[3]);
                        *(u32x4*)(GG + rbase + (size_t)(ai * HALF + m * 16) * 512 + bj * HALF) = w;
                    }
        }
    }
};
}

#define XB_TMO      128
#define XB_XCNT(j)  (256  + 64 * (j))
#define XB_XSUB(j)  (1280 + 64 * (j))
#define XB_XGEN(j)  (2304 + 64 * (j))
#define XB_TOP      3328
#define XB_TOPGEN   3392
#define XCD_BAR_WORDS 3456
#define XB_SPIN_CAP (1u << 22)
__device__ __forceinline__ unsigned xb_ld(unsigned* p)              { return __hip_atomic_load(p, __ATOMIC_RELAXED, __HIP_MEMORY_SCOPE_AGENT); }
__device__ __forceinline__ unsigned xb_add(unsigned* p, unsigned v) { return __hip_atomic_fetch_add(p, v, __ATOMIC_RELAXED, __HIP_MEMORY_SCOPE_AGENT); }
__device__ __forceinline__ unsigned xb_xcc_id() { return (unsigned)__builtin_amdgcn_s_getreg((3 << 11) | 20) & 0xFu; }
#define XB_SPIN(cond, bar) do { unsigned _sp = 0; while (cond) { __builtin_amdgcn_s_sleep(1); \
    if ((++_sp & 255u) == 0u) { if (xb_ld(&(bar)[XB_TMO])) break; if (_sp > XB_SPIN_CAP) { atomicAdd(&(bar)[XB_TMO], 1u); break; } } } } while (0)
struct XcdBarrier { unsigned* bar; unsigned x; volatile LAS unsigned* st; };
__device__ __forceinline__ XcdBarrier xcd_barrier_post(unsigned* bar, volatile LAS unsigned* st) {
    XcdBarrier b; b.bar = bar; b.x = xb_xcc_id(); b.st = st;
    if (threadIdx.x == 0) (void)xb_add(&bar[XB_XCNT(b.x)], 1u);
    return b;
}
__device__ __forceinline__ void xcd_barrier_complete(unsigned* bar, unsigned x, unsigned& nloc, unsigned& nx) {
    const unsigned G = gridDim.x * gridDim.y * gridDim.z;
    unsigned sum, cnt, mine, sp = 0u;
    for (;;) {
        sum = 0u; cnt = 0u; mine = 0u;
#pragma unroll
        for (unsigned j = 0; j < 16; ++j) { const unsigned c = xb_ld(&bar[XB_XCNT(j)]); sum += c; cnt += (c > 0u) ? 1u : 0u; mine = (j == x) ? c : mine; }
        if (sum == G) break;
        __builtin_amdgcn_s_sleep(1);
        if ((++sp & 255u) == 0u) { if (xb_ld(&bar[XB_TMO])) break; if (sp > XB_SPIN_CAP) { atomicAdd(&bar[XB_TMO], 1u); break; } }
    }
    nloc = mine > 0u ? mine : 1u; nx = cnt > 0u ? cnt : 1u;
}
__device__ __forceinline__ void xcd_barrier(const XcdBarrier& b) {
    asm volatile("s_waitcnt vmcnt(0)" ::: "memory");
    __syncthreads();
    if (threadIdx.x == 0) {
        unsigned* bar = b.bar;
        __builtin_amdgcn_s_waitcnt(0);
        unsigned nloc = b.st[0], nx = b.st[1];
        if (nloc == 0u) { xcd_barrier_complete(bar, b.x, nloc, nx); b.st[0] = nloc; b.st[1] = nx; }
        const unsigned old = xb_add(&bar[XB_XSUB(b.x)], 1u);
        const unsigned gen = old / nloc;
        if (old + 1u == (gen + 1u) * nloc) {
            __builtin_amdgcn_fence(__ATOMIC_RELEASE, "agent");
            asm volatile("s_waitcnt vmcnt(0)" ::: "memory");
            const unsigned og = xb_add(&bar[XB_TOP], 1u);
            const unsigned tg = og / nx;
            if (og + 1u == (tg + 1u) * nx) xb_add(&bar[XB_TOPGEN], 1u);
            else XB_SPIN(xb_ld(&bar[XB_TOPGEN]) == tg, bar);
            __builtin_amdgcn_fence(__ATOMIC_ACQUIRE, "agent");
            xb_add(&bar[XB_XGEN(b.x)], 1u);
            asm volatile("s_waitcnt vmcnt(0)" ::: "memory");
        } else {
            XB_SPIN(xb_ld(&bar[XB_XGEN(b.x)]) == gen, bar);
            __builtin_amdgcn_fence(__ATOMIC_ACQUIRE, "agent");
            asm volatile("s_waitcnt vmcnt(0)" ::: "memory");
        }
    }
    __syncthreads();
}

struct Args { const float* in[33]; float* out; unsigned char* ws; int ph_lo, ph_hi, probe, pad; };

#define LDS_WAIT() asm volatile("s_waitcnt lgkmcnt(0)" ::: "memory")

__device__ __forceinline__ void p0_transpose_item(const float* W, int K, int Nsrc, bf16* WT, int dest_row0, int k0, int n0, LAS float* scr, int lane) {
    const int c4 = 4 * (lane & 15), kr = lane >> 4; const bool ok = (n0 + c4) < Nsrc;
    f32x4 tv[16];
#pragma unroll
    for (int i = 0; i < 16; ++i) { const int kk = 4 * i + kr; tv[i] = ok ? __builtin_nontemporal_load((const f32x4*)(W + (size_t)(k0 + kk) * Nsrc + n0 + c4)) : (f32x4){0.f, 0.f, 0.f, 0.f}; }
#pragma unroll
    for (int i = 0; i < 16; ++i) { const int kk = 4 * i + kr; LAS float* d = scr + kk * 65 + c4; d[0] = tv[i].x; d[1] = tv[i].y; d[2] = tv[i].z; d[3] = tv[i].w; }
    LDS_WAIT(); asm volatile("" ::: "memory");
    const int c = lane & 7;
#pragma unroll
    for (int j = 0; j < 8; ++j) { const int n = (lane >> 3) + 8 * j; const LAS float* sp = scr + (8 * c) * 65 + n;
        u32x4 o; o.x = pk2(sp[0 * 65], sp[1 * 65]); o.y = pk2(sp[2 * 65], sp[3 * 65]); o.z = pk2(sp[4 * 65], sp[5 * 65]); o.w = pk2(sp[6 * 65], sp[7 * 65]);
        *(u32x4*)(WT + (size_t)(dest_row0 + n) * K + k0 + 8 * c) = o; }
    LDS_WAIT(); asm volatile("" ::: "memory");
}
struct P0Item { const float* src; bf16* dst; int K, Nsrc, dest_row0, k0, n0; };
__device__ __forceinline__ P0Item p0_expert_desc(const Args& args, unsigned char* ws, int e, int q) {
    P0Item it;
    if (q < 128) {
        const int which = q >> 6, qq = q & 63, kb = qq / 4, nb = qq % 4, n0 = 64 * nb;
        it.src = (e < 256) ? args.in[which ? 28 : 27] + (size_t)e * 1024 * 256 : args.in[which ? 31 : 30];
        it.dst = (bf16*)(ws + WS_W13T) + (size_t)e * 512 * 1024; it.K = 1024; it.Nsrc = 256; it.dest_row0 = (n0 >> 7) * 256 + (n0 & 127) + which * 128; it.k0 = 64 * kb; it.n0 = n0;
    } else {
        const int qq = q - 128, kb = qq / 16, nb = qq % 16;
        it.src = (e < 256) ? args.in[29] + (size_t)e * 256 * 1024 : args.in[32];
        it.dst = (bf16*)(ws + WS_W2T) + (size_t)e * 1024 * 256; it.K = 256; it.Nsrc = 1024; it.dest_row0 = 64 * nb; it.k0 = 64 * kb; it.n0 = 64 * nb;
    }
    return it;
}
__device__ __forceinline__ void p0_expert_item(const Args& args, unsigned char* ws, int e, int q, LAS float* scr, int lane) {
    const P0Item it = p0_expert_desc(args, ws, e, q);
    p0_transpose_item(it.src, it.K, it.Nsrc, it.dst, it.dest_row0, it.k0, it.n0, scr, lane);
}
__device__ __forceinline__ void p0_expert_wave(const Args& args, unsigned char* ws, int e, int qbeg, int qend, int wave, LAS float* scr, int lane) {
    const int c4 = 4 * (lane & 15), kr = lane >> 4, c = lane & 7;
    LAS unsigned* S = (LAS unsigned*)scr;
    f32x4 tv[16];
    P0Item cur = p0_expert_desc(args, ws, e, qbeg + wave);
#pragma unroll
    for (int i = 0; i < 16; ++i) tv[i] = __builtin_nontemporal_load((const f32x4*)(cur.src + (size_t)(cur.k0 + 8 * (i >> 1) + 2 * kr + (i & 1)) * cur.Nsrc + cur.n0 + c4));
    auto step = [&](int q) {
#pragma unroll
        for (int i = 0; i < 8; ++i) { LAS unsigned* d = S + c4 * 33 + 4 * i + kr;
            d[0] = pk2(tv[2 * i].x, tv[2 * i + 1].x); d[33] = pk2(tv[2 * i].y, tv[2 * i + 1].y); d[66] = pk2(tv[2 * i].z, tv[2 * i + 1].z); d[99] = pk2(tv[2 * i].w, tv[2 * i + 1].w); }
        const P0Item nxt = p0_expert_desc(args, ws, e, (q + 8 < qend) ? q + 8 : q);
#pragma unroll
        for (int i = 0; i < 16; ++i) tv[i] = __builtin_nontemporal_load((const f32x4*)(nxt.src + (size_t)(nxt.k0 + 8 * (i >> 1) + 2 * kr + (i & 1)) * nxt.Nsrc + nxt.n0 + c4));
        LDS_WAIT(); asm volatile("" ::: "memory");
#pragma unroll
        for (int j = 0; j < 8; ++j) { const int n = (lane >> 3) + 8 * j; const LAS unsigned* sp = S + n * 33 + 4 * c;
            u32x4 o; o.x = sp[0]; o.y = sp[1]; o.z = sp[2]; o.w = sp[3];
            __builtin_nontemporal_store(o, (u32x4*)(cur.dst + (size_t)(cur.dest_row0 + n) * cur.K + cur.k0 + 8 * c)); }
        LDS_WAIT(); asm volatile("" ::: "memory");
        cur = nxt;
    };
    step(qbeg + wave);
#pragma unroll 1
    for (int q = qbeg + wave + 8; q < qend; q += 8) step(q);
}
__device__ __forceinline__ float wave_sum(float v) {
#define WS_DPP(ctrl, rmask) v += __builtin_bit_cast(float, __builtin_amdgcn_update_dpp(0, __builtin_bit_cast(int, v), ctrl, rmask, 0xF, true))
    WS_DPP(0xB1, 0xF); WS_DPP(0x4E, 0xF); WS_DPP(0x141, 0xF); WS_DPP(0x140, 0xF); WS_DPP(0x142, 0xA); WS_DPP(0x143, 0xC);
#undef WS_DPP
    return __builtin_bit_cast(float, __builtin_amdgcn_readlane(__builtin_bit_cast(int, v), 63));
}
__device__ __forceinline__ void norm_mod_rows16(const float* xbase, const float* g, const float* shift, const float* scale, bf16* obase, int lane) {
    f32x4 gs[4], sh[4];
#pragma unroll
    for (int j = 0; j < 4; ++j) { gs[j] = ((const f32x4*)g)[lane + 64 * j] * (((const f32x4*)scale)[lane + 64 * j] + 1.0f); sh[j] = ((const f32x4*)shift)[lane + 64 * j]; }
#pragma unroll 1
    for (int r = 0; r < 16; r += 2) {
        const f32x4* x0 = (const f32x4*)(xbase + (size_t)r * DM) + lane; const f32x4* x1 = x0 + DM / 4;
        f32x4 v0[4], v1[4]; float s0 = 0.f, s1 = 0.f;
#pragma unroll
        for (int j = 0; j < 4; ++j) { v0[j] = x0[64 * j]; v1[j] = x1[64 * j]; }
#pragma unroll
        for (int j = 0; j < 4; ++j) { s0 += (v0[j].x * v0[j].x + v0[j].y * v0[j].y) + (v0[j].z * v0[j].z + v0[j].w * v0[j].w); s1 += (v1[j].x * v1[j].x + v1[j].y * v1[j].y) + (v1[j].z * v1[j].z + v1[j].w * v1[j].w); }
        const float r0 = __builtin_amdgcn_rsqf(wave_sum(s0) * (1.f / DM) + 1e-6f), r1 = __builtin_amdgcn_rsqf(wave_sum(s1) * (1.f / DM) + 1e-6f);
        unsigned long long* o0 = (unsigned long long*)(obase + (size_t)r * DM) + lane; unsigned long long* o1 = o0 + DM / 4;
#pragma unroll
        for (int j = 0; j < 4; ++j) {
            const f32x4 y0 = v0[j] * r0 * gs[j] + sh[j], y1 = v1[j] * r1 * gs[j] + sh[j];
            o0[64 * j] = (unsigned long long)pk2(y0.x, y0.y) | ((unsigned long long)pk2(y0.z, y0.w) << 32);
            o1[64 * j] = (unsigned long long)pk2(y1.x, y1.y) | ((unsigned long long)pk2(y1.z, y1.w) << 32);
        }
    }
}

__device__ __forceinline__ void norm_mod_rows16_bf(const bf16* xbase, const float* g, const float* shift, const float* scale, bf16* obase, int lane) {
    f32x4 gs[4], sh[4];
#pragma unroll
    for (int j = 0; j < 4; ++j) { gs[j] = ((const f32x4*)g)[lane + 64 * j] * (((const f32x4*)scale)[lane + 64 * j] + 1.0f); sh[j] = ((const f32x4*)shift)[lane + 64 * j]; }
#pragma unroll 1
    for (int r = 0; r < 16; r += 2) {
        const u32x2* x0 = (const u32x2*)(xbase + (size_t)r * DM) + lane; const u32x2* x1 = x0 + DM / 4;
        u32x2 w0[4], w1[4]; f32x4 v0[4], v1[4]; float s0 = 0.f, s1 = 0.f;
#pragma unroll
        for (int j = 0; j < 4; ++j) { w0[j] = x0[64 * j]; w1[j] = x1[64 * j]; }
#pragma unroll
        for (int j = 0; j < 4; ++j) { v0[j] = (f32x4){lo16(w0[j].x), hi16(w0[j].x), lo16(w0[j].y), hi16(w0[j].y)}; v1[j] = (f32x4){lo16(w1[j].x), hi16(w1[j].x), lo16(w1[j].y), hi16(w1[j].y)};
            s0 += (v0[j].x * v0[j].x + v0[j].y * v0[j].y) + (v0[j].z * v0[j].z + v0[j].w * v0[j].w); s1 += (v1[j].x * v1[j].x + v1[j].y * v1[j].y) + (v1[j].z * v1[j].z + v1[j].w * v1[j].w); }
        const float r0 = __builtin_amdgcn_rsqf(wave_sum(s0) * (1.f / DM) + 1e-6f), r1 = __builtin_amdgcn_rsqf(wave_sum(s1) * (1.f / DM) + 1e-6f);
        unsigned long long* o0 = (unsigned long long*)(obase + (size_t)r * DM) + lane; unsigned long long* o1 = o0 + DM / 4;
#pragma unroll
        for (int j = 0; j < 4; ++j) {
            const f32x4 y0 = v0[j] * r0 * gs[j] + sh[j], y1 = v1[j] * r1 * gs[j] + sh[j];
            o0[64 * j] = (unsigned long long)pk2(y0.x, y0.y) | ((unsigned long long)pk2(y0.z, y0.w) << 32);
            o1[64 * j] = (unsigned long long)pk2(y1.x, y1.y) | ((unsigned long long)pk2(y1.z, y1.w) << 32);
        }
    }
}

__device__ __forceinline__ float quad_sum(float x) {
    x += __builtin_bit_cast(float, __builtin_amdgcn_update_dpp(0, __builtin_bit_cast(int, x), 0xB1, 0xF, 0xF, true));
    x += __builtin_bit_cast(float, __builtin_amdgcn_update_dpp(0, __builtin_bit_cast(int, x), 0x4E, 0xF, 0xF, true));
    return x;
}
__device__ __forceinline__ float red16(float x) { x += __shfl_xor(x, 1); x += __shfl_xor(x, 2); x += __shfl_xor(x, 4); x += __shfl_xor(x, 8); return x; }
__device__ __forceinline__ float red8(float x) {
    x = quad_sum(x);
    x += __builtin_bit_cast(float, __builtin_amdgcn_update_dpp(0, __builtin_bit_cast(int, x), 0x141, 0xF, 0xF, true));
    return x;
}

constexpr int CP = 80;
constexpr int MB = 64 * CP * 2;
#define CMAT(i) ((LAS bf16*)(lds + (i) * MB))
__device__ __forceinline__ f32x4 mm_tile(const LAS bf16* A, const LAS bf16* Bt, int m0, int n0, int fr, int fq, f32x4 acc) {
#pragma unroll
    for (int ks = 0; ks < 2; ++ks) {
        const bf16x8 a = *(const LAS bf16x8*)(A + (m0 + fr) * CP + 32 * ks + 8 * fq), b = *(const LAS bf16x8*)(Bt + (n0 + fr) * CP + 32 * ks + 8 * fq);
        acc = __builtin_amdgcn_mfma_f32_16x16x32_bf16(a, b, acc, 0, 0, 0);
    }
    return acc;
}
typedef short s16x4 __attribute__((ext_vector_type(4)));
typedef short s16x8 __attribute__((ext_vector_type(8)));
__device__ __forceinline__ bf16x8 tr_frag(const LAS bf16* X, int c0, int ks, int fr, int fq) {
    const LAS bf16* p = X + (32 * ks + 8 * fq + (fr >> 2)) * CP + c0 + 4 * (fr & 3);
    const s16x4 lo = __builtin_amdgcn_ds_read_tr16_b64_v4i16((LAS s16x4*)p);
    const s16x4 hi = __builtin_amdgcn_ds_read_tr16_b64_v4i16((LAS s16x4*)(p + 4 * CP));
    const s16x8 r = __builtin_shufflevector(lo, hi, 0, 1, 2, 3, 4, 5, 6, 7);
    return __builtin_bit_cast(bf16x8, r);
}
__device__ __forceinline__ f32x4 mm_tile_bn(const LAS bf16* A, const LAS bf16* Xb, int m0, int n0, int fr, int fq, f32x4 acc) {
#pragma unroll
    for (int ks = 0; ks < 2; ++ks) { const bf16x8 a = *(const LAS bf16x8*)(A + (m0 + fr) * CP + 32 * ks + 8 * fq); acc = __builtin_amdgcn_mfma_f32_16x16x32_bf16(a, tr_frag(Xb, n0, ks, fr, fq), acc, 0, 0, 0); }
    return acc;
}
__device__ __forceinline__ f32x4 mm_tile_an(const LAS bf16* Xa, const LAS bf16* Bt, int m0, int n0, int fr, int fq, f32x4 acc) {
#pragma unroll
    for (int ks = 0; ks < 2; ++ks) { const bf16x8 b = *(const LAS bf16x8*)(Bt + (n0 + fr) * CP + 32 * ks + 8 * fq); acc = __builtin_amdgcn_mfma_f32_16x16x32_bf16(tr_frag(Xa, m0, ks, fr, fq), b, acc, 0, 0, 0); }
    return acc;
}
__device__ __forceinline__ f32x4 mm_tile_nn(const LAS bf16* Xa, const LAS bf16* Xb, int m0, int n0, int fr, int fq, f32x4 acc) {
#pragma unroll
    for (int ks = 0; ks < 2; ++ks) acc = __builtin_amdgcn_mfma_f32_16x16x32_bf16(tr_frag(Xa, m0, ks, fr, fq), tr_frag(Xb, n0, ks, fr, fq), acc, 0, 0, 0);
    return acc;
}
__device__ __forceinline__ void tstore(LAS bf16* dst, int m0, int n0, int fr, int fq, f32x4 v) {
    u32x2 w; w.x = pk2(v[0], v[1]); w.y = pk2(v[2], v[3]);
    *(LAS u32x2*)(dst + (n0 + fr) * CP + m0 + 4 * fq) = w;
}
__device__ __forceinline__ void nstore(LAS bf16* dst, int m0, int n0, int fr, int fq, f32x4 v) {
#pragma unroll
    for (int r = 0; r < 4; ++r) dst[(m0 + 4 * fq + r) * CP + n0 + fr] = (bf16)f2bf(v[r]);
}
__device__ __forceinline__ void scan_job(LAS unsigned char* lds, int job, const unsigned char* ws, const float* r_k, const float* ln_w, const float* ln_b, const float* k_k, const float* k_a, int tid, int lane, int wave, int pmode) {
#define REPS(k) for (int _rp = 0; _rp < ((pmode == 10 + (k)) ? 5 : 1); ++_rp)
    const bf16* XR = (const bf16*)(ws + WS_XR); const bf16* EE = (const bf16*)(ws + WS_EE); const bf16* XK = (const bf16*)(ws + WS_XK);
    const bf16* XV = (const bf16*)(ws + WS_XV); const bf16* KKN = (const bf16*)(ws + WS_KKN); const bf16* BV = (const bf16*)(ws + WS_BV);
    const bf16* GG = (const bf16*)(ws + WS_GG); bf16* YC = (bf16*)(ws + WS_H);
    asm volatile("" : "+v"(tid), "+v"(lane));
    const int b = job >> 3, h = job & 7;
    const int fr = lane & 15, fq = lane >> 4;
    const int tm0 = 16 * (wave >> 1), tn0 = 32 * (wave & 1);
    const int et = tid >> 3, ej = 8 * (tid & 7);
    LAS bf16* Kt = CMAT(0); LAS bf16* Rt = CMAT(1); LAS bf16* Kh = CMAT(2); LAS bf16* Bh = CMAT(3); LAS bf16* Kgn = CMAT(4); LAS bf16* Bgn = CMAT(5); LAS bf16* Vn = CMAT(6);
    LAS bf16* Akk = CMAT(7); LAS bf16* Lm = CMAT(8); LAS bf16* LT = CMAT(9); LAS bf16* Ark = CMAT(10); LAS bf16* Arb = CMAT(11);
    LAS float* Ebuf = (LAS float*)(lds + 7 * MB);
    LAS float* Ybuf = (LAS float*)(lds + 2 * MB);
    LAS float* gCv = (LAS float*)(lds + TAB_OFF);
    LAS float* bonv = gCv + 64;
    LAS float* Wtot = gCv + 128;
    const size_t mbase = (size_t)b * SEQ;
    f32x4 Sreg[2]; Sreg[0] = (f32x4){0.f, 0.f, 0.f, 0.f}; Sreg[1] = Sreg[0];
    for (int i = tid; i < MB / 4; i += 512) ((LAS unsigned*)(lds + 14 * MB))[i] = 0u;
    u32x4 ld[6];
    auto issue = [&](int c) {
        const size_t off = (mbase + 64 * c + et) * 512 + h * 64 + ej;
        ld[0] = *(const u32x4*)(XR + off); ld[1] = *(const u32x4*)(EE + off); ld[2] = *(const u32x4*)(XK + off);
        ld[3] = *(const u32x4*)(XV + off); ld[4] = *(const u32x4*)(BV + off); ld[5] = *(const u32x4*)(GG + off);
    };
    LAS float* rkl = gCv + 640; LAS float* lwl = gCv + 704; LAS float* lbl = gCv + 768;
    LAS float* kkl = gCv + 832; LAS float* kal = gCv + 896;
    if (tid < 64) { rkl[tid] = r_k[h * 64 + tid]; lwl[tid] = ln_w[h * 64 + tid]; lbl[tid] = ln_b[h * 64 + tid]; kkl[tid] = k_k[h * 64 + tid]; kal[tid] = k_a[h * 64 + tid]; }
    issue(0);
    __syncthreads();
#pragma unroll 1
    for (int c = 0; c < SEQ / 64; ++c) {
        LAS bf16* S0c = CMAT(14);
        float rr[8], ee[8], kk2[8], vv[8], kn[8], bb[8];
        {
            float n2 = 0.f;
#pragma unroll
            for (int i = 0; i < 4; ++i) { const unsigned w0 = ld[0][i], w1 = ld[1][i], w2 = ld[2][i], w3 = ld[3][i], w4 = ld[4][i];
                rr[2 * i] = lo16(w0); rr[2 * i + 1] = hi16(w0); ee[2 * i] = lo16(w1); ee[2 * i + 1] = hi16(w1); kk2[2 * i] = lo16(w2); kk2[2 * i + 1] = hi16(w2);
                vv[2 * i] = lo16(w3); vv[2 * i + 1] = hi16(w3); bb[2 * i] = lo16(w4); bb[2 * i + 1] = hi16(w4); }
#pragma unroll
            for (int i = 0; i < 8; ++i) { kn[i] = kk2[i] * kkl[ej + i]; n2 += kn[i] * kn[i]; }
            const float inv = __builtin_amdgcn_rsqf(fmaxf(red8(n2), 1e-24f));
#pragma unroll
            for (int i = 0; i < 8; ++i) { kn[i] *= inv; kk2[i] *= 1.0f + (bb[i] - 1.0f) * kal[ej + i]; bb[i] *= kn[i]; }
        }
        const u32x4 gw = ld[5];
        REPS(0) {
        float cum[8];
#pragma unroll
        for (int i = 0; i < 8; ++i) cum[i] = ee[i];
#pragma unroll
        for (int o = 8; o < 64; o <<= 1) {
#pragma unroll
            for (int i = 0; i < 8; ++i) { const float y = __shfl_up(cum[i], o); if (lane >= o) cum[i] += y; } }
        if (lane >= 56) { *(LAS f32x4*)(Wtot + wave * 64 + ej) = (f32x4){cum[0], cum[1], cum[2], cum[3]}; *(LAS f32x4*)(Wtot + wave * 64 + ej + 4) = (f32x4){cum[4], cum[5], cum[6], cum[7]}; }
        __syncthreads();
        {
            float off[8], cumC[8];
#pragma unroll
            for (int i = 0; i < 8; ++i) { off[i] = 0.f; cumC[i] = 0.f; }
#pragma unroll
            for (int w = 0; w < 8; ++w) { const f32x4 a = *(const LAS f32x4*)(Wtot + w * 64 + ej), bq = *(const LAS f32x4*)(Wtot + w * 64 + ej + 4);
                const float tv[8] = {a.x, a.y, a.z, a.w, bq.x, bq.y, bq.z, bq.w};
#pragma unroll
                for (int i = 0; i < 8; ++i) { cumC[i] += tv[i]; off[i] += (w < wave) ? tv[i] : 0.f; } }
            float bsum = 0.f;
            unsigned pkt[4], prt[4], pkh[4], pbh[4], pkg[4], pbg[4], pvn[4]; float okt[8], ort[8], okh[8], obh[8], okg[8], obg[8];
#pragma unroll
            for (int i = 0; i < 8; ++i) {
                const float cm = cum[i] + off[i], cc = cumC[i];
                const float g = __expf(-cm), gp = __expf(ee[i] - cm), gi = __expf(cm), gc = __expf(cm - cc);
                okt[i] = kn[i] * gp; ort[i] = rr[i] * g; okh[i] = kk2[i] * gi; obh[i] = bb[i] * gi; okg[i] = kk2[i] * gc; obg[i] = bb[i] * gc;
                if (et == 63) gCv[ej + i] = __expf(-cc);
                bsum += rr[i] * kk2[i] * rkl[ej + i];
            }
#pragma unroll
            for (int i = 0; i < 4; ++i) { pkt[i] = pk2(okt[2 * i], okt[2 * i + 1]); prt[i] = pk2(ort[2 * i], ort[2 * i + 1]); pkh[i] = pk2(okh[2 * i], okh[2 * i + 1]); pbh[i] = pk2(obh[2 * i], obh[2 * i + 1]);
                pkg[i] = pk2(okg[2 * i], okg[2 * i + 1]); pbg[i] = pk2(obg[2 * i], obg[2 * i + 1]); pvn[i] = pk2(vv[2 * i], vv[2 * i + 1]); }
            *(LAS u32x4*)(Kt + et * CP + ej) = (u32x4){pkt[0], pkt[1], pkt[2], pkt[3]}; *(LAS u32x4*)(Rt + et * CP + ej) = (u32x4){prt[0], prt[1], prt[2], prt[3]};
            *(LAS u32x4*)(Kh + et * CP + ej) = (u32x4){pkh[0], pkh[1], pkh[2], pkh[3]}; *(LAS u32x4*)(Bh + et * CP + ej) = (u32x4){pbh[0], pbh[1], pbh[2], pbh[3]};
            *(LAS u32x4*)(Kgn + et * CP + ej) = (u32x4){pkg[0], pkg[1], pkg[2], pkg[3]}; *(LAS u32x4*)(Bgn + et * CP + ej) = (u32x4){pbg[0], pbg[1], pbg[2], pbg[3]};
            *(LAS u32x4*)(Vn + et * CP + ej) = (u32x4){pvn[0], pvn[1], pvn[2], pvn[3]};
            bsum = red8(bsum);
            if ((tid & 7) == 0) bonv[et] = bsum;
        }
        __syncthreads();
        }
        if (c + 1 < SEQ / 64) issue(c + 1);
        const f32x4 z4 = (f32x4){0.f, 0.f, 0.f, 0.f};
        REPS(1) {
#pragma unroll
        for (int tt = 0; tt < 2; ++tt) {
            const int m0 = tm0, n0 = tn0 + 16 * tt;
            f32x4 a1 = z4, a2 = z4, a3 = z4, a4 = z4, a5 = z4;
            if (m0 <= n0) { a1 = mm_tile(Kh, Kt, m0, n0, fr, fq, z4); a2 = mm_tile(Bh, Kt, m0, n0, fr, fq, z4); a4 = mm_tile(Kh, Rt, m0, n0, fr, fq, z4); a5 = mm_tile(Bh, Rt, m0, n0, fr, fq, z4); }
            if (m0 >= n0) a3 = mm_tile(Kt, Bh, m0, n0, fr, fq, z4);
#pragma unroll
            for (int r = 0; r < 4; ++r) { const int mi = m0 + 4 * fq + r, ni = n0 + fr;
                if (!(mi < ni)) { a1[r] = 0.f; a2[r] = 0.f; } if (!(mi <= ni)) { a4[r] = 0.f; a5[r] = 0.f; } if (!(ni < mi)) a3[r] = 0.f; }
            tstore(Akk, m0, n0, fr, fq, a1); tstore(Lm, m0, n0, fr, fq, a2); tstore(LT, m0, n0, fr, fq, a3); tstore(Ark, m0, n0, fr, fq, a4); tstore(Arb, m0, n0, fr, fq, a5);
        }
        __syncthreads();
        }
        REPS(2) {
            LAS bf16* Pw = CMAT(2); LAS bf16* PwT = CMAT(3); LAS bf16* Tm = CMAT(12);
#pragma unroll
            for (int tt = 0; tt < 2; ++tt) { const int m0 = tm0, n0 = tn0 + 16 * tt;
                const f32x4 p2 = mm_tile(Lm, LT, m0, n0, fr, fq, z4); tstore(PwT, m0, n0, fr, fq, p2); nstore(Pw, m0, n0, fr, fq, p2); }
            const u32x4 lw = *(const LAS u32x4*)(Lm + et * CP + ej); const unsigned lwa[4] = {lw.x, lw.y, lw.z, lw.w}; unsigned o[4];
#pragma unroll
            for (int i = 0; i < 4; ++i) { const float x0 = ((ej + 2 * i) == et ? 1.f : 0.f) - lo16(lwa[i]), x1 = ((ej + 2 * i + 1) == et ? 1.f : 0.f) - hi16(lwa[i]); o[i] = pk2(x0, x1); }
            *(LAS u32x4*)(Tm + et * CP + ej) = (u32x4){o[0], o[1], o[2], o[3]};
        __syncthreads();
        }
        REPS(3)
#pragma unroll 1
        for (int sidx = 0; sidx < 5; ++sidx) {
            LAS bf16* Pw = CMAT((sidx & 1) ? 8 : 2); LAS bf16* PwT = CMAT((sidx & 1) ? 9 : 3); LAS bf16* PwN = CMAT((sidx & 1) ? 2 : 8); LAS bf16* PwNT = CMAT((sidx & 1) ? 3 : 9);
            LAS bf16* Tm = CMAT(12 + (sidx & 1)); LAS bf16* TmN = CMAT(13 - (sidx & 1));
            const LAS bf16* fa = PwT + (tm0 + fr) * CP + 8 * fq; const LAS bf16* fb = Pw + (tm0 + fr) * CP + 8 * fq;
            const bf16x8 aT0 = *(const LAS bf16x8*)fa, aT1 = *(const LAS bf16x8*)(fa + 32), aP0 = *(const LAS bf16x8*)fb, aP1 = *(const LAS bf16x8*)(fb + 32);
            bf16x8 bT[2][2], bP[2][2]; u32x2 tw[2];
#pragma unroll
            for (int tt = 0; tt < 2; ++tt) { const int n0 = tn0 + 16 * tt;
                const LAS bf16* ft = Tm + (n0 + fr) * CP + 8 * fq; const LAS bf16* fp = PwT + (n0 + fr) * CP + 8 * fq;
                bT[tt][0] = *(const LAS bf16x8*)ft; bT[tt][1] = *(const LAS bf16x8*)(ft + 32); bP[tt][0] = *(const LAS bf16x8*)fp; bP[tt][1] = *(const LAS bf16x8*)(fp + 32);
                tw[tt] = *(const LAS u32x2*)(Tm + (n0 + fr) * CP + tm0 + 4 * fq); }
            f32x4 at[2], pt[2];
#pragma unroll
            for (int tt = 0; tt < 2; ++tt) {
                at[tt] = __builtin_amdgcn_mfma_f32_16x16x32_bf16(aT0, bT[tt][0], z4, 0, 0, 0); pt[tt] = __builtin_amdgcn_mfma_f32_16x16x32_bf16(aP0, bP[tt][0], z4, 0, 0, 0); }
#pragma unroll
            for (int tt = 0; tt < 2; ++tt) {
                at[tt] = __builtin_amdgcn_mfma_f32_16x16x32_bf16(aT1, bT[tt][1], at[tt], 0, 0, 0); pt[tt] = __builtin_amdgcn_mfma_f32_16x16x32_bf16(aP1, bP[tt][1], pt[tt], 0, 0, 0); }
#pragma unroll
            for (int tt = 0; tt < 2; ++tt) { const int m0 = tm0, n0 = tn0 + 16 * tt;
                at[tt][0] += lo16(tw[tt].x); at[tt][1] += hi16(tw[tt].x); at[tt][2] += lo16(tw[tt].y); at[tt][3] += hi16(tw[tt].y);
                tstore(TmN, m0, n0, fr, fq, at[tt]); tstore(PwNT, m0, n0, fr, fq, pt[tt]); nstore(PwN, m0, n0, fr, fq, pt[tt]);
            }
            __syncthreads();
        }
        LAS bf16* TmF = CMAT(13);
        LAS bf16* UT = CMAT(8); LAS bf16* SAT = CMAT(9);
        REPS(4) {
#pragma unroll
        for (int tt = 0; tt < 2; ++tt) { const int m0 = tm0, n0 = tn0 + 16 * tt;
            f32x4 a = mm_tile(Kt, S0c, m0, n0, fr, fq, z4); a = mm_tile_bn(Akk, Vn, m0, n0, fr, fq, a); tstore(UT, m0, n0, fr, fq, a); }
        __syncthreads();
        }
        REPS(5) {
#pragma unroll
        for (int tt = 0; tt < 2; ++tt) { const int m0 = tm0, n0 = tn0 + 16 * tt; tstore(SAT, m0, n0, fr, fq, mm_tile(TmF, UT, m0, n0, fr, fq, z4)); }
        __syncthreads();
        }
        REPS(6) {
#pragma unroll
        for (int tt = 0; tt < 2; ++tt) { const int m0 = tm0, n0 = tn0 + 16 * tt;
            f32x4 y = mm_tile(Rt, S0c, m0, n0, fr, fq, z4); y = mm_tile_bn(Ark, Vn, m0, n0, fr, fq, y); const f32x4 y2 = mm_tile(Arb, SAT, m0, n0, fr, fq, z4);
#pragma unroll
            for (int r = 0; r < 4; ++r) Ybuf[(m0 + 4 * fq + r) * 64 + n0 + fr] = y[r] - y2[r];
            f32x4 sn = mm_tile_nn(Kgn, Vn, m0, n0, fr, fq, z4); const f32x4 s2 = mm_tile_an(Bgn, SAT, m0, n0, fr, fq, z4);
            const f32x4 gc4 = *(const LAS f32x4*)(gCv + m0 + 4 * fq);
            sn = gc4 * Sreg[tt] + sn - s2; Sreg[tt] = sn;
        }
        __syncthreads();
#pragma unroll
        for (int tt = 0; tt < 2; ++tt) tstore(S0c, tm0, tn0 + 16 * tt, fr, fq, Sreg[tt]);
        }
        REPS(7) {
            const f32x4 ya = *(const LAS f32x4*)(Ybuf + et * 64 + ej), yb = *(const LAS f32x4*)(Ybuf + et * 64 + ej + 4);
            float y[8] = {ya.x, ya.y, ya.z, ya.w, yb.x, yb.y, yb.z, yb.w};
            float sm = 0.f;
#pragma unroll
            for (int i = 0; i < 8; ++i) sm += y[i];
            const float mean = red8(sm) * (1.f / 64.f); float sq = 0.f;
#pragma unroll
            for (int i = 0; i < 8; ++i) { y[i] -= mean; sq += y[i] * y[i]; }
            const float rs = __builtin_amdgcn_rsqf(red8(sq) * (1.f / 64.f) + 64e-5f);
            const float bon = bonv[et];
            const size_t mrow = mbase + 64 * c + et;
            const unsigned gwa[4] = {gw.x, gw.y, gw.z, gw.w};
            unsigned o[4];
#pragma unroll
            for (int i = 0; i < 4; ++i) {
                const float o0 = ((y[2 * i] * rs) * lwl[ej + 2 * i] + lbl[ej + 2 * i] + vv[2 * i] * bon) * lo16(gwa[i]), o1 = ((y[2 * i + 1] * rs) * lwl[ej + 2 * i + 1] + lbl[ej + 2 * i + 1] + vv[2 * i + 1] * bon) * hi16(gwa[i]);
                o[i] = pk2(o0, o1); }
            *(u32x4*)(YC + mrow * 1024 + h * 64 + ej) = (u32x4){o[0], o[1], o[2], o[3]};
        }
    }
    __syncthreads();
}

__device__ __forceinline__ unsigned sortable(float f) { const unsigned u = __float_as_uint(f); return u ^ ((unsigned)((int)u >> 31) | 0x80000000u); }
#define MFMA32(a, b, c) __builtin_amdgcn_mfma_f32_32x32x16_bf16((a), (b), (c), 0, 0, 0)
__device__ __forceinline__ int wave_sum_i(int v) {
    v += __builtin_amdgcn_update_dpp(0, v, 0xB1, 0xF, 0xF, true);
    v += __builtin_amdgcn_update_dpp(0, v, 0x4E, 0xF, 0xF, true);
    v += __builtin_amdgcn_update_dpp(0, v, 0x141, 0xF, 0xF, true);
    v += __builtin_amdgcn_update_dpp(0, v, 0x140, 0xF, 0xF, true);
    v += __builtin_amdgcn_update_dpp(0, v, 0x142, 0xA, 0xF, true);
    v += __builtin_amdgcn_update_dpp(0, v, 0x143, 0xC, 0xF, true);
    return __builtin_amdgcn_readlane(v, 63);
}
__device__ __forceinline__ int wave_prefix_i(int v) {
    v += __builtin_amdgcn_update_dpp(0, v, 0x111, 0xF, 0xF, false);
    v += __builtin_amdgcn_update_dpp(0, v, 0x112, 0xF, 0xF, false);
    v += __builtin_amdgcn_update_dpp(0, v, 0x114, 0xF, 0xF, false);
    v += __builtin_amdgcn_update_dpp(0, v, 0x118, 0xF, 0xF, false);
    v += __builtin_amdgcn_update_dpp(0, v, 0x142, 0xA, 0xF, false);
    v += __builtin_amdgcn_update_dpp(0, v, 0x143, 0xC, 0xF, false);
    return v;
}
constexpr int HWORDS = 2368;
template <int NR>
__device__ __forceinline__ void radix_pass(const unsigned (&k)[NR], LAS unsigned* H, int lane, int shift, unsigned binmask, bool pred, int pshift, unsigned pval, int need, int& Bout, int& above_out, int& inbin_out) {
    const u32x4 z = (u32x4){0u, 0u, 0u, 0u};
#pragma unroll
    for (int q = 0; q < 9; ++q) ((LAS u32x4*)H)[lane + 64 * q] = z;
    asm volatile("" ::: "memory");
#pragma unroll
    for (int i = 0; i < NR; ++i) {
        const unsigned bin = (k[i] >> shift) & binmask; const unsigned a = bin + 4u * (bin >> 5);
        if (!pred || (k[i] >> pshift) == pval) __hip_atomic_fetch_add(H + a, 1u, __ATOMIC_RELAXED, __HIP_MEMORY_SCOPE_WORKGROUP);
    }
    asm volatile("s_waitcnt lgkmcnt(0)" ::: "memory");
    const int blk = 63 - lane;
    int tot = 0;
#pragma unroll
    for (int q = 0; q < 8; ++q) { const u32x4 v = ((const LAS u32x4*)(H + 36 * blk))[q]; tot += (int)(v.x + v.y + v.z + v.w); }
    const int inc = wave_prefix_i(tot);
    const int A = inc - tot;
    const unsigned long long cross = __ballot(A < need && inc >= need);
    const int Ll = __builtin_ctzll(cross);
    const int Aab = __builtin_amdgcn_readlane(A, Ll);
    const int Bblk = 63 - Ll;
    const int h = (lane < 32) ? (int)H[36 * Bblk + 31 - lane] : 0;
    const int inc2 = wave_prefix_i(h);
    const int a2 = inc2 - h;
    const unsigned long long cross2 = __ballot(lane < 32 && (Aab + a2 < need) && (Aab + inc2 >= need));
    const int js = __builtin_ctzll(cross2);
    Bout = 32 * Bblk + 31 - js; above_out = Aab + __builtin_amdgcn_readlane(a2, js); inbin_out = __builtin_amdgcn_readlane(h, js);
}
template <int NR>
__device__ __forceinline__ void radix_pass1(const unsigned (&k)[NR], LAS unsigned* H, int lane, int need, int& Bout, int& above_out, int& inbin_out) {
    const u32x4 z = (u32x4){0u, 0u, 0u, 0u};
#pragma unroll
    for (int q = 0; q < 9; ++q) ((LAS u32x4*)H)[lane + 64 * q] = z;
    asm volatile("" ::: "memory");
#pragma unroll
    for (int i = 0; i < NR; ++i) { const unsigned vb = ((k[i] >> 24) << 3) | (unsigned)(lane & 7); __hip_atomic_fetch_add(H + vb + 4u * (vb >> 5), 1u, __ATOMIC_RELAXED, __HIP_MEMORY_SCOPE_WORKGROUP); }
    asm volatile("s_waitcnt lgkmcnt(0)" ::: "memory");
    const int blk = 63 - lane;
    int tot = 0;
#pragma unroll
    for (int q = 0; q < 8; ++q) { const u32x4 v = ((const LAS u32x4*)(H + 36 * blk))[q]; tot += (int)(v.x + v.y + v.z + v.w); }
    const int inc = wave_prefix_i(tot);
    const int A = inc - tot;
    const unsigned long long cross = __ballot(A < need && inc >= need);
    const int Ll = __builtin_ctzll(cross);
    const int Aab = __builtin_amdgcn_readlane(A, Ll);
    const int Bblk = 63 - Ll;
    int h = 0;
    if (lane < 4) { const LAS u32x4* hp = (const LAS u32x4*)(H + 36 * Bblk + 8 * (3 - lane)); const u32x4 v0 = hp[0], v1 = hp[1]; h = (int)(v0.x + v0.y + v0.z + v0.w + v1.x + v1.y + v1.z + v1.w); }
    const int inc2 = wave_prefix_i(h);
    const int a2 = inc2 - h;
    const unsigned long long cross2 = __ballot(lane < 4 && (Aab + a2 < need) && (Aab + inc2 >= need));
    const int js = __builtin_ctzll(cross2);
    Bout = 4 * Bblk + 3 - js; above_out = Aab + __builtin_amdgcn_readlane(a2, js); inbin_out = __builtin_amdgcn_readlane(h, js);
}
template <int NR>
__device__ __forceinline__ void dsa_select2(const LAS unsigned* SC, LAS unsigned* MK, LAS unsigned* HB, int sub, int wave, int lane, int nk, int pmode) {
    unsigned ka[NR], kb[NR];
    const int qa = 2 * wave, qb2 = 2 * wave + 1;
#pragma unroll
    for (int i = 0; i < NR; ++i) { const int idx = 64 * i + lane; const bool ok = idx < nk; ka[i] = ok ? SC[qa * 2048 + idx] : 0u; kb[i] = ok ? SC[qb2 * 2048 + idx] : 0u; }
    __syncthreads();
    LAS unsigned* H = HB + wave * HWORDS;
#pragma unroll
    for (int which = 0; which < 2; ++which) {
        const unsigned (&k)[NR] = which ? kb : ka;
        unsigned Tt = 0x80000000u; int need = 1;
        if (pmode != 23) {
            int B, ab, cb; unsigned prefix; bool fin = false;
            radix_pass1<NR>(k, H, lane, 256, B, ab, cb);
            need = 256 - ab; prefix = (unsigned)B;
            if (need == cb && prefix != 0u) { Tt = (prefix << 24) - 1u; need = 0; fin = true; }
            if (!fin) { radix_pass<NR>(k, H, lane, 13, 2047u, true, 24, prefix, need, B, ab, cb);
                need -= ab; prefix = (prefix << 11) | (unsigned)B;
                if (need == cb) { Tt = (prefix << 13) - 1u; need = 0; fin = true; } }
            if (!fin) { radix_pass<NR>(k, H, lane, 2, 2047u, true, 13, prefix, need, B, ab, cb);
                need -= ab; prefix = (prefix << 11) | (unsigned)B;
                if (need == cb) { Tt = (prefix << 2) - 1u; need = 0; fin = true; } }
            if (!fin) { radix_pass<NR>(k, H, lane, 0, 3u, true, 2, prefix, need, B, ab, cb);
                need -= ab; Tt = (prefix << 2) | (unsigned)B; }
        }
        if (pmode != 22) {
        LAS unsigned long long* mrow = (LAS unsigned long long*)(MK + (16 * sub + 2 * wave + which) * 64);
        int ce = 0;
#pragma unroll
        for (int i = 0; i < NR; ++i) ce += (k[i] == Tt) ? 1 : 0;
        const int toteq = (need > 0) ? wave_sum_i(ce) : 0;
        if ((need == 0 && Tt != 0xffffffffu) || (need > 0 && toteq <= need)) {
            const unsigned thr = (need == 0) ? Tt + 1u : Tt;
#pragma unroll
            for (int i = 0; i < NR; ++i) { const unsigned long long mw = __ballot(k[i] >= thr); if (lane == 0) mrow[i] = mw; }
        } else {
#pragma unroll
        for (int i = 0; i < NR; ++i) {
            const unsigned kvv = k[i];
            const unsigned long long gt = __ballot(kvv > Tt), eq = __ballot(kvv == Tt);
            const int ne = __builtin_popcountll(eq);
            unsigned long long take;
            if (ne <= need) { take = eq; need -= ne; }
            else { take = 0ull; unsigned long long e2 = eq; for (int z = 0; z < need; ++z) { const unsigned long long lb = e2 & (~e2 + 1ull); take |= lb; e2 ^= lb; } need = 0; }
            if (lane == 0) mrow[i] = gt | take;
        }
        }
        if (lane >= NR && lane < 32) mrow[lane] = 0ull;
        }
    }
}
__device__ __forceinline__ void dsa_unit(LAS unsigned char* lds, int b, int qb, const unsigned char* ws, const float* at_out_g, int tid, int lane, int wave, int pmode) {
    const bf16* P = (const bf16*)(ws + WS_P); const bf16* VF = (const bf16*)(ws + WS_VF); const bf16* KF = (const bf16*)(ws + WS_KF); const bf16* KIF = (const bf16*)(ws + WS_KIF); bf16* YC = (bf16*)(ws + WS_H);
    asm volatile("" : "+v"(tid), "+v"(lane));
    const int t0 = qb * 32, nk = t0 + 32, nkt = nk >> 5;
    LAS unsigned* SC = (LAS unsigned*)lds;
    LAS unsigned* MK = (LAS unsigned*)(lds + MASK_OFF);
    const size_t rowbase = (size_t)b * SEQ;
    const int l32 = lane & 31, hi = lane >> 5;
    f32x16 zero16;
#pragma unroll
    for (int i = 0; i < 16; ++i) zero16[i] = 0.f;
    unsigned l2touch = 0u;
    if (tid < 416) { const int trow = tid / 13, tli = tid - 13 * trow; const int tcol = (tli < 4) ? C_QI + 64 * tli : ((tli < 12) ? C_Q + 64 * (tli - 4) : C_WI);
        l2touch = *(const volatile unsigned*)(P + (rowbase + t0 + trow) * NP + tcol); }
    if (qb >= 8 && pmode != 4) {
        for (int sub = 0; sub < 2; ++sub) {
            if (pmode != 6) {
            bf16x8 aq[2][4]; float wq[2][4][4];
#pragma unroll
            for (int mt = 0; mt < 2; ++mt) {
#pragma unroll
                for (int s = 0; s < 4; ++s) aq[mt][s] = *(const bf16x8*)(P + (rowbase + t0 + 16 * sub + 8 * mt + (l32 & 7)) * NP + C_QI + (l32 >> 3) * 64 + 16 * s + 8 * hi);
#pragma unroll
                for (int j = 0; j < 4; ++j) { const u32x2 w = *(const u32x2*)(P + (rowbase + t0 + 16 * sub + 8 * mt + 4 * hi + j) * NP + C_WI);
                    wq[mt][j][0] = lo16(w.x) * 0.0625f; wq[mt][j][1] = hi16(w.x) * 0.0625f; wq[mt][j][2] = lo16(w.y) * 0.0625f; wq[mt][j][3] = hi16(w.y) * 0.0625f; }
            }
            bf16x8 bkA[4], bkB[4];
#define SC_LOAD(BK_, kt_) do { const int _kt = (kt_) < nkt ? (kt_) : nkt - 1; \
                _Pragma("unroll") for (int s = 0; s < 4; ++s) BK_[s] = *(const bf16x8*)(KIF + ((((size_t)b * 64 + _kt) * 4 + s) * 64 + lane) * 8); } while (0)
#define SC_STEP(BK_, kt_) do { const bool _ok = (kt_) < nkt; { \
                _Pragma("unroll") for (int mt = 0; mt < 2; ++mt) { \
                    f32x16 acc = zero16; \
                    _Pragma("unroll") for (int s = 0; s < 4; ++s) acc = MFMA32(aq[mt][s], BK_[s], acc); \
                    _Pragma("unroll") for (int j = 0; j < 4; ++j) { \
                        float sc = 0.f; \
                        _Pragma("unroll") for (int g = 0; g < 4; ++g) sc += wq[mt][j][g] * fmaxf(acc[4 * g + j], 0.f); \
                        const int ql = 8 * mt + 4 * hi + j, tq = t0 + 16 * sub + ql, key = 32 * (kt_) + l32; \
                        unsigned u = sortable(sc); if (key > tq) u = 0u; \
                        if (_ok) SC[ql * 2048 + key] = u; } } } } while (0)
            for (int _rp = 0; _rp < (pmode == 20 ? 5 : 1); ++_rp) {
            SC_LOAD(bkA, wave);
            for (int kt = wave; kt < nkt; kt += 16) {
                SC_LOAD(bkB, kt + 8); __builtin_amdgcn_sched_barrier(0); SC_STEP(bkA, kt);
                SC_LOAD(bkA, kt + 16); __builtin_amdgcn_sched_barrier(0); SC_STEP(bkB, kt + 8);
            }
            }
#undef SC_LOAD
#undef SC_STEP
            }
            __syncthreads();
            if (pmode != 5) { const int nr8 = (nk + 511) >> 9;
              if (nr8 == 1) dsa_select2<8>(SC, MK, SC, sub, wave, lane, nk, pmode); else if (nr8 == 2) dsa_select2<16>(SC, MK, SC, sub, wave, lane, nk, pmode);
              else if (nr8 == 3) dsa_select2<24>(SC, MK, SC, sub, wave, lane, nk, pmode); else dsa_select2<32>(SC, MK, SC, sub, wave, lane, nk, pmode); }
            __syncthreads();
        }
    } else {
        for (int idx = tid; idx < 32 * 64; idx += 512) { const int qq = idx >> 6, w = idx & 63, tq = t0 + qq, lo = 32 * w;
            const unsigned m = (lo + 31 <= tq) ? 0xffffffffu : (lo > tq ? 0u : ((1u << (tq - lo + 1)) - 1u)); MK[idx] = m; }
        __syncthreads();
    }
    asm volatile("" :: "v"(l2touch));
    if (pmode != 3 && pmode != 5 && pmode != 6 && pmode < 20) {
        const int hd = wave;
        bf16x8 qf[4];
#pragma unroll
        for (int s = 0; s < 4; ++s) qf[s] = *(const bf16x8*)(P + (rowbase + t0 + l32) * NP + C_Q + 64 * hd + 16 * s + 8 * hi);
        f32x16 o0 = zero16, o1 = zero16; float lrun = 0.f;
        const bf16* Kb = KF + ((size_t)(b * 8 + hd) * 64) * 4 * 64 * 8 + (size_t)lane * 8;
        const bf16* Vb = VF + ((size_t)(b * 8 + hd) * 64) * 4 * 64 * 8 + (size_t)lane * 8;
        bf16x8 kf0[4], kf1[4], vf0[2][2], vf1[2][2];
#define ATT_LOAD(KF_, VF_, kt_) do { const int _kt = (kt_) < nkt ? (kt_) : nkt - 1; \
            _Pragma("unroll") for (int s = 0; s < 4; ++s) KF_[s] = *(const bf16x8*)(Kb + ((size_t)_kt * 4 + s) * 512); \
            _Pragma("unroll") for (int dt = 0; dt < 2; ++dt) _Pragma("unroll") for (int s2 = 0; s2 < 2; ++s2) VF_[dt][s2] = *(const bf16x8*)(Vb + (((size_t)_kt * 2 + dt) * 2 + s2) * 512); } while (0)
#define ATT_STEP(KF_, VF_, kt_) do { \
            f32x16 sacc = zero16; \
            _Pragma("unroll") for (int s = 0; s < 4; ++s) sacc = MFMA32(KF_[s], qf[s], sacc); \
            const int _kc = (kt_) < nkt ? (kt_) : nkt - 1; \
            unsigned mw = MK[l32 * 64 + _kc] >> (4 * hi); mw = ((kt_) < nkt) ? mw : 0u;     \
            float pv[16]; \
            _Pragma("unroll") for (int r = 0; r < 16; ++r) { int sb; asm("v_bfe_i32 %0, %1, %2, 1" : "=v"(sb) : "v"(mw), "n"(8 * (r >> 2) + (r & 3)));     \
                pv[r] = __int_as_float(__float_as_int(__builtin_amdgcn_exp2f(sacc[r])) & sb); lrun += pv[r]; } \
            bf16x8 pf[2]; \
            _Pragma("unroll") for (int s2 = 0; s2 < 2; ++s2) { u32x4 t; t.x = pk2(pv[8 * s2], pv[8 * s2 + 1]); t.y = pk2(pv[8 * s2 + 2], pv[8 * s2 + 3]); t.z = pk2(pv[8 * s2 + 4], pv[8 * s2 + 5]); t.w = pk2(pv[8 * s2 + 6], pv[8 * s2 + 7]); pf[s2] = __builtin_bit_cast(bf16x8, t); } \
            _Pragma("unroll") for (int s2 = 0; s2 < 2; ++s2) { o0 = MFMA32(VF_[0][s2], pf[s2], o0); o1 = MFMA32(VF_[1][s2], pf[s2], o1); } } while (0)
        ATT_LOAD(kf0, vf0, 0);
        for (int kt = 0; kt < nkt; kt += 2) {
            ATT_LOAD(kf1, vf1, kt + 1); __builtin_amdgcn_sched_barrier(0); ATT_STEP(kf0, vf0, kt);
            ATT_LOAD(kf0, vf0, kt + 2); __builtin_amdgcn_sched_barrier(0); ATT_STEP(kf1, vf1, kt + 1);
        }
#undef ATT_LOAD
#undef ATT_STEP
        lrun += __shfl_xor(lrun, 32);
        const float inv = __builtin_amdgcn_rcpf(lrun);
        float ss = 0.f;
#pragma unroll
        for (int r = 0; r < 16; ++r) { o0[r] *= inv; o1[r] *= inv; ss += o0[r] * o0[r] + o1[r] * o1[r]; }
        ss += __shfl_xor(ss, 32);
        const float rs = __builtin_amdgcn_rsqf(ss * (1.f / 64.f) + 1e-6f);
        bf16* orow = YC + (rowbase + t0 + l32) * 1024 + 512 + 64 * hd;
        f32x4 ogv[2][4];
#pragma unroll
        for (int dt = 0; dt < 2; ++dt)
#pragma unroll
            for (int g = 0; g < 4; ++g) ogv[dt][g] = *(const f32x4*)(at_out_g + hd * 64 + 32 * dt + 8 * g + 4 * hi);
#pragma unroll
        for (int dt = 0; dt < 2; ++dt)
#pragma unroll
            for (int g = 0; g < 4; ++g) { const int d = 32 * dt + 8 * g + 4 * hi; const f32x4 og = ogv[dt][g];
                float v0, v1, v2, v3;
                if (dt == 0) { v0 = o0[4 * g]; v1 = o0[4 * g + 1]; v2 = o0[4 * g + 2]; v3 = o0[4 * g + 3]; } else { v0 = o1[4 * g]; v1 = o1[4 * g + 1]; v2 = o1[4 * g + 2]; v3 = o1[4 * g + 3]; }
                u32x2 w; w.x = pk2(v0 * rs * og.x, v1 * rs * og.y); w.y = pk2(v2 * rs * og.z, v3 * rs * og.w);
                *(u32x2*)(orow + d) = w; }
    }
    __syncthreads();
}

constexpr int TAB_FCUM = 1504;
__device__ __forceinline__ void moe_tables(LAS int* tab, const unsigned* ctl, int tid) {
    LAS int* cnt = tab; LAS int* cum = tab + 260; LAS int* tcum = tab + 520; LAS int* fcum = tab + TAB_FCUM;
    if (tid < 64) {
        int c[4], tl[4], nf[4]; int sc = 0, stl = 0, snf = 0;
#pragma unroll
        for (int i = 0; i < 4; ++i) { c[i] = (int)__hip_atomic_load(ctl + CW_CNT + 4 * tid + i, __ATOMIC_RELAXED, __HIP_MEMORY_SCOPE_AGENT); tl[i] = (c[i] + 255) >> 8;
            nf[i] = tl[i] - ((tl[i] >= 1 && c[i] - 256 * (tl[i] - 1) <= 128) ? 1 : 0); sc += c[i]; stl += tl[i]; snf += nf[i]; }
        int ic = sc, it = stl, inf = snf;
        ic = wave_prefix_i(ic); it = wave_prefix_i(it); inf = wave_prefix_i(inf);
        int ec = ic - sc, et = it - stl, ef = inf - snf;
#pragma unroll
        for (int i = 0; i < 4; ++i) { cnt[4 * tid + i] = c[i]; cum[4 * tid + i] = ec; tcum[4 * tid + i] = et; fcum[4 * tid + i] = ef; ec += c[i]; et += tl[i]; ef += nf[i]; }
        if (tid == 63) { cnt[256] = T; cum[256] = T * 8; tcum[256] = et; tcum[257] = et + T / 256; cum[257] = T * 8 + T; fcum[256] = ef; fcum[257] = ef + T / 256; }
    }
    __syncthreads();
    LAS unsigned short* t2e = (LAS unsigned short*)(tab + 800);
    if (tid <= 256) { const int f0 = fcum[tid], nfl = fcum[tid + 1] - f0, F = fcum[257];
        for (int k = 0; k < nfl; ++k) t2e[f0 + k] = (unsigned short)tid;
        if (tcum[tid + 1] - tcum[tid] - nfl == 1) t2e[F + (tcum[tid] - f0)] = (unsigned short)tid; }
    __syncthreads();
}
__device__ __forceinline__ int tile_j(const LAS int* tab, int r, int e) {
    const LAS int* tcum = tab + 520; const LAS int* fcum = tab + TAB_FCUM;
    return (r < fcum[257]) ? r - fcum[e] : tcum[e + 1] - tcum[e] - 1;
}
__device__ __forceinline__ int find_expert(const LAS int* tcum, int tile) {
    return (int)((const LAS unsigned short*)(tcum - 520 + 800))[tile];
}
struct LdsGather {
    static constexpr bool GATHER = true;
    const LAS unsigned* tabl;
    __device__ __forceinline__ unsigned rowoff(int ui, int r) const { return tabl[ui * 256 + r]; }
};
struct Fc1Order {
    const LAS int* tab; int total, G, c;
    __device__ bool next(int i, pg8::Unit& u) const {
        const long L = (long)i * G + c; if (L >= total) return false;
        const int tile = (int)(L >> 1), pn = (int)(L & 1);
        const LAS int* cnt = tab; const LAS int* cum = tab + 260; const LAS int* tcum = tab + 520;
        const int e = __builtin_amdgcn_readfirstlane(find_expert(tcum, tile)), j = __builtin_amdgcn_readfirstlane(tile_j(tab, tile, e));
        u.arow = 0; u.brow = e * 512 + 256 * pn; u.orow = __builtin_amdgcn_readfirstlane(cum[e]) + 256 * j; u.ocol = 128 * pn; const int rem = __builtin_amdgcn_readfirstlane(cnt[e]) - 256 * j; u.nvalid = rem < 256 ? rem : 256; u.aux = 0; return true;
    }
};
struct Fc2Order {
    const LAS int* tab; int total, G, c;
    __device__ bool next(int i, pg8::Unit& u) const {
        const long L = (long)i * G + c; if (L >= total) return false;
        const int tile = (int)(L >> 2), pn = (int)(L & 3);
        const LAS int* cnt = tab; const LAS int* cum = tab + 260; const LAS int* tcum = tab + 520;
        const int e = __builtin_amdgcn_readfirstlane(find_expert(tcum, tile)), j = __builtin_amdgcn_readfirstlane(tile_j(tab, tile, e));
        u.arow = __builtin_amdgcn_readfirstlane(cum[e]) + 256 * j; u.brow = e * 1024 + 256 * pn; u.orow = u.arow; u.ocol = 256 * pn; const int rem = __builtin_amdgcn_readfirstlane(cnt[e]) - 256 * j; u.nvalid = rem < 256 ? rem : 256; u.aux = 0; return true;
    }
};

constexpr int NPHASE = 14;
__global__ void __launch_bounds__(512, 2) fwd_kernel(Args args) {
    extern __shared__ __attribute__((aligned(16))) unsigned char lds_raw[];
    LAS unsigned char* lds = (LAS unsigned char*)lds_raw;
    volatile LAS unsigned* MISC = (volatile LAS unsigned*)(lds + MISC_OFF);
    const int tid = threadIdx.x, lane = tid & 63, wave = __builtin_amdgcn_readfirstlane(tid >> 6);
    const int G = gridDim.x; const int bx = blockIdx.x; const int vcu = (G % 8 == 0) ? (bx % 8) * (G / 8) + bx / 8 : bx;
    unsigned char* ws = args.ws;
    unsigned* ctl = (unsigned*)(ws + WS_CTL);
    if (tid < 64) MISC[tid] = 0u;
    __syncthreads();
    XcdBarrier bar; bar.bar = ctl + CW_BAR; bar.x = 0; bar.st = nullptr;
    if (!MK_PER_PHASE) bar = xcd_barrier_post(ctl + CW_BAR, MISC + 8);
    const int lo = args.ph_lo, hi = args.ph_hi;
#ifdef PROBE_SUB
#define PMODE (args.probe ? PROBE_SUB : 0)
#else
#define PMODE 0
#endif
#ifndef PHASE_MASK
#define PHASE_MASK 0xffffffffu
#endif
#define IN(k) (((PHASE_MASK >> (k)) & 1u) && lo <= (k) && (k) < hi)
#ifndef REPEAT_MASK
#define REPEAT_MASK 0u
#endif
#define NREP(k) (1 + (int)((REPEAT_MASK >> (k)) & 1u))
#define SEAM(k) do { if (IN(k) && IN((k) + 1)) xcd_barrier(bar); } while (0)
    const float* x = args.in[0];
    float* mod = (float*)(ws + WS_MOD);
    const int gw = vcu * 8 + wave, NGW = G * 8;
    const bool conv_split = (G == 256); const int conv_base = conv_split ? 64 : 0;

    if (IN(0)) for (int rep = 0; rep < NREP(0); ++rep) {
        __syncthreads();
        if (vcu < 192) {
            LAS float* cact = (LAS float*)lds;
            const float* c = args.in[1];
            { float cv[32];
#pragma unroll
              for (int j = 0; j < 32; ++j) cv[j] = c[tid + 512 * j];
              __builtin_amdgcn_sched_barrier(0);
#pragma unroll
              for (int j = 0; j < 32; ++j) { const int i = tid + 512 * j, b = i >> 10, k = i & 1023; cact[k * 16 + b] = cv[j] / (1.0f + __expf(-cv[j])); } }
            __syncthreads();
            const float* w_ada = args.in[3]; const float* b_ada = args.in[4];
            const int j0 = vcu * 32, col = lane & 31, kh = lane >> 5;
            float acc[16];
#pragma unroll
            for (int b = 0; b < 16; ++b) acc[b] = 0.f;
#pragma unroll 8
            for (int kk = 0; kk < 64; ++kk) { const int k = 128 * wave + 2 * kk + kh; const float wv = w_ada[(size_t)k * 6144 + j0 + col];
                const LAS f32x4* cp = (const LAS f32x4*)(cact + k * 16);
#pragma unroll
                for (int q4 = 0; q4 < 4; ++q4) { const f32x4 cv = cp[q4]; acc[4 * q4] += cv.x * wv; acc[4 * q4 + 1] += cv.y * wv; acc[4 * q4 + 2] += cv.z * wv; acc[4 * q4 + 3] += cv.w * wv; } }
            LAS float* part = (LAS float*)(lds + 65536);
#pragma unroll
            for (int b = 0; b < 16; ++b) { const float v = acc[b] + __shfl_xor(acc[b], 32); if (lane < 32) part[(wave * 16 + b) * 32 + col] = v; }
            __syncthreads();
            { const int b = tid >> 5, cc = tid & 31; float s = b_ada[j0 + cc];
#pragma unroll
              for (int w = 0; w < 8; ++w) s += part[(w * 16 + b) * 32 + cc];
              mod[(size_t)b * 6144 + j0 + cc] = s; }
            __syncthreads();
        }
        {
            bf16* WLT = (bf16*)(ws + WS_WLT); const float* w2 = args.in[10]; const float* a2 = args.in[12]; const float* g2 = args.in[13];
            for (int idx = vcu * 512 + tid; idx < 1536 * 256; idx += G * 512) { const int n = idx >> 8, k = idx & 255, br = n >> 9, c = n & 511; float v = 0.f;
                if (br == 0) { if (k < 64) v = w2[k * 512 + c]; } else if (br == 1) { if (k >= 64 && k < 128) v = a2[(k - 64) * 512 + c]; } else { if (k >= 128) v = g2[(k - 128) * 512 + c]; }
                WLT[idx] = (bf16)f2bf(v); }
        }
        LAS float* scr = (LAS float*)(lds + wave * 16640);
        constexpr int I_IN = 16 * 60, I_OUT = 16 * 16, I_R = 16 * 4, I_SMALL = I_IN + I_OUT + I_R, I_E = 192, NITEMS = I_SMALL + 257 * I_E;
#ifndef CONV_IN_P5
#define CONV_IN_P5 1
#endif
        const bool p0_split = CONV_IN_P5 && G == 256;
        for (int it = p0_split ? ((vcu >= 192) ? (vcu - 192) * 8 + wave : NITEMS) : gw; it < (CONV_IN_P5 ? I_SMALL : NITEMS); it += p0_split ? 512 : NGW) {
            int r = it;
            if (r < I_IN) { const int kb = r / 60, nb = r % 60; p0_transpose_item(args.in[7], 1024, IN_COLS, (bf16*)(ws + WS_WINT), 64 * nb, 64 * kb, 64 * nb, scr, lane); continue; } r -= I_IN;
            if (r < I_OUT) { const int kb = r / 16, nb = r % 16; p0_transpose_item(args.in[24], 1024, 1024, (bf16*)(ws + WS_WOUTT), 64 * nb, 64 * kb, 64 * nb, scr, lane); continue; } r -= I_OUT;
            if (r < I_R) { const int kb = r / 4, nb = r % 4; p0_transpose_item(args.in[25], 1024, 256, (bf16*)(ws + WS_WRT), 64 * nb, 64 * kb, 64 * nb, scr, lane); continue; } r -= I_R;
            p0_expert_item(args, ws, r / I_E, r % I_E, scr, lane);
        }
    }
    SEAM(0);
    if (IN(1)) for (int rep = 0; rep < NREP(1); ++rep) {
        bf16* H = (bf16*)(ws + WS_H);
        for (int m = gw * 16; m < T; m += NGW * 16) { const int b = m / SEQ; const float* mb = mod + (size_t)b * 6144; norm_mod_rows16(x + (size_t)m * DM, args.in[5], mb, mb + 1024, H + (size_t)m * DM, lane); }
    }
    SEAM(1);
    if (IN(2)) for (int rep = 0; rep < NREP(2); ++rep) {
        pg8::Gemm g{(const bf16*)(ws + WS_H), (const bf16*)(ws + WS_WINT), 1024}; pg8::StaticOrder S; S.init(T, NP, G, bx);
        pg8::EpiBf16 E{(bf16*)(ws + WS_P), NP, 0};
        pg8::gemm_phase<pg8::EpiBf16, pg8::StaticOrder, true, true, pg8::NoGather>(lds, g, S, E, pg8::NoGather{});
        if (conv_split && bx >= 128) {
            __syncthreads();
            const int un = bx - 128; int ln = lane; asm volatile("" : "+v"(ln));
            p0_expert_wave(args, ws, un / 6, 32 * (un % 6), 32 * (un % 6) + 32, wave, (LAS float*)(lds + wave * 16640), ln);
        }
    }
    SEAM(2);
    if (IN(3)) for (int rep = 0; rep < NREP(3); ++rep) {
        bf16* P = (bf16*)(ws + WS_P);
        bf16* XR = (bf16*)(ws + WS_XR); bf16* XK = (bf16*)(ws + WS_XK); bf16* XV = (bf16*)(ws + WS_XV); bf16* KKN = (bf16*)(ws + WS_KKN); bf16* LORA = (bf16*)(ws + WS_LORA); bf16* VF = (bf16*)(ws + WS_VF); bf16* KF = (bf16*)(ws + WS_KF); bf16* KIF = (bf16*)(ws + WS_KIF);
        const float* mu = args.in[8]; const float* k_k = args.in[14]; const int* positions = (const int*)args.in[2];
        const float* qg = args.in[19]; const float* kg = args.in[20]; const float* ilw = args.in[21]; const float* ilb = args.in[22];
        LAS bf16* vbuf = (LAS bf16*)lds;
        LAS bf16* kbuf = (LAS bf16*)(lds + 65536);
        float mu0[8], mu1[8], mu2[8], mu3[8], kkc[8], g1[8], g2[8], frq[8];
        const int ri = lane & 3;
#pragma unroll
        for (int i = 0; i < 8; ++i) { mu0[i] = mu[8 * lane + i]; mu1[i] = mu[512 + 8 * lane + i]; mu2[i] = mu[1024 + 8 * lane + i]; mu3[i] = (lane < 32) ? mu[1536 + 8 * lane + i] : 0.f;
            kkc[i] = k_k[8 * lane + i]; const float* gsrc = (lane < 32) ? qg : kg; g1[i] = gsrc[8 * ri + i]; g2[i] = gsrc[32 + 8 * ri + i];
            frq[i] = exp2f(-(float)(8 * ri + i) * (13.287712379549449f / 32.0f)) * 0.15915494309189535f; }
        struct Tok { u32x4 c0, c1, c2, c3, p0, p1, p2, p3, qa, qb, va, ia, ib; float pos; };
        auto load_tok = [&](size_t m, Tok& t) {
            const bf16* prow = P + m * NP; const bool has_prev = (m % SEQ) != 0; const bf16* pp = has_prev ? prow - NP : prow;
            t.c0 = *(const u32x4*)(prow + 8 * lane); t.c1 = *(const u32x4*)(prow + 512 + 8 * lane); t.c2 = *(const u32x4*)(prow + 1024 + 8 * lane);
            t.p0 = *(const u32x4*)(pp + 8 * lane); t.p1 = *(const u32x4*)(pp + 512 + 8 * lane); t.p2 = *(const u32x4*)(pp + 1024 + 8 * lane);
            if (lane < 32) { t.c3 = *(const u32x4*)(prow + 1536 + 8 * lane); t.p3 = *(const u32x4*)(pp + 1536 + 8 * lane); } else { t.c3 = (u32x4){0u, 0u, 0u, 0u}; t.p3 = t.c3; }
            if (!has_prev) { const u32x4 z = (u32x4){0u, 0u, 0u, 0u}; t.p0 = z; t.p1 = z; t.p2 = z; t.p3 = z; }
            const int qkb = ((lane < 32) ? C_Q : C_K) + 64 * ((lane & 31) >> 2) + 8 * ri;
            t.qa = *(const u32x4*)(prow + qkb); t.qb = *(const u32x4*)(prow + qkb + 32);
            t.va = *(const u32x4*)(prow + C_V + 8 * lane);
            const int ib0 = (lane < 16) ? (C_QI + 64 * (lane >> 2) + 8 * ri) : (C_KI + 8 * ri);
            if (lane < 20) { t.ia = *(const u32x4*)(prow + ib0); t.ib = *(const u32x4*)(prow + ib0 + 32); } else { t.ia = (u32x4){0u, 0u, 0u, 0u}; t.ib = t.ia; }
            t.pos = (float)positions[m];
        };
        auto unpack8 = [&](const u32x4& w, float (&o)[8]) { o[0] = lo16(w.x); o[1] = hi16(w.x); o[2] = lo16(w.y); o[3] = hi16(w.y); o[4] = lo16(w.z); o[5] = hi16(w.z); o[6] = lo16(w.w); o[7] = hi16(w.w); };
        auto pack8 = [&](const float (&o)[8]) { return (u32x4){pk2(o[0], o[1]), pk2(o[2], o[3]), pk2(o[4], o[5]), pk2(o[6], o[7])}; };
        auto proc_tok = [&](size_t m, int tl, const Tok& t) {
            bf16* prow = P + m * NP; const int sq = (int)(m % SEQ), bb = (int)(m / SEQ);
            float c[8], p[8], x[8];
            unpack8(t.c0, c); unpack8(t.p0, p);
#pragma unroll
            for (int i = 0; i < 8; ++i) x[i] = c[i] + (p[i] - c[i]) * mu0[i];
            *(u32x4*)(XR + m * 512 + 8 * lane) = pack8(x);
            unpack8(t.c1, c); unpack8(t.p1, p);
#pragma unroll
            for (int i = 0; i < 8; ++i) x[i] = c[i] + (p[i] - c[i]) * mu1[i];
            *(u32x4*)(XK + m * 512 + 8 * lane) = pack8(x);
            unpack8(t.c2, c); unpack8(t.p2, p);
#pragma unroll
            for (int i = 0; i < 8; ++i) x[i] = c[i] + (p[i] - c[i]) * mu2[i];
            *(u32x4*)(XV + m * 512 + 8 * lane) = pack8(x);
            if (lane < 32) {
                unpack8(t.c3, c); unpack8(t.p3, p);
#pragma unroll
                for (int i = 0; i < 8; ++i) { const float ps = c[i] + (p[i] - c[i]) * mu3[i]; x[i] = (lane < 8) ? tanh_fast(ps) : ((lane < 16) ? ps : sigmoid_fast(ps)); }
                *(u32x4*)(LORA + m * 256 + 8 * lane) = pack8(x);
            }
            float cs[8], sn[8];
#pragma unroll
            for (int i = 0; i < 8; ++i) { float rev = t.pos * frq[i]; rev -= rintf(rev); sn[i] = __builtin_amdgcn_sinf(rev); cs[i] = __builtin_amdgcn_cosf(rev); }
            {
                float x1[8], x2[8]; unpack8(t.qa, x1); unpack8(t.qb, x2);
                float ssq = 0.f;
#pragma unroll
                for (int i = 0; i < 8; ++i) ssq += x1[i] * x1[i] + x2[i] * x2[i];
                ssq = quad_sum(ssq);
                float rstd = __builtin_amdgcn_rsqf(ssq * (1.f / 64.f) + 1e-6f); if (lane < 32) rstd *= 0.125f * 1.4426950408889634f;
                float y1[8], y2[8];
#pragma unroll
                for (int i = 0; i < 8; ++i) { const float a = x1[i] * rstd * g1[i], bq = x2[i] * rstd * g2[i]; y1[i] = a * cs[i] - bq * sn[i]; y2[i] = bq * cs[i] + a * sn[i]; }
                const u32x4 o1 = pack8(y1), o2 = pack8(y2);
                if (lane < 32) { const int qkb = C_Q + 64 * (lane >> 2) + 8 * ri; *(u32x4*)(prow + qkb) = o1; *(u32x4*)(prow + qkb + 32) = o2; }
                else {
                    LAS bf16* kr_ = kbuf + tl * 520 + ((lane - 32) >> 2) * 64 + 8 * ri;
                    *(LAS u32x4*)kr_ = o1; *(LAS u32x4*)(kr_ + 32) = o2;
                }
            }
            *(LAS u32x4*)(vbuf + tl * 512 + 8 * lane) = t.va;
            if (lane < 20) {
                float x1[8], x2[8]; unpack8(t.ia, x1); unpack8(t.ib, x2);
                float sm = 0.f;
#pragma unroll
                for (int i = 0; i < 8; ++i) sm += x1[i] + x2[i];
                sm = quad_sum(sm);
                const bool iski = lane >= 16;
                const float mean = iski ? sm * (1.f / 64.f) : 0.f; float vq = 0.f;
#pragma unroll
                for (int i = 0; i < 8; ++i) { x1[i] -= mean; x2[i] -= mean; vq += x1[i] * x1[i] + x2[i] * x2[i]; }
                vq = quad_sum(vq);
                const float rstd = iski ? __builtin_amdgcn_rsqf(vq * (1.f / 64.f) + 1e-6f) : 1.0f;
                float y1[8], y2[8];
#pragma unroll
                for (int i = 0; i < 8; ++i) { float a = x1[i] * rstd, bq = x2[i] * rstd;
                    if (iski) { a = a * ilw[8 * ri + i] + ilb[8 * ri + i]; bq = bq * ilw[32 + 8 * ri + i] + ilb[32 + 8 * ri + i]; }
                    y1[i] = a * cs[i] - bq * sn[i]; y2[i] = bq * cs[i] + a * sn[i]; }
                const u32x4 o1 = pack8(y1), o2 = pack8(y2);
                if (!iski) { const int ib0 = C_QI + 64 * (lane >> 2) + 8 * ri; *(u32x4*)(prow + ib0) = o1; *(u32x4*)(prow + ib0 + 32) = o2; }
                else {
                    bf16* kfb = KIF + (((size_t)bb * 64 + (sq >> 5)) * 4) * 512 + (sq & 31) * 8;
                    *(u32x4*)(kfb + ((ri >> 1) * 64 + (ri & 1) * 32) * 8) = o1;
                    *(u32x4*)(kfb + ((2 + (ri >> 1)) * 64 + (ri & 1) * 32) * 8) = o2;
                }
            }
        };
        for (int tile = vcu; tile < T / 64; tile += G) {
#pragma unroll 1
            for (int i = 0; i < 8; i += 2) {
                const int tl = wave * 8 + i; const size_t m = (size_t)tile * 64 + tl;
                Tok ta, tb; load_tok(m, ta); load_tok(m + 1, tb);
                proc_tok(m, tl, ta); proc_tok(m + 1, tl + 1, tb);
            }
            __syncthreads();
            {
                const size_t m0 = (size_t)tile * 64; const int b = (int)(m0 / SEQ), s0 = (int)(m0 % SEQ);
                const int h = tid >> 6, d = tid & 63, dt = d >> 5, dl = d & 31;
#pragma unroll
                for (int ktl = 0; ktl < 2; ++ktl)
#pragma unroll
                    for (int s2 = 0; s2 < 2; ++s2)
#pragma unroll
                        for (int hh = 0; hh < 2; ++hh) {
                            const int tb = 32 * ktl + 16 * s2 + 4 * hh; unsigned e[8];
#pragma unroll
                            for (int i = 0; i < 4; ++i) { e[i] = vbuf[(tb + i) * 512 + tid]; e[4 + i] = vbuf[(tb + 8 + i) * 512 + tid]; }
                            u32x4 w; w.x = e[0] | (e[1] << 16); w.y = e[2] | (e[3] << 16); w.z = e[4] | (e[5] << 16); w.w = e[6] | (e[7] << 16);
                            *(u32x4*)(VF + ((((((size_t)(b * 8 + h) * 64 + (s0 >> 5) + ktl) * 2 + dt) * 2 + s2) * 64) + hh * 32 + dl) * 8) = w;
                        }
#pragma unroll
                for (int j = 0; j < 8; ++j) {
                    const int p = tid + 512 * j, tk = p & 31, hi2 = (p >> 5) & 1, s4 = (p >> 6) & 3, kt = (p >> 8) & 1, hk = p >> 9;
                    const u32x4 w = *(const LAS u32x4*)(kbuf + (32 * kt + tk) * 520 + hk * 64 + 8 * (2 * s4 + hi2));
                    *(u32x4*)(KF + (((((size_t)(b * 8 + hk) * 64 + (s0 >> 5) + kt) * 4 + s4) * 64) + hi2 * 32 + tk) * 8) = w;
                }
            }
            __syncthreads();
        }
    }
    SEAM(3);
    if (IN(4)) for (int rep = 0; rep < NREP(4); ++rep) {
        pg8::Gemm g{(const bf16*)(ws + WS_LORA), (const bf16*)(ws + WS_WLT), 256}; pg8::StaticOrder S; S.init(T, 1536, G, bx);
        pg8::EpiLora E{args.in[9], args.in[11], args.in[15], (bf16*)(ws + WS_EE), (bf16*)(ws + WS_XK), (const bf16*)(ws + WS_KKN), (bf16*)(ws + WS_BV), (bf16*)(ws + WS_GG)};
        pg8::gemm_phase<pg8::EpiLora, pg8::StaticOrder, true, true, pg8::NoGather>(lds, g, S, E, pg8::NoGather{});
    }
    SEAM(4);
    if (IN(5)) for (int rep = 0; rep < NREP(5); ++rep) {
        const int myx = (int)(xb_xcc_id() & 7u);
#if CONV_IN_P5
        const int nconv = conv_split ? 25 : 33, cper = conv_split ? 4 : 5, patt = cper * nconv, qlimit = 16 + nconv + 128;
#else
        const int qlimit = 16 + 128;
#endif
        unsigned* qbase = ctl + CW_QUEUE + 256 * (rep + 2 * args.probe);
        int qx = myx;
        unsigned nxt_item = 0u;
        if (tid == 0) nxt_item = atomicAdd(qbase + 16 * qx, 1u);
        for (;;) {
            if (tid == 0) MISC[0] = nxt_item;
            __syncthreads();
            int item = (int)MISC[0];
            __syncthreads();
#ifdef PROBE_SUB
            if (args.probe) { if (PROBE_SUB == 1 || (PROBE_SUB >= 10 && PROBE_SUB < 20)) { if (item >= 16) item = qlimit; } else item += 16; }
#endif
            if (item >= qlimit) {
                if (wave == 0) { unsigned cq = (unsigned)qlimit; if (lane < 8) cq = xb_ld(qbase + 16 * ((myx + lane) & 7));
                    const unsigned long long mq = __ballot(lane < 8 && cq < (unsigned)qlimit); if (lane == 0) MISC[1] = mq ? (unsigned)__builtin_ctzll(mq) : 8u; }
                __syncthreads();
                const int nd = (int)MISC[1];
                __syncthreads();
#ifdef PROBE_SUB
                if (args.probe && (PROBE_SUB == 1 || (PROBE_SUB >= 10 && PROBE_SUB < 20))) break;
#endif
                if (nd >= 8) break;
                qx = (myx + nd) & 7;
                if (tid == 0) nxt_item = atomicAdd(qbase + 16 * qx, 1u);
                continue;
            }
            if (tid == 0) nxt_item = atomicAdd(qbase + 16 * qx, 1u);
#if CONV_IN_P5
            if (item >= 16) {
                const int sl = item - 16;
                if (sl < patt) {
                    const int c5 = sl / cper;
                    if (sl - cper * c5 == cper - 1) {
                        const int e = conv_base + qx + 8 * c5;
                        if (e < 257) { int ln = lane; asm volatile("" : "+v"(ln)); p0_expert_wave(args, ws, e, 0, 192, wave, (LAS float*)(lds + wave * 16640), ln); }
                        continue;
                    }
                    item = 16 + sl - c5;
                } else item = 16 + (cper - 1) * nconv + (sl - patt);
                if (item >= 16 + 128) continue;
            }
#endif
#ifndef NO_SCAN
            if (item < 16) scan_job(lds, 16 * qx + item, ws, args.in[16], args.in[17], args.in[18], args.in[14], args.in[15], tid, lane, wave, PMODE);
#endif
#ifndef NO_DSA
            if (item >= 16) { const int u = item - 16; dsa_unit(lds, 2 * qx + (u >> 6), 63 - (u & 63), ws, args.in[23], tid, lane, wave, PMODE); }
#endif
        }
    }
    SEAM(5);
    if (IN(6)) for (int rep = 0; rep < NREP(6); ++rep) {
        pg8::Gemm g{(const bf16*)(ws + WS_H), (const bf16*)(ws + WS_WOUTT), 1024}; pg8::StaticOrder S; S.init(T, 1024, G, bx);
        pg8::EpiResid E{x, (bf16*)(ws + WS_X1B), mod, 2048};
        pg8::gemm_phase<pg8::EpiResid, pg8::StaticOrder, true, true, pg8::NoGather>(lds, g, S, E, pg8::NoGather{});
    }
    SEAM(6);
    if (IN(7)) for (int rep = 0; rep < NREP(7); ++rep) {
        bf16* H = (bf16*)(ws + WS_H);
        for (int m = gw * 16; m < T; m += NGW * 16) { const int b = m / SEQ; const float* mb = mod + (size_t)b * 6144; norm_mod_rows16_bf((const bf16*)(ws + WS_X1B) + (size_t)m * DM, args.in[6], mb + 3072, mb + 4096, H + (size_t)m * DM, lane); }
    }
    SEAM(7);
    if (IN(8)) for (int rep = 0; rep < NREP(8); ++rep) {
        pg8::Gemm g{(const bf16*)(ws + WS_H), (const bf16*)(ws + WS_WRT), 1024}; pg8::StaticOrder S; S.init(T, 256, G, bx);
        pg8::EpiF32 E{(float*)(ws + WS_LOGIT), 256};
        pg8::gemm_phase<pg8::EpiF32, pg8::StaticOrder, true, true, pg8::NoGather>(lds, g, S, E, pg8::NoGather{});
        if (conv_split && bx >= 128) {
            __syncthreads();
            int ln = lane; asm volatile("" : "+v"(ln));
#pragma unroll 1
            for (int j = 0; j < 2; ++j) { const int un = 128 + 2 * (bx - 128) + j; p0_expert_wave(args, ws, un / 6, 32 * (un % 6), 32 * (un % 6) + 32, wave, (LAS float*)(lds + wave * 16640), ln); }
        }
    }
    SEAM(8);
    if (IN(9)) for (int rep = 0; rep < NREP(9); ++rep) {
        const float* LG = (const float*)(ws + WS_LOGIT); const float* rbias = args.in[26];
        unsigned* SEL = (unsigned*)(ws + WS_SEL); float* GWt = (float*)(ws + WS_GW); int* HG = (int*)(ws + WS_HG);
        LAS int* hist = (LAS int*)lds;
        if (tid < 256) hist[tid] = 0;
        __syncthreads();
        const f32x4 bv = *(const f32x4*)(rbias + 4 * lane);
        constexpr int NT = 4;
        auto dppf = [](float v, auto ctrl) { return __int_as_float(__builtin_amdgcn_update_dpp(0, __float_as_int(v), decltype(ctrl)::value, 0xF, 0xF, true)); };
#pragma unroll 1
        for (int i16 = 0; i16 < 16; i16 += NT) {
            const int m0 = vcu * 128 + wave * 16 + i16;
            f32x4 lg[NT];
#pragma unroll
            for (int t = 0; t < NT; ++t) lg[t] = *(const f32x4*)(LG + (size_t)(m0 + t) * 256 + 4 * lane);
            float sc[NT][4], bs[NT][4], gs[NT];
#pragma unroll
            for (int t = 0; t < NT; ++t) {
#pragma unroll
                for (int i = 0; i < 4; ++i) { sc[t][i] = sigmoidf_(lg[t][i]); bs[t][i] = sc[t][i] + bv[i]; }
            }
            {
                float a1[NT], a2[NT];
#pragma unroll
                for (int t = 0; t < NT; ++t) { a1[t] = fmaxf(bs[t][0], bs[t][1]); a2[t] = fminf(bs[t][0], bs[t][1]);
                    const float b1 = fmaxf(bs[t][2], bs[t][3]), b2 = fminf(bs[t][2], bs[t][3]); const float n1 = fmaxf(a1[t], b1), n2 = fmaxf(fminf(a1[t], b1), fmaxf(a2[t], b2)); a1[t] = n1; a2[t] = n2; }
#pragma unroll
                for (int t = 0; t < NT; ++t) {
                    { const float b1 = dppf(a1[t], std::integral_constant<int, 0xB1>{}), b2 = dppf(a2[t], std::integral_constant<int, 0xB1>{}); const float n1 = fmaxf(a1[t], b1), n2 = fmaxf(fminf(a1[t], b1), fmaxf(a2[t], b2)); a1[t] = n1; a2[t] = n2; }
                    { const float b1 = dppf(a1[t], std::integral_constant<int, 0x4E>{}), b2 = dppf(a2[t], std::integral_constant<int, 0x4E>{}); const float n1 = fmaxf(a1[t], b1), n2 = fmaxf(fminf(a1[t], b1), fmaxf(a2[t], b2)); a1[t] = n1; a2[t] = n2; }
                    { const float b1 = dppf(a1[t], std::integral_constant<int, 0x141>{}), b2 = dppf(a2[t], std::integral_constant<int, 0x141>{}); const float n1 = fmaxf(a1[t], b1), n2 = fmaxf(fminf(a1[t], b1), fmaxf(a2[t], b2)); a1[t] = n1; a2[t] = n2; }
                    gs[t] = a1[t] + a2[t];
                }
            }
            const int mygrp = lane >> 3;
            unsigned key[NT][4];
#pragma unroll
            for (int t = 0; t < NT; ++t) {
                int rank = 0;
#pragma unroll
                for (int g = 0; g < 8; ++g) { const float og = __int_as_float(__builtin_amdgcn_readlane(__float_as_int(gs[t]), 8 * g)); rank += (og > gs[t] || (og == gs[t] && g < mygrp)) ? 1 : 0; }
#pragma unroll
                for (int i = 0; i < 4; ++i) key[t][i] = (rank < 4) ? sortable(bs[t][i]) : 0u;
            }
            int my_e[NT]; float my_s[NT], ssum[NT];
#pragma unroll
            for (int t = 0; t < NT; ++t) { my_e[t] = 0; my_s[t] = 0.f; ssum[t] = 0.f; }
#pragma unroll 1
            for (int r = 0; r < 8; ++r) {
#pragma unroll
                for (int t = 0; t < NT; ++t) {
                    const unsigned lb = max(max(key[t][0], key[t][1]), max(key[t][2], key[t][3]));
                    unsigned v = lb;
                    v = max(v, (unsigned)__builtin_amdgcn_update_dpp(0, (int)v, 0xB1, 0xF, 0xF, true));
                    v = max(v, (unsigned)__builtin_amdgcn_update_dpp(0, (int)v, 0x4E, 0xF, 0xF, true));
                    v = max(v, (unsigned)__builtin_amdgcn_update_dpp(0, (int)v, 0x141, 0xF, 0xF, true));
                    v = max(v, (unsigned)__builtin_amdgcn_update_dpp(0, (int)v, 0x140, 0xF, 0xF, true));
                    v = max(v, (unsigned)__builtin_amdgcn_update_dpp(0, (int)v, 0x142, 0xA, 0xF, true));
                    v = max(v, (unsigned)__builtin_amdgcn_update_dpp(0, (int)v, 0x143, 0xC, 0xF, true));
                    const unsigned M = (unsigned)__builtin_amdgcn_readlane((int)v, 63);
                    const int ol = (int)__builtin_ctzll(__ballot(lb == M));
                    const int oi_l = (key[t][0] == M) ? 0 : (key[t][1] == M) ? 1 : (key[t][2] == M) ? 2 : 3;
                    const float sv_l = (oi_l == 0) ? sc[t][0] : (oi_l == 1) ? sc[t][1] : (oi_l == 2) ? sc[t][2] : sc[t][3];
                    const int oi = __builtin_amdgcn_readlane(oi_l, ol);
                    const float sv = __int_as_float(__builtin_amdgcn_readlane(__float_as_int(sv_l), ol));
                    const int e = 4 * ol + oi;
#pragma unroll
                    for (int i = 0; i < 4; ++i) key[t][i] = (lane == ol && i == oi) ? 0u : key[t][i];
                    ssum[t] += sv;
                    if (lane == r) { my_e[t] = e; my_s[t] = sv; }
                }
            }
            if (lane < 8) {
#pragma unroll
                for (int t = 0; t < NT; ++t) {
                    const int lpos = __hip_atomic_fetch_add(hist + my_e[t], 1, __ATOMIC_RELAXED, __HIP_MEMORY_SCOPE_WORKGROUP);
                    SEL[(size_t)(m0 + t) * 8 + lane] = (unsigned)my_e[t] | ((unsigned)lpos << 8);
                    GWt[(size_t)(m0 + t) * 8 + lane] = my_s[t] / ssum[t] * 2.5f;
                }
            }
        }
        __syncthreads();
        if (tid < 256) HG[vcu * 256 + tid] = hist[tid];
        __syncthreads();
    }
    SEAM(9);
    if (IN(10)) for (int rep = 0; rep < NREP(10); ++rep) {
        unsigned* SEL = (unsigned*)(ws + WS_SEL); const int* HG = (const int*)(ws + WS_HG); int* TOKL = (int*)(ws + WS_TOKL);
        LAS int* basel = (LAS int*)lds;
        {
            const int e = tid & 255, half = tid >> 8; int bsum = 0, tsum = 0;
#pragma unroll 16
            for (int w = 0; w < 128; ++w) { const int wg = half * 128 + w; const int v = HG[wg * 256 + e]; tsum += v; bsum += (wg < vcu) ? v : 0; }
            basel[half * 256 + e] = bsum; basel[512 + half * 256 + e] = tsum;
        }
        __syncthreads();
        if (tid < 256) { const int bsum = basel[tid] + basel[256 + tid], tsum = basel[512 + tid] + basel[768 + tid]; basel[1024 + tid] = bsum; if (vcu == 0) ctl[CW_CNT + tid] = (unsigned)tsum; }
        __syncthreads();
#pragma unroll
        for (int k2 = 0; k2 < 2; ++k2) { const int idx = tid + 512 * k2; const int m = vcu * 128 + (idx >> 3);
            const unsigned se = SEL[(size_t)m * 8 + (idx & 7)]; const int e = (int)(se & 255u), pos = basel[1024 + e] + (int)(se >> 8);
            SEL[(size_t)m * 8 + (idx & 7)] = (unsigned)e | ((unsigned)pos << 8); TOKL[(size_t)e * ECAP + pos] = m; }
        __syncthreads();
    }
    SEAM(10);
    if (IN(11)) for (int rep = 0; rep < NREP(11); ++rep) {
        LAS int* tab = (LAS int*)(lds + TAB_OFF);
        moe_tables(tab, ctl, tid);
        const LAS int* cnt = tab; const LAS int* cum = tab + 260; const LAS int* tcum = tab + 520;
        const int total = 2 * __builtin_amdgcn_readfirstlane(tcum[257]);
        LAS unsigned* gtab = (LAS unsigned*)(lds + 131072);
        {
            const int* TOKL = (const int*)(ws + WS_TOKL);
            int tokv[11];
#pragma unroll
            for (int k = 0; k < 11; ++k) { const int i = (tid >> 8) + 2 * k; int uix = vcu + i * G; uix = uix < total ? uix : total - 1;
                const int tile = uix >> 1, e = find_expert(tcum, tile), j = tile_j(tab, tile, e), r = tid & 255, rem = cnt[e] - 256 * j;
                const int ld = TOKL[(size_t)(e < 256 ? e : 0) * ECAP + 256 * j * (e < 256 ? 1 : 0) + (r < rem ? r : 0)];
                tokv[k] = (e < 256) ? ld : 256 * j + r; }
#pragma unroll
            for (int k = 0; k < 11; ++k) { const int i = (tid >> 8) + 2 * k; if (vcu + i * G < total) gtab[i * 256 + (tid & 255)] = (unsigned)tokv[k] * 2048u; }
        }
        __syncthreads();
        Fc1Order S; S.tab = tab; S.total = total; S.G = G; S.c = vcu;
        LdsGather am; am.tabl = gtab;
        pg8::Gemm g{(const bf16*)(ws + WS_H), (const bf16*)(ws + WS_W13T), 1024};
        pg8::EpiSwiglu E{(bf16*)(ws + WS_ACT)};
        pg8::gemm_phase<pg8::EpiSwiglu, Fc1Order, true, true, LdsGather>(lds, g, S, E, am);
        (void)cum;
    }
    SEAM(11);
    if (IN(12)) for (int rep = 0; rep < NREP(12); ++rep) {
        LAS int* tab = (LAS int*)(lds + TAB_OFF);
        if (!IN(11)) moe_tables(tab, ctl, tid);
        Fc2Order S; S.tab = tab; S.total = 4 * __builtin_amdgcn_readfirstlane(tab[520 + 257]); S.G = G; S.c = vcu;
        pg8::Gemm g{(const bf16*)(ws + WS_ACT), (const bf16*)(ws + WS_W2T), 256};
        pg8::EpiFp8 E{(unsigned char*)(ws + WS_Y), 1024, (PMODE == 7) ? 100000 : 0};
        pg8::gemm_phase<pg8::EpiFp8, Fc2Order, true, true, pg8::NoGather>(lds, g, S, E, pg8::NoGather{});
    }
    SEAM(12);
    if (IN(13)) for (int rep = 0; rep < NREP(13); ++rep) {
        LAS int* tab = (LAS int*)(lds + TAB_OFF);
        if (!IN(11)) moe_tables(tab, ctl, tid);
        const LAS int* cum = tab + 260;
        const unsigned char* Y = (const unsigned char*)(ws + WS_Y); const unsigned* SEL = (const unsigned*)(ws + WS_SEL); const float* GWt = (const float*)(ws + WS_GW);
        for (int m = gw; m < T; m += NGW) {
            const int b = m / SEQ; const float* g2 = mod + (size_t)b * 6144 + 5120;
            float acc[16];
            u32x4 yv[9]; float wv[9];
            yv[0] = __builtin_nontemporal_load((const u32x4*)(Y + ((size_t)T * 8 + m) * 1024 + 16 * lane)); wv[0] = 1.0f;
#pragma unroll
            for (int j = 0; j < 8; ++j) {
                const unsigned se = SEL[(size_t)m * 8 + j]; wv[1 + j] = GWt[(size_t)m * 8 + j];
                const int e = (int)(se & 255u), pos = (int)(se >> 8);
                yv[1 + j] = __builtin_nontemporal_load((const u32x4*)(Y + ((size_t)cum[e] + pos) * 1024 + 16 * lane));
            }
#pragma unroll
            for (int i = 0; i < 16; ++i) acc[i] = 0.f;
#pragma unroll
            for (int j = 0; j < 9; ++j) {
                const float w = wv[j]; const unsigned dw[4] = {yv[j].x, yv[j].y, yv[j].z, yv[j].w};
#pragma unroll
                for (int q4 = 0; q4 < 4; ++q4) { const f32x2 lo = __builtin_amdgcn_cvt_pk_f32_fp8((int)dw[q4], false), hi2 = __builtin_amdgcn_cvt_pk_f32_fp8((int)dw[q4], true);
                    acc[4 * q4] += w * lo.x; acc[4 * q4 + 1] += w * lo.y; acc[4 * q4 + 2] += w * hi2.x; acc[4 * q4 + 3] += w * hi2.y; }
            }
            float* orow = args.out + (size_t)m * DM + 16 * lane;
            const u32x4* xr1 = (const u32x4*)((const bf16*)(ws + WS_X1B) + (size_t)m * DM + 16 * lane); const u32x4 xa = xr1[0], xb = xr1[1];
            const unsigned xw[8] = {xa.x, xa.y, xa.z, xa.w, xb.x, xb.y, xb.z, xb.w};
#pragma unroll
            for (int q4 = 0; q4 < 4; ++q4) { const f32x4 gv = *(const f32x4*)(g2 + 16 * lane + 4 * q4);
                f32x4 o; o.x = lo16(xw[2 * q4]) + gv.x * acc[4 * q4]; o.y = hi16(xw[2 * q4]) + gv.y * acc[4 * q4 + 1]; o.z = lo16(xw[2 * q4 + 1]) + gv.z * acc[4 * q4 + 2]; o.w = hi16(xw[2 * q4 + 1]) + gv.w * acc[4 * q4 + 3];
                *(f32x4*)(orow + 4 * q4) = o; }
        }
    }
#undef IN
#undef SEAM
}

extern "C" void kernel_launch(void* const* d_in, const int* in_sizes, int n_in, void* d_out, int out_size, void* d_ws, size_t ws_size, hipStream_t stream) {
    static int grid = 0;
    if (grid == 0) {
        if (n_in != 33 || out_size != T * DM || ws_size < WS_END) { fprintf(stderr, "kernel_launch: unexpected shapes (n_in %d out %d ws %zu)\n", n_in, out_size, ws_size); grid = -1; return; }
        int dev = 0, cus = 0, per_cu = 0;
        hipGetDevice(&dev); hipDeviceGetAttribute(&cus, hipDeviceAttributeMultiprocessorCount, dev);
        hipFuncSetAttribute((const void*)fwd_kernel, hipFuncAttributeMaxDynamicSharedMemorySize, LDS_BYTES);
        hipOccupancyMaxActiveBlocksPerMultiprocessor(&per_cu, (const void*)fwd_kernel, 512, LDS_BYTES);
        (void)hipGetLastError();
        if (per_cu < 1) fprintf(stderr, "kernel_launch: occupancy query says %d\n", per_cu);
        grid = cus;
    }
    if (grid < 0) return;
    hipMemsetAsync((char*)d_ws + WS_CTL, 0, CTL_BYTES, stream);
    Args a{};
    for (int i = 0; i < 33; ++i) a.in[i] = (const float*)d_in[i];
    a.out = (float*)d_out; a.ws = (unsigned char*)d_ws;
#if MK_PER_PHASE
    for (int p = 0; p < NPHASE; ++p) { a.ph_lo = p; a.ph_hi = p + 1; hipLaunchKernelGGL(fwd_kernel, dim3(grid), dim3(512), LDS_BYTES, stream, a); }
#else
    a.ph_lo = 0; a.ph_hi = NPHASE;
    void* kargs[] = {&a};
    hipError_t e = hipLaunchCooperativeKernel((const void*)fwd_kernel, dim3(grid), dim3(512), kargs, LDS_BYTES, stream);
    if (e != hipSuccess) fprintf(stderr, "cooperative launch failed: %s (grid %d)\n", hipGetErrorString(e), grid);
#ifdef PROBE_PHASE
    a.ph_lo = PROBE_PHASE; a.ph_hi = PROBE_PHASE + 1; a.probe = 1; hipLaunchKernelGGL(fwd_kernel, dim3(grid), dim3(512), LDS_BYTES, stream, a);
#endif
#endif
}
```
